# Optimizing an MI355X kernel written in HIP

```python
import math
import jax, jax.numpy as jnp
from jax import lax
import numpy as np

D_MODEL = 2048
BATCH = 4
SEQ = 2048
DEPTH = 2

GRID_W = 64
CTX_LEN = 256
N_MOD = 6
SSM_WIDTH = D_MODEL // 2
SSM_GROUP = 16
SSM_GROUPS = SSM_WIDTH // SSM_GROUP
SSM_STATE = 64
DT_MIN = 0.001
DT_MAX = 0.1
NA_HEADS = 16
NA_HEAD_DIM = 64
NA_WIDTH = NA_HEADS * NA_HEAD_DIM
WIN_R = 8
WIN_C = 16
ROPE_BASE = 10000.0
D_FF = 4 * D_MODEL
NORM_EPS = 1e-6
PROJ_WIDTH = SSM_WIDTH + 3 * NA_WIDTH + 2 * D_MODEL

kernel_name = "hybrid_s5_natten_prefix_dit_block"


def rms_norm(x, g):
    xf = x.astype(jnp.float32)
    y = xf * lax.rsqrt(jnp.mean(xf * xf, axis=-1, keepdims=True) + NORM_EPS)
    return (y * g.astype(jnp.float32)).astype(x.dtype)


def modulate(x, shift, scale):
    return x * (1.0 + scale) + shift


def axial_rope(x, rows, cols):
    nf = NA_HEAD_DIM // 4
    half = NA_HEAD_DIM // 2
    inv = ROPE_BASE ** (-jnp.arange(nf, dtype=jnp.float32) / nf)

    def rot(xp, pos):
        ang = pos.astype(jnp.float32)[:, None] * inv
        cos = jnp.cos(ang)[None, :, None, :]
        sin = jnp.sin(ang)[None, :, None, :]
        x1, x2 = xp[..., :nf], xp[..., nf:]
        return jnp.concatenate([x1 * cos - x2 * sin, x1 * sin + x2 * cos], axis=-1)

    xf = x.astype(jnp.float32)
    out = jnp.concatenate([rot(xf[..., :half], rows), rot(xf[..., half:], cols)], axis=-1)
    return out.astype(x.dtype)


def s5_discretise(lam_re, lam_im, log_dt, b_re, b_im):
    lam = lax.complex(lam_re.astype(jnp.float32), lam_im.astype(jnp.float32))
    dt = jnp.exp(log_dt.astype(jnp.float32))[:, None]
    lam_bar = jnp.exp(lam * dt)
    b = lax.complex(b_re.astype(jnp.float32), b_im.astype(jnp.float32))
    b_bar = ((lam_bar - 1.0) / lam)[..., None] * b
    return lam_bar, b_bar


def _lin_comb(e_i, e_j):
    a_i, b_i = e_i
    a_j, b_j = e_j
    return a_j * a_i, a_j * b_i + b_j


def s5_scan(u, lam_bar, b_bar, s0, reverse):
    bu = jnp.einsum('gpc,btgc->btgp', b_bar, u.astype(jnp.complex64))
    if s0 is not None:
        first = -1 if reverse else 0
        bu = bu.at[:, first].add(lam_bar * s0)
    a = jnp.broadcast_to(lam_bar, bu.shape)
    _, states = lax.associative_scan(_lin_comb, (a, bu), axis=1, reverse=reverse)
    return states


def s5_readout(states, c_re, c_im):
    cmat = lax.complex(c_re.astype(jnp.float32), c_im.astype(jnp.float32))
    return jnp.real(jnp.einsum('gcp,btgp->btgc', cmat, states))


def s5_mixer(u_lat, u_ctx, lam_re, lam_im, log_dt, b_re, b_im, c_re, c_im, d_skip, with_ctx_out):
    bsz, t_len, _ = u_lat.shape
    c_len = u_ctx.shape[1]
    ul = u_lat.astype(jnp.float32).reshape(bsz, t_len, SSM_GROUPS, SSM_GROUP)
    uc = u_ctx.astype(jnp.float32).reshape(bsz, c_len, SSM_GROUPS, SSM_GROUP)
    dg = d_skip.astype(jnp.float32).reshape(SSM_GROUPS, SSM_GROUP)
    y_lat = ul * dg
    y_ctx = uc * dg
    for dirn, reverse in ((0, False), (1, True)):
        lam_bar, b_bar = s5_discretise(lam_re[dirn], lam_im[dirn], log_dt[dirn], b_re[dirn], b_im[dirn])
        st_ctx = s5_scan(uc, lam_bar, b_bar, None, reverse)
        s0 = st_ctx[:, 0] if reverse else st_ctx[:, -1]
        st_lat = s5_scan(ul, lam_bar, b_bar, s0, reverse)
        y_lat = y_lat + s5_readout(st_lat, c_re[dirn], c_im[dirn])
        if with_ctx_out:
            y_ctx = y_ctx + s5_readout(st_ctx, c_re[dirn], c_im[dirn])
    y_lat = y_lat.reshape(bsz, t_len, SSM_WIDTH).astype(u_lat.dtype)
    y_ctx = y_ctx.reshape(bsz, c_len, SSM_WIDTH).astype(u_ctx.dtype)
    return y_lat, y_ctx


def s5_glu(y, w_val, w_glu):
    a = jax.nn.gelu(y)
    return (a @ w_val) * jax.nn.sigmoid(a @ w_glu)


def neighbourhood_attention(q, k, v, k_ctx, v_ctx, rpb):
    bsz, t_len, n_h, dh = q.shape
    rows = t_len // GRID_W
    kr = min(WIN_R, rows)
    kc = min(WIN_C, GRID_W)
    nk = kr * kc
    qg = q.reshape(bsz, rows, GRID_W, n_h, dh)
    kg = k.reshape(bsz, rows, GRID_W, n_h, dh)
    vg = v.reshape(bsz, rows, GRID_W, n_h, dh)
    cols = np.arange(GRID_W)
    c0 = np.clip(cols - kc // 2, 0, GRID_W - kc)
    col_idx = c0[:, None] + np.arange(kc)[None, :]
    col_off = col_idx - cols[:, None] + (WIN_C - 1)
    bias_c = rpb.astype(jnp.float32)[:, :, col_off]
    scale = dh ** -0.5

    def one_row(r):
        r0 = jnp.clip(r - kr // 2, 0, rows - kr)
        q_r = lax.dynamic_index_in_dim(qg, r, axis=1, keepdims=False)
        k_rows = lax.dynamic_slice_in_dim(kg, r0, kr, axis=1)
        v_rows = lax.dynamic_slice_in_dim(vg, r0, kr, axis=1)
        k_win = k_rows[:, :, col_idx].transpose(0, 2, 1, 3, 4, 5).reshape(bsz, GRID_W, nk, n_h, dh)
        v_win = v_rows[:, :, col_idx].transpose(0, 2, 1, 3, 4, 5).reshape(bsz, GRID_W, nk, n_h, dh)
        row_off = r0 + jnp.arange(kr) - r + (WIN_R - 1)
        bias = jnp.take(bias_c, row_off, axis=1)
        bias = bias.transpose(0, 2, 1, 3).reshape(n_h, GRID_W, nk)
        s_loc = jnp.einsum('bwhd,bwkhd->bhwk', q_r, k_win).astype(jnp.float32) * scale + bias
        s_ctx = jnp.einsum('bwhd,blhd->bhwl', q_r, k_ctx).astype(jnp.float32) * scale
        p = jax.nn.softmax(jnp.concatenate([s_loc, s_ctx], axis=-1), axis=-1).astype(v.dtype)
        return (jnp.einsum('bhwk,bwkhd->bwhd', p[..., :nk], v_win)
                + jnp.einsum('bhwl,blhd->bwhd', p[..., nk:], v_ctx))

    out = lax.map(one_row, jnp.arange(rows))
    return out.transpose(1, 0, 2, 3, 4).reshape(bsz, t_len, n_h * dh)


def context_attention(q, k, v):
    s = jnp.einsum('blhd,bmhd->bhlm', q, k).astype(jnp.float32) * (NA_HEAD_DIM ** -0.5)
    p = jax.nn.softmax(s, axis=-1).astype(v.dtype)
    o = jnp.einsum('bhlm,bmhd->blhd', p, v)
    return o.reshape(q.shape[0], q.shape[1], NA_WIDTH)


def mixer_sublayer(h, hc, w_in, lam_re, lam_im, log_dt, b_re, b_im, c_re, c_im, d_skip,
                   w_ssm_val, w_ssm_glu, rpb, w_na_proj, w_out, with_ctx_out):
    bsz, t_len, _ = h.shape
    c_len = hc.shape[1]
    s1 = SSM_WIDTH
    s2 = s1 + NA_WIDTH
    s3 = s2 + NA_WIDTH
    s4 = s3 + NA_WIDTH
    s5 = s4 + D_MODEL
    proj = h @ w_in
    projc = hc @ w_in
    u, q, k, v, g_s, g_n = (proj[..., :s1], proj[..., s1:s2], proj[..., s2:s3],
                            proj[..., s3:s4], proj[..., s4:s5], proj[..., s5:])
    uc, qc, kc_, vc, g_sc, g_nc = (projc[..., :s1], projc[..., s1:s2], projc[..., s2:s3],
                                   projc[..., s3:s4], projc[..., s4:s5], projc[..., s5:])
    y_s, y_sc = s5_mixer(u, uc, lam_re, lam_im, log_dt, b_re, b_im, c_re, c_im, d_skip, with_ctx_out)
    br_s = s5_glu(y_s, w_ssm_val, w_ssm_glu)
    pos = jnp.arange(t_len)
    rows_pos, cols_pos = pos // GRID_W, pos % GRID_W
    qh = axial_rope(q.reshape(bsz, t_len, NA_HEADS, NA_HEAD_DIM), rows_pos, cols_pos)
    kh = axial_rope(k.reshape(bsz, t_len, NA_HEADS, NA_HEAD_DIM), rows_pos, cols_pos)
    vh = v.reshape(bsz, t_len, NA_HEADS, NA_HEAD_DIM)
    kch = kc_.reshape(bsz, c_len, NA_HEADS, NA_HEAD_DIM)
    vch = vc.reshape(bsz, c_len, NA_HEADS, NA_HEAD_DIM)
    br_n = neighbourhood_attention(qh, kh, vh, kch, vch, rpb) @ w_na_proj
    out = (jax.nn.sigmoid(g_s) * br_s + jax.nn.sigmoid(g_n) * br_n) @ w_out
    if not with_ctx_out:
        return out, None
    br_sc = s5_glu(y_sc, w_ssm_val, w_ssm_glu)
    qch = qc.reshape(bsz, c_len, NA_HEADS, NA_HEAD_DIM)
    br_nc = context_attention(qch, kch, vch) @ w_na_proj
    outc = (jax.nn.sigmoid(g_sc) * br_sc + jax.nn.sigmoid(g_nc) * br_nc) @ w_out
    return out, outc


def sq_relu_mlp(h, w_fc1, w_fc2):
    a = jax.nn.relu(h @ w_fc1)
    return (a * a) @ w_fc2


def setup_inputs(seed: int = 0) -> dict:
    key = jax.random.key(seed)
    ks = jax.random.split(key, 32)
    f32 = jnp.float32
    G, P, CG = SSM_GROUPS, SSM_STATE, SSM_GROUP

    def nrm(k, shape, std):
        return jax.random.normal(k, shape, f32) * std

    n_idx = jnp.arange(P, dtype=f32)
    return {
        "x": nrm(ks[0], (BATCH, SEQ, D_MODEL), 1.0),
        "c": nrm(ks[1], (BATCH, D_MODEL), 1.0),
        "ctx": nrm(ks[2], (BATCH, CTX_LEN, D_MODEL), 1.0),
        "c_ctx": nrm(ks[3], (D_MODEL,), 1.0),
        "w_mod": nrm(ks[4], (DEPTH, D_MODEL, N_MOD * D_MODEL), 0.5 * D_MODEL ** -0.5),
        "b_mod": nrm(ks[5], (DEPTH, N_MOD * D_MODEL), 0.02),
        "g_pre_mix": 1.0 + nrm(ks[6], (DEPTH, D_MODEL), 0.02),
        "g_post_mix": 1.0 + nrm(ks[7], (DEPTH, D_MODEL), 0.02),
        "g_pre_mlp": 1.0 + nrm(ks[8], (DEPTH, D_MODEL), 0.02),
        "g_post_mlp": 1.0 + nrm(ks[9], (DEPTH, D_MODEL), 0.02),
        "w_in": nrm(ks[10], (DEPTH, D_MODEL, PROJ_WIDTH), D_MODEL ** -0.5),
        "ssm_lam_re": -0.5 + nrm(ks[11], (DEPTH, 2, G, P), 0.01),
        "ssm_lam_im": math.pi * n_idx + nrm(ks[12], (DEPTH, 2, G, P), 0.01),
        "ssm_log_dt": jax.random.uniform(ks[13], (DEPTH, 2, G), f32, math.log(DT_MIN), math.log(DT_MAX)),
        "ssm_b_re": nrm(ks[14], (DEPTH, 2, G, P, CG), (2 * CG) ** -0.5),
        "ssm_b_im": nrm(ks[15], (DEPTH, 2, G, P, CG), (2 * CG) ** -0.5),
        "ssm_c_re": nrm(ks[16], (DEPTH, 2, G, CG, P), (2 * P) ** -0.5),
        "ssm_c_im": nrm(ks[17], (DEPTH, 2, G, CG, P), (2 * P) ** -0.5),
        "ssm_d": nrm(ks[18], (DEPTH, SSM_WIDTH), 0.5),
        "w_ssm_val": nrm(ks[19], (DEPTH, SSM_WIDTH, D_MODEL), SSM_WIDTH ** -0.5),
        "w_ssm_glu": nrm(ks[20], (DEPTH, SSM_WIDTH, D_MODEL), SSM_WIDTH ** -0.5),
        "na_rpb": nrm(ks[21], (DEPTH, NA_HEADS, 2 * WIN_R - 1, 2 * WIN_C - 1), 0.1),
        "w_na_proj": nrm(ks[22], (DEPTH, NA_WIDTH, D_MODEL), NA_WIDTH ** -0.5),
        "w_out": nrm(ks[23], (DEPTH, D_MODEL, D_MODEL), D_MODEL ** -0.5),
        "w_fc1": nrm(ks[24], (DEPTH, D_MODEL, D_FF), D_MODEL ** -0.5),
        "w_fc2": nrm(ks[25], (DEPTH, D_FF, D_MODEL), D_FF ** -0.5),
    }


def reference(x, c, ctx, c_ctx, w_mod, b_mod, g_pre_mix, g_post_mix, g_pre_mlp, g_post_mlp, w_in,
              ssm_lam_re, ssm_lam_im, ssm_log_dt, ssm_b_re, ssm_b_im, ssm_c_re, ssm_c_im, ssm_d,
              w_ssm_val, w_ssm_glu, na_rpb, w_na_proj, w_out, w_fc1, w_fc2):
    xc = ctx
    for l in range(DEPTH):
        with_ctx_out = l < DEPTH - 1
        mod = jax.nn.silu(c) @ w_mod[l] + b_mod[l]
        sh1, sc1, gt1, sh2, sc2, gt2 = [m[:, None, :] for m in jnp.split(mod, N_MOD, axis=-1)]
        modc = jax.nn.silu(c_ctx) @ w_mod[l] + b_mod[l]
        csh1, csc1, cgt1, csh2, csc2, cgt2 = jnp.split(modc, N_MOD, axis=-1)
        h = modulate(rms_norm(x, g_pre_mix[l]), sh1, sc1)
        hc = modulate(rms_norm(xc, g_pre_mix[l]), csh1, csc1)
        out, outc = mixer_sublayer(h, hc, w_in[l], ssm_lam_re[l], ssm_lam_im[l], ssm_log_dt[l],
                                   ssm_b_re[l], ssm_b_im[l], ssm_c_re[l], ssm_c_im[l], ssm_d[l],
                                   w_ssm_val[l], w_ssm_glu[l], na_rpb[l], w_na_proj[l], w_out[l],
                                   with_ctx_out)
        x = x + gt1 * rms_norm(out, g_post_mix[l])
        h2 = modulate(rms_norm(x, g_pre_mlp[l]), sh2, sc2)
        x = x + gt2 * rms_norm(sq_relu_mlp(h2, w_fc1[l], w_fc2[l]), g_post_mlp[l])
        if with_ctx_out:
            xc = xc + cgt1 * rms_norm(outc, g_post_mix[l])
            h2c = modulate(rms_norm(xc, g_pre_mlp[l]), csh2, csc2)
            xc = xc + cgt2 * rms_norm(sq_relu_mlp(h2c, w_fc1[l], w_fc2[l]), g_post_mlp[l])
    return x
```

```cpp
#include <hip/hip_runtime.h>
#include <cstdio>
#include <cstdint>
#ifndef MK_PER_PHASE
#define MK_PER_PHASE 0
#endif
namespace pg8 {
#define PG8_LAS __attribute__((address_space(3)))
typedef unsigned short bf16_t;
typedef short bf16x8 __attribute__((ext_vector_type(8)));
typedef float f32x4 __attribute__((ext_vector_type(4)));
typedef unsigned u32x4 __attribute__((ext_vector_type(4)));
constexpr int BM = 256, BK = 64, HALF = 128, HTB = HALF * BK * 2  , STAGE_BYTES = 8 * HTB, NXCD = 8, WGM = 8;

__host__ __device__ __forceinline__ int lds_byte(int r, int c) { const int st = (r >> 4) * 2 + (c >> 5), rr = r & 15, cc = c & 31, ob = rr * 64 + cc * 2; return st * 1024 + (ob ^ (((ob >> 9) & 1) << 5)); }
__host__ __device__ __forceinline__ void stage_rc(int b, int& R, int& C) { const int st = b / 1024, sb = b % 1024, swz = sb ^ (((sb >> 9) & 1) << 5); R = (st >> 1) * 16 + swz / 64; C = (st & 1) * 32 + (swz % 64) / 2; }
__host__ __device__ __forceinline__ int perm32(int rho) { const int n = rho >> 4, i = rho & 15; return 8 * (i >> 2) + 4 * n + (i & 3); }

struct Unit { int pm, pn, nt, ks; };
struct Gemm { const bf16_t* A; const bf16_t* Bt; int M, N, K; };

struct StaticOrder {
    int nM, nN, nwg, G, c;
    __host__ __device__ void init(int M, int N, int G_, int c_) { nM = M / BM; nN = N / BM; nwg = nM * nN; G = G_; c = c_; }
    __host__ __device__ __forceinline__ bool next(int i, Unit& u, int ntdef) const {
        u.nt = ntdef; u.ks = 0; u.pm = 0; u.pn = 0;
        const long L = (long)i * G + c; if (L >= nwg) return false;
        int wgid = (int)L; { const int q = nwg / NXCD, r = nwg % NXCD, xcd = wgid % NXCD, off = wgid / NXCD; wgid = (xcd < r ? xcd * (q + 1) : r * (q + 1) + (xcd - r) * q) + off; }
        const int nig = WGM * nN, gid = wgid / nig, fm = gid * WGM, gsz = (nM - fm) < WGM ? (nM - fm) : WGM;
        u.pm = fm + ((wgid % nig) % gsz); u.pn = (wgid % nig) / gsz; return true;
    }
    __device__ __forceinline__ void a_ready(const Unit&) const {}
    __device__ __forceinline__ void done(const Unit&) const {}
};


__device__ __forceinline__ unsigned cvt_pk_bf16(float lo, float hi) { unsigned r; asm volatile("v_cvt_pk_bf16_f32 %0, %1, %2" : "=v"(r) : "v"(lo), "v"(hi)); return r; }
typedef unsigned u32x2 __attribute__((ext_vector_type(2)));
__device__ __forceinline__ float sigm(float x) { return __builtin_amdgcn_rcpf(1.0f + __builtin_amdgcn_exp2f(-1.4426950408889634f * x)); }
__device__ __forceinline__ float bflo(unsigned w) { return __uint_as_float(w << 16); }
__device__ __forceinline__ float bfhi(unsigned w) { return __uint_as_float(w & 0xffff0000u); }
__device__ __forceinline__ u32x2 pack4(f32x4 v) { u32x2 w; w.x = cvt_pk_bf16(v[0], v[1]); w.y = cvt_pk_bf16(v[2], v[3]); return w; }

constexpr float QSCALE = 0.125f * 1.4426950408889634f;

struct EpiIn {
    static constexpr bool PERM = false, AFTER_DRAIN = false;
    bf16_t *U, *Q, *Kb, *VTl, *VTc, *GS, *GN; const float* rope;
    __device__ __forceinline__ void operator()(const f32x4 (&acc)[2][2][4][2], const Unit& u, int wr, int wc, int fr, int fq) const {
        const int pn = u.pn; const bool lat = u.pm < 32;
        const int row0 = u.pm * BM + wr * 64 + fr;
        if (pn < 4 || pn >= 16) {
            bf16_t* base; int ld, colt; bool sg;
            if (pn < 4) { base = U; ld = 1024; colt = pn * 256; sg = false; }
            else if (pn < 24) { base = GS; ld = 2048; colt = (pn - 16) * 256; sg = true; }
            else { base = GN; ld = 2048; colt = (pn - 24) * 256; sg = true; }
            const int col0 = colt + wc * 32 + 4 * fq;
#pragma unroll
            for (int ai = 0; ai < 2; ++ai)
#pragma unroll
                for (int m = 0; m < 4; ++m) { bf16_t* rowp = base + (size_t)(row0 + ai * HALF + m * 16) * ld + col0;
#pragma unroll
                    for (int bj = 0; bj < 2; ++bj)
#pragma unroll
                        for (int n = 0; n < 2; ++n) { f32x4 v = acc[ai][bj][m][n];
                            if (sg) { v[0] = sigm(v[0]); v[1] = sigm(v[1]); v[2] = sigm(v[2]); v[3] = sigm(v[3]); }
                            *(u32x2*)(rowp + bj * HALF + n * 16) = pack4(v); } }
        } else if (pn < 12) {
            const bool isq = pn < 8; bf16_t* base = isq ? Q : Kb; const int colt = (pn - (isq ? 4 : 8)) * 256;
            const float sc = isq ? QSCALE : 1.0f; const int col0 = colt + wc * 32 + 4 * fq; const int colsel = wc & 1;
#pragma unroll
            for (int ai = 0; ai < 2; ++ai)
#pragma unroll
                for (int m = 0; m < 4; ++m) { const int row = row0 + ai * HALF + m * 16; bf16_t* rowp = base + (size_t)row * 1024 + col0;
                    f32x4 cA = (f32x4){1.f, 0.f, 1.f, 0.f}, cB = cA;
                    if (lat) { const int t = row & 2047, pos = colsel ? (t & 63) : (t >> 6); const f32x4* rp = (const f32x4*)(rope + (pos * 16 + 4 * fq) * 2); cA = rp[0]; cB = rp[1]; }
#pragma unroll
                    for (int bj = 0; bj < 2; ++bj) { const f32x4 x1 = acc[ai][bj][m][0], x2 = acc[ai][bj][m][1]; f32x4 o1, o2;
                        o1[0] = x1[0] * cA[0] - x2[0] * cA[1]; o2[0] = x1[0] * cA[1] + x2[0] * cA[0];
                        o1[1] = x1[1] * cA[2] - x2[1] * cA[3]; o2[1] = x1[1] * cA[3] + x2[1] * cA[2];
                        o1[2] = x1[2] * cB[0] - x2[2] * cB[1]; o2[2] = x1[2] * cB[1] + x2[2] * cB[0];
                        o1[3] = x1[3] * cB[2] - x2[3] * cB[3]; o2[3] = x1[3] * cB[3] + x2[3] * cB[2];
                        o1 = o1 * sc; o2 = o2 * sc;
                        *(u32x2*)(rowp + bj * HALF) = pack4(o1); *(u32x2*)(rowp + bj * HALF + 16) = pack4(o2); } }
        } else {
            const int colt = (pn - 12) * 256;
#pragma unroll
            for (int ai = 0; ai < 2; ++ai)
#pragma unroll
                for (int m = 0; m < 4; ++m) { const int row = row0 + ai * HALF + m * 16;
                    bf16_t* bp; int tstride;
                    if (lat) { const int b = row >> 11, t = row & 2047; bp = VTl + (size_t)b * (16 * 64 * 2048) + t; tstride = 2048; }
                    else { const int rr = row - 8192, b = rr >> 8, l = rr & 255; bp = VTc + (size_t)b * (16 * 64 * 256) + l; tstride = 256; }
#pragma unroll
                    for (int bj = 0; bj < 2; ++bj)
#pragma unroll
                        for (int n = 0; n < 2; ++n) { const int c = colt + bj * HALF + wc * 32 + n * 16 + 4 * fq; const f32x4 v = acc[ai][bj][m][n];
                            const u32x2 w = pack4(v);
                            bp[(size_t)(c + 0) * tstride] = (bf16_t)(w.x & 0xffffu); bp[(size_t)(c + 1) * tstride] = (bf16_t)(w.x >> 16);
                            bp[(size_t)(c + 2) * tstride] = (bf16_t)(w.y & 0xffffu); bp[(size_t)(c + 3) * tstride] = (bf16_t)(w.y >> 16); } }
        }
    }
};
struct EpiD1 {
    static constexpr bool PERM = false, AFTER_DRAIN = false;
    const bf16_t* GS; bf16_t* T1;
    __device__ __forceinline__ void operator()(const f32x4 (&acc)[2][2][4][2], const Unit& u, int wr, int wc, int fr, int fq) const {
        const int row0 = u.pm * BM + wr * 64 + fr, L0 = u.pn * 128 + wc * 16 + 4 * fq;
#pragma unroll
        for (int ai = 0; ai < 2; ++ai)
#pragma unroll
            for (int m = 0; m < 4; ++m) { const size_t off = (size_t)(row0 + ai * HALF + m * 16) * 2048 + L0;
#pragma unroll
                for (int bj = 0; bj < 2; ++bj) { const f32x4 val = acc[ai][bj][m][0], glu = acc[ai][bj][m][1]; const u32x2 g = *(const u32x2*)(GS + off + bj * 64); f32x4 t;
                    t[0] = bflo(g.x) * val[0] * sigm(glu[0]); t[1] = bfhi(g.x) * val[1] * sigm(glu[1]); t[2] = bflo(g.y) * val[2] * sigm(glu[2]); t[3] = bfhi(g.y) * val[3] * sigm(glu[3]);
                    *(u32x2*)(T1 + off + bj * 64) = pack4(t); } }
    }
};
struct EpiD2 {
    static constexpr bool PERM = true, AFTER_DRAIN = false;
    const bf16_t* GN; bf16_t* TM;
    __device__ __forceinline__ void operator()(const f32x4 (&acc)[2][2][4][2], const Unit& u, int wr, int wc, int fr, int fq) const {
        const int row0 = u.pm * BM + wr * 64 + fr, col0 = u.pn * BM + wc * 32 + 8 * fq;
#pragma unroll
        for (int ai = 0; ai < 2; ++ai)
#pragma unroll
            for (int m = 0; m < 4; ++m) { const size_t off = (size_t)(row0 + ai * HALF + m * 16) * 2048 + col0;
#pragma unroll
                for (int bj = 0; bj < 2; ++bj) { const f32x4 v0 = acc[ai][bj][m][0], v1 = acc[ai][bj][m][1];
                    const u32x4 t = *(const u32x4*)(TM + off + bj * HALF), g = *(const u32x4*)(GN + off + bj * HALF); u32x4 w;
                    w.x = cvt_pk_bf16(bflo(t.x) + bflo(g.x) * v0[0], bfhi(t.x) + bfhi(g.x) * v0[1]); w.y = cvt_pk_bf16(bflo(t.y) + bflo(g.y) * v0[2], bfhi(t.y) + bfhi(g.y) * v0[3]);
                    w.z = cvt_pk_bf16(bflo(t.z) + bflo(g.z) * v1[0], bfhi(t.z) + bfhi(g.z) * v1[1]); w.w = cvt_pk_bf16(bflo(t.w) + bflo(g.w) * v1[2], bfhi(t.w) + bfhi(g.w) * v1[3]);
                    *(u32x4*)(TM + off + bj * HALF) = w; } }
    }
};
struct EpiF32 {
    static constexpr bool PERM = false, AFTER_DRAIN = false;
    float* O; int ldc;
    __device__ __forceinline__ void operator()(const f32x4 (&acc)[2][2][4][2], const Unit& u, int wr, int wc, int fr, int fq) const {
        const int row0 = u.pm * BM + wr * 64 + fr, col0 = u.pn * BM + wc * 32 + 4 * fq;
#pragma unroll
        for (int ai = 0; ai < 2; ++ai)
#pragma unroll
            for (int m = 0; m < 4; ++m) { float* rowp = O + (size_t)(row0 + ai * HALF + m * 16) * ldc + col0;
#pragma unroll
                for (int bj = 0; bj < 2; ++bj)
#pragma unroll
                    for (int n = 0; n < 2; ++n) *(f32x4*)(rowp + bj * HALF + n * 16) = acc[ai][bj][m][n]; }
    }
};
struct EpiF32S {
    static constexpr bool PERM = true, AFTER_DRAIN = false;
    bf16_t* O; bf16_t* SL;
    __device__ __forceinline__ void operator()(const f32x4 (&acc)[2][2][4][2], const Unit& u, int wr, int wc, int fr, int fq) const {
        const int row0 = u.pm * BM + wr * 64 + fr, col0 = u.pn * BM + wc * 32 + 8 * fq;
        if (u.pm < 32) {
#pragma unroll
            for (int ai = 0; ai < 2; ++ai)
#pragma unroll
                for (int m = 0; m < 4; ++m) { bf16_t* rowp = O + (size_t)(row0 + ai * HALF + m * 16) * 2048 + col0;
#pragma unroll
                    for (int bj = 0; bj < 2; ++bj) { const f32x4 v0 = acc[ai][bj][m][0], v1 = acc[ai][bj][m][1];
                        u32x4 w; w.x = cvt_pk_bf16(v0[0], v0[1]); w.y = cvt_pk_bf16(v0[2], v0[3]); w.z = cvt_pk_bf16(v1[0], v1[1]); w.w = cvt_pk_bf16(v1[2], v1[3]);
                        *(u32x4*)(rowp + bj * HALF) = w; } }
        } else {
            bf16_t* base = SL + ((size_t)u.ks * 1024 + (row0 - 8192)) * 2048;
#pragma unroll
            for (int ai = 0; ai < 2; ++ai)
#pragma unroll
                for (int m = 0; m < 4; ++m) { bf16_t* rowp = base + (size_t)(ai * HALF + m * 16) * 2048 + col0;
#pragma unroll
                    for (int bj = 0; bj < 2; ++bj) { const f32x4 v0 = acc[ai][bj][m][0], v1 = acc[ai][bj][m][1];
                        u32x4 w; w.x = cvt_pk_bf16(v0[0], v0[1]); w.y = cvt_pk_bf16(v0[2], v0[3]); w.z = cvt_pk_bf16(v1[0], v1[1]); w.w = cvt_pk_bf16(v1[2], v1[3]);
                        *(u32x4*)(rowp + bj * HALF) = w; } }
        }
    }
};
struct OrderSplitCtx : StaticOrder {
    int ksl, nctx;
    __device__ __forceinline__ bool next(int i, Unit& u, int ntdef) const {
        if (StaticOrder::next(i, u, ntdef)) return true;
        const long L = (long)i * G + c - nwg; if (L >= nctx) return false;
        const int unit = (int)L >> 3; u.pm = 32 + (unit & 3); u.pn = unit >> 2; u.ks = (int)L & 7; u.nt = ksl; return true;
    }
};
struct EpiRelu2 {
    static constexpr bool PERM = true, AFTER_DRAIN = false;
    bf16_t* O; int ldc;
    __device__ __forceinline__ void operator()(const f32x4 (&acc)[2][2][4][2], const Unit& u, int wr, int wc, int fr, int fq) const {
        const int row0 = u.pm * BM + wr * 64 + fr, col0 = u.pn * BM + wc * 32 + 8 * fq;
#pragma unroll
        for (int ai = 0; ai < 2; ++ai)
#pragma unroll
            for (int m = 0; m < 4; ++m) { bf16_t* rowp = O + (size_t)(row0 + ai * HALF + m * 16) * ldc + col0;
#pragma unroll
                for (int bj = 0; bj < 2; ++bj) { f32x4 v0 = acc[ai][bj][m][0], v1 = acc[ai][bj][m][1];
                    v0 = __builtin_elementwise_max(v0, (f32x4){0.f, 0.f, 0.f, 0.f}); v1 = __builtin_elementwise_max(v1, (f32x4){0.f, 0.f, 0.f, 0.f}); v0 = v0 * v0; v1 = v1 * v1;
                    u32x4 w; w.x = cvt_pk_bf16(v0[0], v0[1]); w.y = cvt_pk_bf16(v0[2], v0[3]); w.z = cvt_pk_bf16(v1[0], v1[1]); w.w = cvt_pk_bf16(v1[2], v1[3]);
                    *(u32x4*)(rowp + bj * HALF) = w; } }
    }
};
struct OrderL1In : StaticOrder {
    __device__ __forceinline__ bool next(int i, Unit& u, int ntdef) const {
        if (StaticOrder::next(i, u, ntdef)) return true;
        const long L = (long)i * G + c - nwg; if (L >= 48) return false;
        const int k = (int)L >> 2; u.pm = 32 + ((int)L & 3); u.pn = k < 4 ? k : k + 4; return true;
    }
};

template <class Epi, class Sched, bool ALIGN_EPI = false, bool SP2 = false>
__device__ __forceinline__ void gemm_phase(PG8_LAS unsigned char* lds, const Gemm g, const Sched& S, const Epi& E) {
    int tid_o = threadIdx.x; asm volatile("" : "+v"(tid_o));
    const int tid = tid_o, wid = __builtin_amdgcn_readfirstlane(tid >> 6), lane = tid & 63, wr = wid >> 2, wc = wid & 3, fr = lane & 15, fq = lane >> 4;
    const int K = g.K, nt = K / BK;
    unsigned voffA[2], voffB[2];
#pragma unroll
    for (int i = 0; i < 2; ++i) { int R, C; stage_rc(tid * 16 + i * 8192, R, C); const int Rb = Epi::PERM ? ((R & ~31) + perm32(R & 31)) : R;
        voffA[i] = (unsigned)(R * K + C) * 2u; voffB[i] = (unsigned)(Rb * K + C) * 2u; }
    const size_t kstep = (size_t)(BK * 2);
    const size_t hstep = (size_t)HALF * K * 2;
    const size_t tstep = 2 * hstep;
    const unsigned ldsw = (unsigned)wid * 1024u;
    const int aoff = lds_byte(wr * 64 + fr, fq * 8), boff = lds_byte(wc * 32 + fr, fq * 8);
#define PG8_SA(b, h) (((b) * 2 + (h)) * HTB)
#define PG8_SB(b, h) ((4 + (b) * 2 + (h)) * HTB)
#define PG8_STAGE(bufoff, gbase, voff) do { _Pragma("unroll") for (int _i = 0; _i < 2; ++_i) \
        __builtin_amdgcn_global_load_lds((const unsigned*)((const char*)(gbase) + (voff)[_i]), (PG8_LAS unsigned*)(lds + (bufoff) + ldsw + _i * 8192), 16, 0, 0); } while (0)
#define PG8_LDA(dst, b, h) do { _Pragma("unroll") for (int m = 0; m < 4; ++m) _Pragma("unroll") for (int k = 0; k < 2; ++k) dst[m][k] = *(const PG8_LAS bf16x8*)(lds + PG8_SA(b, h) + aoff + m * 2048 + k * 1024); } while (0)
#define PG8_LDB(dst, b, h) do { _Pragma("unroll") for (int n = 0; n < 2; ++n) _Pragma("unroll") for (int k = 0; k < 2; ++k) dst[n][k] = *(const PG8_LAS bf16x8*)(lds + PG8_SB(b, h) + boff + n * 2048 + k * 1024); } while (0)
#define PG8_MMA(ai, bj, At, Bt) do { __builtin_amdgcn_s_setprio(1); _Pragma("unroll") for (int m = 0; m < 4; ++m) _Pragma("unroll") for (int n = 0; n < 2; ++n) _Pragma("unroll") for (int k = 0; k < 2; ++k) \
        acc[ai][bj][m][n] = __builtin_amdgcn_mfma_f32_16x16x32_bf16(Bt[n][k], At[m][k], acc[ai][bj][m][n], 0, 0, 0); __builtin_amdgcn_s_setprio(0); } while (0)
#define PG8_WAIT_V(n) asm volatile("s_waitcnt vmcnt(" #n ")" ::: "memory")
#define PG8_WAIT_L(n) asm volatile("s_waitcnt lgkmcnt(" #n ")" ::: "memory")
#define PG8_BAR __builtin_amdgcn_s_barrier()
#define PG8_SCHED __builtin_amdgcn_sched_barrier(0)
    Unit cur, nxt; int ui = 0;
    if (!S.next(0, cur, nt)) return;
    f32x4 acc[2][2][4][2];
#pragma unroll
    for (int a = 0; a < 2; ++a)
#pragma unroll
        for (int b = 0; b < 2; ++b)
#pragma unroll
            for (int m = 0; m < 4; ++m)
#pragma unroll
                for (int n = 0; n < 2; ++n) acc[a][b][m][n] = (f32x4){0.f, 0.f, 0.f, 0.f};
    bf16x8 At[4][2], B0[2][2], B1[2][2];
    const char* cA = (const char*)g.A + (size_t)cur.pm * tstep + (size_t)(cur.ks * cur.nt) * (BK * 2); const char* cB = (const char*)g.Bt + (size_t)cur.pn * tstep + (size_t)(cur.ks * cur.nt) * (BK * 2);
    S.a_ready(cur);
    if constexpr (SP2) {
        PG8_STAGE(PG8_SB(0, 0), cB, voffB); PG8_STAGE(PG8_SB(0, 1), cB + hstep, voffB); PG8_STAGE(PG8_SA(0, 0), cA, voffA); PG8_STAGE(PG8_SA(0, 1), cA + hstep, voffA);
        if (wr == 1) PG8_BAR;
        PG8_WAIT_V(2); PG8_BAR;
        PG8_STAGE(PG8_SB(1, 0), cB + kstep, voffB); PG8_STAGE(PG8_SA(1, 0), cA + kstep, voffA); PG8_STAGE(PG8_SB(1, 1), cB + hstep + kstep, voffB);
        PG8_WAIT_V(6); PG8_BAR;
    } else {
        PG8_STAGE(PG8_SB(0, 0), cB, voffB); PG8_STAGE(PG8_SA(0, 0), cA, voffA); PG8_STAGE(PG8_SB(0, 1), cB + hstep, voffB); PG8_STAGE(PG8_SA(0, 1), cA + hstep, voffA);
        if (wr == 1) PG8_BAR;
        PG8_WAIT_V(4); PG8_BAR;
        PG8_STAGE(PG8_SB(1, 0), cB + kstep, voffB); PG8_STAGE(PG8_SA(1, 0), cA + kstep, voffA); PG8_STAGE(PG8_SB(1, 1), cB + hstep + kstep, voffB);
        PG8_WAIT_V(6); PG8_BAR;
    }
    for (;;) {
        const bool has_next = S.next(ui + 1, nxt, nt);
        const int ntu = cur.nt;
        const char* nA = has_next ? (const char*)g.A + (size_t)nxt.pm * tstep + (size_t)(nxt.ks * nxt.nt) * (BK * 2) : cA; const char* nB = has_next ? (const char*)g.Bt + (size_t)nxt.pn * tstep + (size_t)(nxt.ks * nxt.nt) * (BK * 2) : cB;
        for (int t = 0; t < ntu; t += 2) {
            const bool last = (t == ntu - 2);
            const char* a1 = cA + (size_t)(t + 1) * kstep;
            const char* a2 = last ? nA : cA + (size_t)(t + 2) * kstep; const char* b2 = last ? nB : cB + (size_t)(t + 2) * kstep;
            const char* a3 = a2 + kstep; const char* b3 = b2 + kstep;
            if (last && has_next) S.a_ready(nxt);
            if constexpr (SP2) {
            PG8_LDB(B0, 0, 0); PG8_LDB(B1, 0, 1); PG8_SCHED; PG8_LDA(At, 0, 0); PG8_STAGE(PG8_SA(1, 1), a1 + hstep, voffA);
            PG8_WAIT_V(8); PG8_WAIT_L(0); PG8_BAR; PG8_MMA(0, 0, At, B0); PG8_MMA(0, 1, At, B1); PG8_BAR; PG8_SCHED;
            PG8_LDA(At, 0, 1); PG8_STAGE(PG8_SB(0, 0), b2, voffB); PG8_STAGE(PG8_SB(0, 1), b2 + hstep, voffB); PG8_STAGE(PG8_SA(0, 0), a2, voffA);
            PG8_WAIT_V(8); PG8_WAIT_L(0); PG8_BAR; PG8_MMA(1, 0, At, B0); PG8_MMA(1, 1, At, B1); PG8_BAR; PG8_SCHED;
            PG8_LDB(B0, 1, 0); PG8_LDB(B1, 1, 1); PG8_SCHED; PG8_LDA(At, 1, 0); PG8_STAGE(PG8_SA(0, 1), a2 + hstep, voffA);
            PG8_WAIT_V(8); PG8_WAIT_L(0); PG8_BAR; PG8_MMA(0, 0, At, B0); PG8_MMA(0, 1, At, B1); PG8_BAR; PG8_SCHED;
            PG8_LDA(At, 1, 1); PG8_STAGE(PG8_SB(1, 0), b3, voffB); PG8_STAGE(PG8_SB(1, 1), b3 + hstep, voffB); PG8_STAGE(PG8_SA(1, 0), a3, voffA);
            PG8_WAIT_V(8); PG8_WAIT_L(0); PG8_BAR; PG8_MMA(1, 0, At, B0); PG8_MMA(1, 1, At, B1); PG8_BAR; PG8_SCHED;
            } else {
            PG8_LDB(B0, 0, 0); PG8_SCHED; PG8_LDA(At, 0, 0); PG8_STAGE(PG8_SA(1, 1), a1 + hstep, voffA);
            PG8_WAIT_L(8); PG8_BAR; PG8_WAIT_L(0); PG8_MMA(0, 0, At, B0); PG8_BAR; PG8_SCHED;
            PG8_LDB(B1, 0, 1); PG8_STAGE(PG8_SB(0, 0), b2, voffB);
            PG8_BAR; PG8_WAIT_L(0); PG8_MMA(0, 1, At, B1); PG8_BAR;
            PG8_LDA(At, 0, 1); PG8_STAGE(PG8_SA(0, 0), a2, voffA);
            PG8_BAR; PG8_WAIT_L(0); PG8_MMA(1, 0, At, B0); PG8_BAR; PG8_SCHED;
            PG8_STAGE(PG8_SB(0, 1), b2 + hstep, voffB);
            PG8_WAIT_V(6); PG8_BAR; PG8_MMA(1, 1, At, B1); PG8_BAR;
            PG8_LDB(B0, 1, 0); PG8_SCHED; PG8_LDA(At, 1, 0); PG8_STAGE(PG8_SA(0, 1), a2 + hstep, voffA);
            PG8_WAIT_L(8); PG8_BAR; PG8_WAIT_L(0); PG8_MMA(0, 0, At, B0); PG8_BAR; PG8_SCHED;
            PG8_LDB(B1, 1, 1); PG8_STAGE(PG8_SB(1, 0), b3, voffB);
            PG8_BAR; PG8_WAIT_L(0); PG8_MMA(0, 1, At, B1); PG8_BAR;
            PG8_LDA(At, 1, 1); PG8_STAGE(PG8_SA(1, 0), a3, voffA);
            PG8_BAR; PG8_WAIT_L(0); PG8_MMA(1, 0, At, B0); PG8_BAR; PG8_SCHED;
            PG8_STAGE(PG8_SB(1, 1), b3 + hstep, voffB);
            PG8_WAIT_V(6); PG8_BAR; PG8_MMA(1, 1, At, B1); PG8_BAR;
            }
        }
        if constexpr (ALIGN_EPI) { if (wr == 0) PG8_BAR; }
        if constexpr (!Epi::AFTER_DRAIN) { E(acc, cur, wr, wc, fr, fq); S.done(cur); }
        if (!has_next) break;
#pragma unroll
        for (int a = 0; a < 2; ++a)
#pragma unroll
            for (int b = 0; b < 2; ++b)
#pragma unroll
                for (int m = 0; m < 4; ++m)
#pragma unroll
                    for (int n = 0; n < 2; ++n) acc[a][b][m][n] = (f32x4){0.f, 0.f, 0.f, 0.f};
        cur = nxt; cA = nA; cB = nB; ++ui;
        if constexpr (ALIGN_EPI) { if (wr == 1) PG8_BAR; }
    }
    PG8_WAIT_V(0);
    if constexpr (!ALIGN_EPI) { if (wr == 0) PG8_BAR; }
    PG8_BAR;
    if constexpr (Epi::AFTER_DRAIN) { E.fused(acc, cur, wr, wc, fr, fq, lds, wid, lane); S.done(cur); }
#undef PG8_SA
#undef PG8_SB
#undef PG8_STAGE
#undef PG8_LDA
#undef PG8_LDB
#undef PG8_MMA
#undef PG8_WAIT_V
#undef PG8_WAIT_L
#undef PG8_BAR
#undef PG8_SCHED
}
}

constexpr int NWAVES = 8;
constexpr int DM = 2048, NB = 4, SEQ = 2048, CTX = 256, DEPTH = 2, NHEAD = 16, HD = 64, GRIDW = 64, NMOD = 6;
constexpr int RL = NB * SEQ, RC = NB * CTX, RT = RL + RC;
constexpr int SSMW = 1024, NAW = 1024, PW = 8192, DFF = 8192, SG = 64, SP = 64, SC = 16;
constexpr float NORM_EPS = 1e-6f;
constexpr float LOG2E = 1.4426950408889634f;

constexpr size_t MiB = 1u << 20;
constexpr size_t WS_CTL = 0, CTL_ZERO_BYTES = 1 * MiB;
constexpr size_t WS_MOD = 1 * MiB;
constexpr size_t WS_ROPE = 1 * MiB + 512 * 1024;
constexpr size_t WS_W = 2 * MiB, W_LAYER = 116 * MiB;
constexpr size_t WO_IN = 0, WO_VG = 32 * MiB, WO_NA = 40 * MiB, WO_OUT = 44 * MiB, WO_FC1 = 52 * MiB, WO_FC2 = 84 * MiB;
constexpr size_t WS_XA = 234 * MiB;
constexpr size_t WS_H = 306 * MiB;
constexpr size_t WS_PROJ = 342 * MiB;
constexpr size_t PO_U = 0, PO_Q = 18 * MiB, PO_K = 36 * MiB, PO_VTL = 54 * MiB, PO_VTC = 70 * MiB, PO_GS = 72 * MiB, PO_GN = 108 * MiB;
constexpr size_t WS_ACT = 486 * MiB;
constexpr size_t WS_ATT = 504 * MiB;
constexpr size_t WS_TM = 522 * MiB;
constexpr size_t WS_OUT = 558 * MiB;
constexpr size_t WS_SLAB = 630 * MiB;
constexpr size_t WS_END = 694 * MiB;
constexpr int CW_BAR = 4096;

constexpr int RING_BYTES = 131072, MISC_OFF = RING_BYTES + 320, LDS_BYTES = 147456;
constexpr int SCAN_LDS = 17408;
#define GAS __attribute__((address_space(1)))
#define LAS __attribute__((address_space(3)))
typedef unsigned short bf16;
typedef unsigned v4u __attribute__((ext_vector_type(4)));
typedef unsigned v2u __attribute__((ext_vector_type(2)));
typedef float f32x4 __attribute__((ext_vector_type(4)));
typedef float f32x16 __attribute__((ext_vector_type(16)));
typedef short bf16x8 __attribute__((ext_vector_type(8)));
typedef GAS unsigned gu32;
#define RLX_AGENT __ATOMIC_RELAXED, __HIP_MEMORY_SCOPE_AGENT
#define LDS_WAIT() asm volatile("s_waitcnt lgkmcnt(0)" ::: "memory")
#define VM_WAIT() asm volatile("s_waitcnt vmcnt(0)" ::: "memory")
__device__ __forceinline__ unsigned f2bf(float f) { unsigned u = __builtin_bit_cast(unsigned, f); return (u + 0x7fffu + ((u >> 16) & 1u)) >> 16; }
__device__ __forceinline__ unsigned pk2(float lo, float hi) { return f2bf(lo) | (f2bf(hi) << 16); }
__device__ __forceinline__ float bf2f(bf16 v) { return __uint_as_float((unsigned)v << 16); }
__device__ __forceinline__ float wave_sum(float v) {
#pragma unroll
    for (int o = 1; o < 64; o <<= 1) v += __shfl_xor(v, o);
    return v;
}
#define XB_TMO      128
#define XB_XCNT(j)  (256  + 64 * (j))
#define XB_XSUB(j)  (1280 + 64 * (j))
#define XB_XGEN(j)  (2304 + 64 * (j))
#define XB_TOP      3328
#define XB_TOPGEN   3392
#define XCD_BAR_WORDS 3456
#define XB_SPIN_CAP (1u << 18)

__device__ __forceinline__ unsigned xb_ld(unsigned* p)              { return __hip_atomic_load(p, __ATOMIC_RELAXED, __HIP_MEMORY_SCOPE_AGENT); }
__device__ __forceinline__ unsigned xb_add(unsigned* p, unsigned v) { return __hip_atomic_fetch_add(p, v, __ATOMIC_RELAXED, __HIP_MEMORY_SCOPE_AGENT); }
__device__ __forceinline__ unsigned xb_xcc_id() { return (unsigned)__builtin_amdgcn_s_getreg((3 << 11) | 20) & 0xFu; }
#define XB_SPIN(cond, bar) do { unsigned _sp = 0; while (cond) { __builtin_amdgcn_s_sleep(1); \
    if ((++_sp & 255u) == 0u) { if (xb_ld(&(bar)[XB_TMO])) break; if (_sp > XB_SPIN_CAP) { atomicAdd(&(bar)[XB_TMO], 1u); break; } } } } while (0)

struct XcdBarrier {
    unsigned* bar; unsigned x;
    volatile LAS unsigned* st;
};

__device__ __forceinline__ XcdBarrier xcd_barrier_post(unsigned* bar, volatile LAS unsigned* st) {
    XcdBarrier b; b.bar = bar; b.x = xb_xcc_id(); b.st = st;
    if (threadIdx.x == 0) (void)xb_add(&bar[XB_XCNT(b.x)], 1u);
    return b;
}
__device__ __forceinline__ void xcd_barrier_complete(unsigned* bar, unsigned x, unsigned& nloc, unsigned& nx) {
    const unsigned G = gridDim.x * gridDim.y * gridDim.z;
    unsigned sum, cnt, mine, sp = 0u;
    for (;;) {
        sum = 0u; cnt = 0u; mine = 0u;
#pragma unroll
        for (unsigned j = 0; j < 16; ++j) { const unsigned c = xb_ld(&bar[XB_XCNT(j)]); sum += c; cnt += (c > 0u) ? 1u : 0u; mine = (j == x) ? c : mine; }
        if (sum == G) break;
        __builtin_amdgcn_s_sleep(1);
        if ((++sp & 255u) == 0u) { if (xb_ld(&bar[XB_TMO])) break; if (sp > XB_SPIN_CAP) { atomicAdd(&bar[XB_TMO], 1u); break; } }
    }
    nloc = mine > 0u ? mine : 1u; nx = cnt > 0u ? cnt : 1u;
}

__device__ __forceinline__ void xcd_barrier(const XcdBarrier& b) {
    asm volatile("s_waitcnt vmcnt(0)" ::: "memory");
    __syncthreads();
    if (threadIdx.x == 0) {
        unsigned* bar = b.bar;
        __builtin_amdgcn_s_waitcnt(0);
        unsigned nloc = b.st[0], nx = b.st[1];
        if (nloc == 0u) { xcd_barrier_complete(bar, b.x, nloc, nx); b.st[0] = nloc; b.st[1] = nx; }
        const unsigned old = xb_add(&bar[XB_XSUB(b.x)], 1u);
        const unsigned gen = old / nloc;
        if (old + 1u == (gen + 1u) * nloc) {
            __builtin_amdgcn_fence(__ATOMIC_RELEASE, "agent");
            asm volatile("s_waitcnt vmcnt(0)" ::: "memory");
            const unsigned og = xb_add(&bar[XB_TOP], 1u);
            const unsigned tg = og / nx;
            if (og + 1u == (tg + 1u) * nx) xb_add(&bar[XB_TOPGEN], 1u);
            else XB_SPIN(xb_ld(&bar[XB_TOPGEN]) == tg, bar);
            __builtin_amdgcn_fence(__ATOMIC_ACQUIRE, "agent");
            xb_add(&bar[XB_XGEN(b.x)], 1u);
            asm volatile("s_waitcnt vmcnt(0)" ::: "memory");
        } else {
            XB_SPIN(xb_ld(&bar[XB_XGEN(b.x)]) == gen, bar);
            __builtin_amdgcn_fence(__ATOMIC_ACQUIRE, "agent");
            asm volatile("s_waitcnt vmcnt(0)" ::: "memory");
        }
    }
    __syncthreads();
}

__device__ __forceinline__ void p0_transpose_item(const float* W, int K, int N, bf16* WT, int mode, LAS float* scr, int item, int lane) {
    const int nblk = N / 32, kb = item / nblk, nb = item % nblk, k0 = 64 * kb, n0 = 32 * nb;
    float wv[32];
    const float* wp = W + (size_t)(k0 + (lane >> 5)) * N + n0 + (lane & 31);
#pragma unroll
    for (int i = 0; i < 32; ++i) wv[i] = wp[(size_t)(2 * i) * N];
#pragma unroll
    for (int i = 0; i < 32; ++i) scr[(2 * i + (lane >> 5)) * 33 + (lane & 31)] = wv[i];
    LDS_WAIT(); asm volatile("" ::: "memory");
    const int c = lane & 7;
#pragma unroll
    for (int j = 0; j < 4; ++j) { const int n = (lane >> 3) + 8 * j; const LAS float* s = scr + (8 * c) * 33 + n;
        v4u o; o.x = pk2(s[0 * 33], s[1 * 33]); o.y = pk2(s[2 * 33], s[3 * 33]); o.z = pk2(s[4 * 33], s[5 * 33]); o.w = pk2(s[6 * 33], s[7 * 33]);
        const int ng = n0 + n; const int drow = mode == 0 ? ng : (32 * (ng >> 4) + (ng & 15) + (mode == 2 ? 16 : 0));
        *(GAS v4u*)(WT + (size_t)drow * K + k0 + 8 * c) = o; }
    LDS_WAIT(); asm volatile("" ::: "memory");
}

template <bool HASY, int XOUT, bool HOUT>
__device__ __forceinline__ void rowpass_pipe(int lane, int first, int step, int M, const void* xin, bool xbf, const bf16* yin, void* xout, bf16* hout,
                                             const float* modg, const float* modh, int kss, int ksh, int mr_fixed) {
    int m = first; if (m >= M) return;
    f32x4 xr_[8]; v2u yc[8];
#pragma unroll
    for (int j = 0; j < 8; ++j) { xr_[j] = (f32x4){0.f, 0.f, 0.f, 0.f}; yc[j] = (v2u){0u, 0u}; }
    if (xbf) { const GAS v2u* xb = (const GAS v2u*)((const bf16*)xin + (size_t)m * DM) + lane;
#pragma unroll
        for (int j = 0; j < 8; ++j) { const v2u t = xb[64 * j]; xr_[j].x = __uint_as_float(t.x); xr_[j].y = __uint_as_float(t.y); } }
    else { const GAS f32x4* xr = (const GAS f32x4*)((const float*)xin + (size_t)m * DM) + lane;
#pragma unroll
        for (int j = 0; j < 8; ++j) xr_[j] = xr[64 * j]; }
    if (HASY) { const GAS v2u* yb = (const GAS v2u*)(yin + (size_t)m * DM) + lane;
#pragma unroll
        for (int j = 0; j < 8; ++j) yc[j] = yb[64 * j]; }
    for (;;) {
        const int mn = m + step; const bool hn = mn < M;
        const int mr = mr_fixed >= 0 ? mr_fixed : (m >> 11);
        f32x4 gg[8], sv[8], hv[8];
        if (HASY) { const GAS f32x4* p = (const GAS f32x4*)(modg + (size_t)mr * (NMOD * DM)) + lane;
#pragma unroll
            for (int j = 0; j < 8; ++j) gg[j] = p[64 * j]; }
        f32x4 xn[8]; v2u yn[8];
#pragma unroll
        for (int j = 0; j < 8; ++j) { xn[j] = xr_[j]; yn[j] = yc[j]; }
        if (hn) {
            if (xbf) { const GAS v2u* xb = (const GAS v2u*)((const bf16*)xin + (size_t)mn * DM) + lane;
#pragma unroll
                for (int j = 0; j < 8; ++j) { const v2u t = xb[64 * j]; xn[j].x = __uint_as_float(t.x); xn[j].y = __uint_as_float(t.y); } }
            else { const GAS f32x4* xr = (const GAS f32x4*)((const float*)xin + (size_t)mn * DM) + lane;
#pragma unroll
                for (int j = 0; j < 8; ++j) xn[j] = xr[64 * j]; }
            if (HASY) { const GAS v2u* yb = (const GAS v2u*)(yin + (size_t)mn * DM) + lane;
#pragma unroll
                for (int j = 0; j < 8; ++j) yn[j] = yb[64 * j]; } }
        f32x4 xc[8];
#pragma unroll
        for (int j = 0; j < 8; ++j) { const unsigned w0 = __float_as_uint(xr_[j].x), w1 = __float_as_uint(xr_[j].y);
            xc[j] = xbf ? (f32x4){pg8::bflo(w0), pg8::bfhi(w0), pg8::bflo(w1), pg8::bfhi(w1)} : xr_[j]; }
        if (HASY) { f32x4 yv[8]; float ss = 0.f;
#pragma unroll
            for (int j = 0; j < 8; ++j) { yv[j] = (f32x4){pg8::bflo(yc[j].x), pg8::bfhi(yc[j].x), pg8::bflo(yc[j].y), pg8::bfhi(yc[j].y)};
                ss += (yv[j].x * yv[j].x + yv[j].y * yv[j].y) + (yv[j].z * yv[j].z + yv[j].w * yv[j].w); }
            const float r = 1.0f / sqrtf(wave_sum(ss) * (1.0f / DM) + NORM_EPS);
#pragma unroll
            for (int j = 0; j < 8; ++j) xc[j] = xc[j] + gg[j] * (yv[j] * r); }
        if (XOUT == 1) { GAS f32x4* xo = (GAS f32x4*)((float*)xout + (size_t)m * DM) + lane;
#pragma unroll
            for (int j = 0; j < 8; ++j) xo[64 * j] = xc[j]; }
        if (XOUT == 2) { GAS v2u* xo = (GAS v2u*)((bf16*)xout + (size_t)m * DM) + lane;
#pragma unroll
            for (int j = 0; j < 8; ++j) { v2u w; w.x = pg8::cvt_pk_bf16(xc[j].x, xc[j].y); w.y = pg8::cvt_pk_bf16(xc[j].z, xc[j].w); xo[64 * j] = w; } }
        if (HOUT) { float ss = 0.f;
            if (HASY) __builtin_amdgcn_sched_barrier(0);
            { const GAS f32x4* p = (const GAS f32x4*)(modh + (size_t)mr * (NMOD * DM) + kss * DM) + lane; const GAS f32x4* q = (const GAS f32x4*)(modh + (size_t)mr * (NMOD * DM) + ksh * DM) + lane;
#pragma unroll
              for (int j = 0; j < 8; ++j) { sv[j] = p[64 * j]; hv[j] = q[64 * j]; } }
#pragma unroll
            for (int j = 0; j < 8; ++j) ss += (xc[j].x * xc[j].x + xc[j].y * xc[j].y) + (xc[j].z * xc[j].z + xc[j].w * xc[j].w);
            const float r = 1.0f / sqrtf(wave_sum(ss) * (1.0f / DM) + NORM_EPS);
            GAS v2u* ho = (GAS v2u*)(hout + (size_t)m * DM) + lane;
#pragma unroll
            for (int j = 0; j < 8; ++j) { const f32x4 h = (xc[j] * r) * sv[j] + hv[j];
                v2u w; w.x = pg8::cvt_pk_bf16(h.x, h.y); w.y = pg8::cvt_pk_bf16(h.z, h.w); ho[64 * j] = w; } }
        if (!hn) break;
#pragma unroll
        for (int j = 0; j < 8; ++j) { xr_[j] = xn[j]; yc[j] = yn[j]; }
        m = mn;
    }
}
__device__ __forceinline__ void rowpass_ctx8(LAS float* red, int lane, int wave, int vcu, int G, const void* xin, bool xbf, const bf16* slab, bf16* xout, bf16* hout,
                                             const float* gg, const float* sv, const float* hv) {
    for (int base = vcu * 4; base < RC; base += G * 4) {
        const int row = base + (wave >> 1); const size_t off = (size_t)row * DM + (wave & 1) * 1024; const int co = (wave & 1) * 1024;
        f32x4 xv[4], yv[4];
        v2u yb[8][4];
#pragma unroll
        for (int sl = 0; sl < 8; ++sl) { const GAS v2u* ys = (const GAS v2u*)(slab + (size_t)sl * RC * DM + off) + lane;
#pragma unroll
            for (int j = 0; j < 4; ++j) yb[sl][j] = ys[64 * j]; }
        if (xbf) { const GAS v2u* xb = (const GAS v2u*)((const bf16*)xin + off) + lane;
#pragma unroll
            for (int j = 0; j < 4; ++j) { const v2u t = xb[64 * j]; xv[j] = (f32x4){pg8::bflo(t.x), pg8::bfhi(t.x), pg8::bflo(t.y), pg8::bfhi(t.y)}; } }
        else { const GAS f32x4* xr = (const GAS f32x4*)((const float*)xin + off) + lane;
#pragma unroll
            for (int j = 0; j < 4; ++j) xv[j] = xr[64 * j]; }
#pragma unroll
        for (int j = 0; j < 4; ++j) { yv[j] = (f32x4){0.f, 0.f, 0.f, 0.f};
#pragma unroll
            for (int sl = 0; sl < 8; ++sl) yv[j] = yv[j] + (f32x4){pg8::bflo(yb[sl][j].x), pg8::bfhi(yb[sl][j].x), pg8::bflo(yb[sl][j].y), pg8::bfhi(yb[sl][j].y)}; }
        float ss = 0.f;
#pragma unroll
        for (int j = 0; j < 4; ++j) ss += (yv[j].x * yv[j].x + yv[j].y * yv[j].y) + (yv[j].z * yv[j].z + yv[j].w * yv[j].w);
        ss = wave_sum(ss); if (lane == 0) red[wave] = ss;
        LDS_WAIT(); __syncthreads();
        float r = 1.0f / sqrtf((red[wave] + red[wave ^ 1]) * (1.0f / DM) + NORM_EPS);
        const GAS f32x4* gp = (const GAS f32x4*)(gg + co) + lane;
#pragma unroll
        for (int j = 0; j < 4; ++j) xv[j] = xv[j] + gp[64 * j] * (yv[j] * r);
        GAS v2u* xo = (GAS v2u*)(xout + off) + lane;
#pragma unroll
        for (int j = 0; j < 4; ++j) { v2u w; w.x = pg8::cvt_pk_bf16(xv[j].x, xv[j].y); w.y = pg8::cvt_pk_bf16(xv[j].z, xv[j].w); xo[64 * j] = w; }
        ss = 0.f;
#pragma unroll
        for (int j = 0; j < 4; ++j) ss += (xv[j].x * xv[j].x + xv[j].y * xv[j].y) + (xv[j].z * xv[j].z + xv[j].w * xv[j].w);
        ss = wave_sum(ss); if (lane == 0) red[8 + wave] = ss;
        LDS_WAIT(); __syncthreads();
        r = 1.0f / sqrtf((red[8 + wave] + red[8 + (wave ^ 1)]) * (1.0f / DM) + NORM_EPS);
        const GAS f32x4* sp = (const GAS f32x4*)(sv + co) + lane; const GAS f32x4* hp = (const GAS f32x4*)(hv + co) + lane; GAS v2u* ho = (GAS v2u*)(hout + off) + lane;
#pragma unroll
        for (int j = 0; j < 4; ++j) { const f32x4 h = (xv[j] * r) * sp[64 * j] + hp[64 * j];
            v2u w; w.x = pg8::cvt_pk_bf16(h.x, h.y); w.y = pg8::cvt_pk_bf16(h.z, h.w); ho[64 * j] = w; }
        LDS_WAIT();
    }
}

#define MFMA32(a, b, c) __builtin_amdgcn_mfma_f32_32x32x16_bf16(a, b, c, 0, 0, 0)
#define MFMA16(a, b, c) __builtin_amdgcn_mfma_f32_16x16x32_bf16(a, b, c, 0, 0, 0)
struct ScanPtrs { const float *lam_re, *lam_im, *log_dt, *b_re, *b_im, *c_re, *c_im, *dsk; const bf16* U; float* YP; bf16* ACT; };

__device__ __forceinline__ void s5_disc(const float* lam_re, const float* lam_im, int ldg, int pp, float dt, float& lbr, float& lbi, float& cr, float& ci) {
    const float lr = lam_re[ldg * 64 + pp], li = lam_im[ldg * 64 + pp];
    const float a = lr * dt, th = li * dt; float sn, cs; sincosf(th, &sn, &cs);
    const float em1 = expm1f(a), mag = em1 + 1.0f; float sh_, ch_; sincosf(0.5f * th, &sh_, &ch_);
    lbr = mag * cs; lbi = mag * sn;
    const float nr = em1 * cs - 2.0f * sh_ * sh_, ni = lbi;
    const float den = 1.0f / (lr * lr + li * li);
    cr = (nr * lr + ni * li) * den; ci = (ni * lr - nr * li) * den;
}
__device__ __forceinline__ float gelu_tanh(float y) { const float z = 0.7978845608028654f * (y + 0.044715f * y * y * y); return y * pg8::sigm(2.0f * z); }

constexpr int SELF_CI = 22;
template <bool REV>
__device__ __forceinline__ void scan_chain(LAS unsigned char* sl, LAS unsigned* flags, int layer, int b, int g, const ScanPtrs P, int lane, bool ctx_out) {
    const int d = REV ? 1 : 0, ldg = (layer * 2 + d) * 64 + g, hh = lane >> 5, l31 = lane & 31;
    const float dt = expf(P.log_dt[ldg]);
    float lb0r, lb0i, c0r, c0i, lb1r, lb1i, c1r, c1i;
    s5_disc(P.lam_re, P.lam_im, ldg, l31, dt, lb0r, lb0i, c0r, c0i);
    s5_disc(P.lam_re, P.lam_im, ldg, 32 + l31, dt, lb1r, lb1i, c1r, c1i);
    const float lr = hh ? lb1r : lb0r, li = hh ? lb1i : lb0i;
    bf16x8 bfr[4];
#pragma unroll
    for (int j = 0; j < 4; ++j) { const int pp = l31 + 32 * (j & 1); const float cr = (j & 1) ? c1r : c0r, ci = (j & 1) ? c1i : c0i;
        const float* br = P.b_re + ((size_t)ldg * 64 + pp) * 16 + 8 * hh; const float* bi = P.b_im + ((size_t)ldg * 64 + pp) * 16 + 8 * hh;
        const f32x4 r0 = *(const f32x4*)br, r1 = *(const f32x4*)(br + 4), i0 = *(const f32x4*)bi, i1 = *(const f32x4*)(bi + 4);
        f32x4 v0, v1; if (j < 2) { v0 = r0 * cr - i0 * ci; v1 = r1 * cr - i1 * ci; } else { v0 = i0 * cr + r0 * ci; v1 = i1 * cr + r1 * ci; }
        v4u w; w.x = pk2(v0.x, v0.y); w.y = pk2(v0.z, v0.w); w.z = pk2(v1.x, v1.y); w.w = pk2(v1.z, v1.w); bfr[j] = __builtin_bit_cast(bf16x8, w); }
    const int cc = lane & 15, kq = lane >> 4;
    bf16x8 cfr[4];
#pragma unroll
    for (int s = 0; s < 4; ++s) { const size_t o = ((size_t)ldg * 16 + cc) * 64 + 16 * s + 4 * kq; const f32x4 re = *(const f32x4*)(P.c_re + o), im = *(const f32x4*)(P.c_im + o);
        v4u w; w.x = pk2(re.x, -im.x); w.y = pk2(re.y, -im.y); w.z = pk2(re.z, -im.z); w.w = pk2(re.w, -im.w); cfr[s] = __builtin_bit_cast(bf16x8, w); }
    LAS unsigned char* SB = sl;
    float sr = 0.f, si = 0.f; int pend0 = -1, pend1 = -1;
    auto rowbase_of = [&](int ci) -> int { if (ci < 4) { const int c4 = REV ? 3 - ci : ci; return RL + b * CTX + c4 * 64; } const int lc = ci - 4, c32 = REV ? 31 - lc : lc; return b * SEQ + c32 * 64; };
    bf16x8 ufr[2], un1[2], un2[2];
    { const int rb = rowbase_of(0), r1 = rowbase_of(1);
#pragma unroll
      for (int i = 0; i < 2; ++i) { ufr[i] = *(const bf16x8*)(P.U + (size_t)(rb + 32 * i + l31) * 1024 + g * 16 + 8 * hh); un1[i] = *(const bf16x8*)(P.U + (size_t)(r1 + 32 * i + l31) * 1024 + g * 16 + 8 * hh); } }
    un2[0] = un1[0]; un2[1] = un1[1];
    const f32x4 dk4 = *(const f32x4*)(P.dsk + layer * 1024 + g * 16 + 4 * kq);
    for (int ci = 0; ci < 36; ++ci) {
        const int rb = rowbase_of(ci);
        const int fidx = ci < 4 ? (REV ? 3 - ci : ci) : 4 + (REV ? 35 - ci : ci - 4);
        const bool selfc = ci >= SELF_CI;
        unsigned long long op[8]; v2u uu[4];
#pragma unroll
        for (int e = 0; e < 4; ++e) { op[2 * e] = 0ull; op[2 * e + 1] = 0ull; uu[e] = (v2u){0u, 0u}; }
        if (selfc) {
            while (__hip_atomic_load(flags + fidx, __ATOMIC_RELAXED, __HIP_MEMORY_SCOPE_WORKGROUP) < 1u) __builtin_amdgcn_s_sleep(2);
            asm volatile("" ::: "memory");
            const size_t eo = (size_t)(rb + cc) * 1024 + g * 16 + 4 * kq;
            const unsigned long long* opp = (const unsigned long long*)(P.YP + (size_t)(1 - d) * RT * 1024 + eo); const bf16* upp = P.U + eo;
#pragma unroll
            for (int f = 0; f < 4; ++f) { op[2 * f] = __hip_atomic_load(opp + (size_t)f * 8192, RLX_AGENT); op[2 * f + 1] = __hip_atomic_load(opp + (size_t)f * 8192 + 1, RLX_AGENT); uu[f] = *(const v2u*)(upp + (size_t)f * 16384); }
        }
        if (ci + 2 < 36) { const int rn = rowbase_of(ci + 2);
#pragma unroll
            for (int i = 0; i < 2; ++i) un2[i] = *(const bf16x8*)(P.U + (size_t)(rn + 32 * i + l31) * 1024 + g * 16 + 8 * hh); }
#pragma unroll
        for (int ib = 0; ib < 2; ++ib) { const int i = REV ? 1 - ib : ib;
            const f32x16 z = {0.f, 0.f, 0.f, 0.f, 0.f, 0.f, 0.f, 0.f, 0.f, 0.f, 0.f, 0.f, 0.f, 0.f, 0.f, 0.f};
            f32x16 x0 = MFMA32(ufr[i], bfr[0], z), x1 = MFMA32(ufr[i], bfr[1], z), x2 = MFMA32(ufr[i], bfr[2], z), x3 = MFMA32(ufr[i], bfr[3], z);
#pragma unroll
            for (int r = 0; r < 16; ++r) {
                auto pa = __builtin_amdgcn_permlane32_swap(__float_as_uint(x0[r]), __float_as_uint(x1[r]), false, false); x0[r] = __uint_as_float(pa[0]); x1[r] = __uint_as_float(pa[1]);
                auto pc = __builtin_amdgcn_permlane32_swap(__float_as_uint(x2[r]), __float_as_uint(x3[r]), false, false); x2[r] = __uint_as_float(pc[0]); x3[r] = __uint_as_float(pc[1]);
            }
#pragma unroll
            for (int k = 0; k < 32; ++k) { const int t = REV ? 31 - k : k; const int tg = (t >> 2) & 1, rg = (t & 3) + 4 * (t >> 3);
                const float xr = tg ? x1[rg] : x0[rg], xi = tg ? x3[rg] : x2[rg];
                const float nr = fmaf(-li, si, fmaf(lr, sr, xr)), ni = fmaf(li, sr, fmaf(lr, si, xi)); sr = nr; si = ni;
                *(LAS unsigned*)(SB + (32 * i + t) * 272 + lane * 4) = pg8::cvt_pk_bf16(sr, si); }
        }
        LDS_WAIT(); asm volatile("" ::: "memory");
        if (ci >= 4 || ctx_out) {
            f32x4 ya[4];
#pragma unroll
            for (int f = 0; f < 4; ++f) { f32x4 a = {0.f, 0.f, 0.f, 0.f};
#pragma unroll
                for (int s = 0; s < 4; ++s) { const bf16x8 af = *(const LAS bf16x8*)(SB + (16 * f + cc) * 272 + (32 * s + 8 * kq) * 2); a = MFMA16(cfr[s], af, a); }
                ya[f] = a; }
            if (!selfc) {
            asm volatile("s_waitcnt vmcnt(6)" ::: "memory");
            if (pend1 >= 0 && lane == 0) (void)__hip_atomic_fetch_add(flags + pend1, 1u, __ATOMIC_RELAXED, __HIP_MEMORY_SCOPE_WORKGROUP);
            pend1 = pend0; pend0 = fidx;
            float* myp = P.YP + ((size_t)d * RT + rb + cc) * 1024 + g * 16 + 4 * kq;
#pragma unroll
            for (int f = 0; f < 4; ++f) *(f32x4*)(myp + (size_t)f * 16384) = ya[f];
            } else {
                VM_WAIT();
                if (lane == 0) { if (pend1 >= 0) (void)__hip_atomic_fetch_add(flags + pend1, 1u, __ATOMIC_RELAXED, __HIP_MEMORY_SCOPE_WORKGROUP);
                                 if (pend0 >= 0) (void)__hip_atomic_fetch_add(flags + pend0, 1u, __ATOMIC_RELAXED, __HIP_MEMORY_SCOPE_WORKGROUP); }
                pend1 = -1; pend0 = -1;
                bf16* ap = P.ACT + (size_t)(rb + cc) * 1024 + g * 16 + 4 * kq;
#pragma unroll
                for (int f = 0; f < 4; ++f) {
                    const float y0 = ya[f][0] + __uint_as_float((unsigned)op[2 * f]) + dk4[0] * pg8::bflo(uu[f].x), y1 = ya[f][1] + __uint_as_float((unsigned)(op[2 * f] >> 32)) + dk4[1] * pg8::bfhi(uu[f].x);
                    const float y2 = ya[f][2] + __uint_as_float((unsigned)op[2 * f + 1]) + dk4[2] * pg8::bflo(uu[f].y), y3 = ya[f][3] + __uint_as_float((unsigned)(op[2 * f + 1] >> 32)) + dk4[3] * pg8::bfhi(uu[f].y);
                    v2u w; w.x = pg8::cvt_pk_bf16(gelu_tanh(y0), gelu_tanh(y1)); w.y = pg8::cvt_pk_bf16(gelu_tanh(y2), gelu_tanh(y3)); *(v2u*)(ap + (size_t)f * 16384) = w; }
            }
        }
        ufr[0] = un1[0]; ufr[1] = un1[1]; un1[0] = un2[0]; un1[1] = un2[1];
    }
    VM_WAIT();
    if (lane == 0) { if (pend1 >= 0) (void)__hip_atomic_fetch_add(flags + pend1, 1u, __ATOMIC_RELAXED, __HIP_MEMORY_SCOPE_WORKGROUP);
                     if (pend0 >= 0) (void)__hip_atomic_fetch_add(flags + pend0, 1u, __ATOMIC_RELAXED, __HIP_MEMORY_SCOPE_WORKGROUP); }
}


__device__ __forceinline__ void scan_combine(const ScanPtrs P, int layer, int b, int g, int fidx, int lane) {
    const int rb = fidx < 4 ? RL + b * CTX + fidx * 64 : b * SEQ + (fidx - 4) * 64;
    const size_t ro = (size_t)(rb + lane) * 1024 + g * 16;
    const unsigned long long* p0 = (const unsigned long long*)(P.YP + ro); const unsigned long long* p1 = (const unsigned long long*)(P.YP + (size_t)RT * 1024 + ro);
    unsigned long long a[8], c[8];
#pragma unroll
    for (int i = 0; i < 8; ++i) { a[i] = __hip_atomic_load(p0 + i, RLX_AGENT); c[i] = __hip_atomic_load(p1 + i, RLX_AGENT); }
    const v4u u0 = *(const v4u*)(P.U + ro), u1 = *(const v4u*)(P.U + ro + 8);
    const unsigned uw[8] = {u0.x, u0.y, u0.z, u0.w, u1.x, u1.y, u1.z, u1.w};
    const float* dk = P.dsk + layer * 1024 + g * 16;
    unsigned ow[8];
#pragma unroll
    for (int i = 0; i < 8; ++i) {
        const float y0 = __uint_as_float((unsigned)a[i]) + __uint_as_float((unsigned)c[i]) + dk[2 * i] * pg8::bflo(uw[i]);
        const float y1 = __uint_as_float((unsigned)(a[i] >> 32)) + __uint_as_float((unsigned)(c[i] >> 32)) + dk[2 * i + 1] * pg8::bfhi(uw[i]);
        ow[i] = pg8::cvt_pk_bf16(gelu_tanh(y0), gelu_tanh(y1)); }
    v4u o0 = {ow[0], ow[1], ow[2], ow[3]}, o1 = {ow[4], ow[5], ow[6], ow[7]};
    *(v4u*)(P.ACT + ro) = o0; *(v4u*)(P.ACT + ro + 8) = o1;
}
struct AttPtrs { const bf16 *Q, *K, *VTl, *VTc; bf16* O; const float* rpb; };
constexpr int ATT_KS = 144, ATT_VS = 80, ATT_TILE = 32 * ATT_KS + 64 * ATT_VS;
struct AttG { v4u k[4], v[4]; };
__device__ __forceinline__ void att_gload(AttG& G, const bf16* kblk, const bf16* vblk, int vstride, int lane) {
#pragma unroll
    for (int i = 0; i < 4; ++i) { G.k[i] = *(const v4u*)(kblk + (size_t)(8 * i + (lane >> 3)) * 1024 + (lane & 7) * 8);
                                  G.v[i] = *(const v4u*)(vblk + (size_t)(16 * i + (lane >> 2)) * vstride + (lane & 3) * 8); }
}
__device__ __forceinline__ void att_lwrite(const AttG& G, LAS unsigned char* tile, int lane) {
#pragma unroll
    for (int i = 0; i < 4; ++i) { *(LAS v4u*)(tile + (8 * i + (lane >> 3)) * ATT_KS + (lane & 7) * 16) = G.k[i];
        LAS unsigned char* vp = tile + 32 * ATT_KS + (16 * i + (lane >> 2)) * ATT_VS + 32 * ((lane & 3) >> 1) + 8 * (lane & 1); v2u lo = {G.v[i].x, G.v[i].y}, hi = {G.v[i].z, G.v[i].w}; *(LAS v2u*)vp = lo; *(LAS v2u*)(vp + 16) = hi; }
}
struct AttF { bf16x8 k[4]; v2u v[8]; };
__device__ __forceinline__ void att_fread(AttF& F, const LAS unsigned char* tile, int lane) {
    const int q = lane & 31, hh = lane >> 5;
#pragma unroll
    for (int ss = 0; ss < 4; ++ss) F.k[ss] = *(const LAS bf16x8*)(tile + q * ATT_KS + (16 * ss + 8 * hh) * 2);
#pragma unroll
    for (int f = 0; f < 2; ++f)
#pragma unroll
        for (int s2 = 0; s2 < 2; ++s2) { const v4u w = *(const LAS v4u*)(tile + 32 * ATT_KS + (32 * f + q) * ATT_VS + 32 * s2 + 16 * hh); F.v[(f * 2 + s2) * 2] = (v2u){w.x, w.y}; F.v[(f * 2 + s2) * 2 + 1] = (v2u){w.z, w.w}; }
}
__device__ __forceinline__ void att_compute(const AttF& B, const bf16x8 (&qf)[4], f32x16& o0, f32x16& o1, float& mrun, float& lrun, bool local, const unsigned (&colb)[4], unsigned rowb) {
    f32x16 s = {0.f, 0.f, 0.f, 0.f, 0.f, 0.f, 0.f, 0.f, 0.f, 0.f, 0.f, 0.f, 0.f, 0.f, 0.f, 0.f};
#pragma unroll
    for (int ss = 0; ss < 4; ++ss) s = MFMA32(B.k[ss], qf[ss], s);
    if (local) {
        float bs[16];
#pragma unroll
        for (int r = 0; r < 16; ++r) bs[r] = *(const LAS float*)(size_t)(((colb[r >> 2] >> (8 * (r & 3))) & 0xffu) + rowb);
#pragma unroll
        for (int r = 0; r < 16; ++r) s[r] += bs[r];
    }
    float bm = s[0];
#pragma unroll
    for (int r = 1; r < 16; ++r) bm = fmaxf(bm, s[r]);
    bm = fmaxf(bm, __shfl_xor(bm, 32));
    if (__any(bm > mrun)) {
        const float mn = fmaxf(mrun, bm), alpha = __builtin_amdgcn_exp2f(mrun - mn); mrun = mn;
        lrun = lrun * alpha; o0 = o0 * alpha; o1 = o1 * alpha;
    }
    float p[16]; float ps = 0.f;
#pragma unroll
    for (int r = 0; r < 16; ++r) { p[r] = __builtin_amdgcn_exp2f(s[r] - mrun); ps += p[r]; }
    lrun += ps;
#pragma unroll
    for (int s2 = 0; s2 < 2; ++s2) { v4u w; w.x = pg8::cvt_pk_bf16(p[8 * s2], p[8 * s2 + 1]); w.y = pg8::cvt_pk_bf16(p[8 * s2 + 2], p[8 * s2 + 3]);
        w.z = pg8::cvt_pk_bf16(p[8 * s2 + 4], p[8 * s2 + 5]); w.w = pg8::cvt_pk_bf16(p[8 * s2 + 6], p[8 * s2 + 7]); const bf16x8 pf = __builtin_bit_cast(bf16x8, w);
        { v4u a = {B.v[s2 * 2].x, B.v[s2 * 2].y, B.v[s2 * 2 + 1].x, B.v[s2 * 2 + 1].y}; o0 = MFMA32(__builtin_bit_cast(bf16x8, a), pf, o0); }
        { v4u a = {B.v[(2 + s2) * 2].x, B.v[(2 + s2) * 2].y, B.v[(2 + s2) * 2 + 1].x, B.v[(2 + s2) * 2 + 1].y}; o1 = MFMA32(__builtin_bit_cast(bf16x8, a), pf, o1); } }
}
__device__ __forceinline__ void att_item(int item, int layer, const AttPtrs P, LAS unsigned char* tile, LAS float* btab, int& tab_head, int lane) {
    const int q = lane & 31, hh = lane >> 5;
    const bool local = item < 4096;
    int b, h, r = 0, half = 0, qrow;
    if (local) { half = item & 1; r = (item >> 1) & 31; h = (item >> 6) & 15; b = item >> 10; qrow = b * SEQ + r * 64 + half * 32 + q; }
    else { const int it = item - 4096; const int qb = it & 7; h = (it >> 3) & 15; b = it >> 7; qrow = RL + b * CTX + qb * 32 + q; }
    if (local && tab_head != h) {
        LDS_WAIT(); asm volatile("" ::: "memory");
        const float* src = P.rpb + ((size_t)layer * NHEAD + h) * 465;
        for (int i = lane; i < 480; i += 64) { const int ro = i >> 5, j = i & 31; btab[i] = j < 31 ? src[ro * 31 + j] * LOG2E : -1e30f; }
        LDS_WAIT(); asm volatile("" ::: "memory");
        tab_head = h;
    }
    bf16x8 qf[4];
#pragma unroll
    for (int s = 0; s < 4; ++s) qf[s] = *(const bf16x8*)(P.Q + (size_t)qrow * 1024 + h * 64 + 16 * s + 8 * hh);
    f32x16 o0 = {0.f, 0.f, 0.f, 0.f, 0.f, 0.f, 0.f, 0.f, 0.f, 0.f, 0.f, 0.f, 0.f, 0.f, 0.f, 0.f}, o1 = o0; float mrun = -1e30f, lrun = 0.f;
    const bf16* vtc = P.VTc + (size_t)(b * 16 + h) * 64 * CTX;
    const bf16* kc = P.K + (size_t)(RL + b * CTX) * 1024 + h * 64;
    int r0 = r - 4; r0 = r0 < 0 ? 0 : (r0 > 24 ? 24 : r0);
    const int c = half * 32 + q; int c0 = c - 8; c0 = c0 < 0 ? 0 : (c0 > 48 ? 48 : c0);
    const bf16* vtl = P.VTl + (size_t)(b * 16 + h) * 64 * SEQ;
    const bf16* kl = P.K + (size_t)(b * SEQ) * 1024 + h * 64;
    unsigned colb0[4] = {0u, 0u, 0u, 0u}, colb1[4] = {0u, 0u, 0u, 0u}; const unsigned tb = (unsigned)(size_t)btab;
#pragma unroll
    for (int rr = 0; rr < 16; ++rr) { const int k0 = (rr & 3) + 8 * (rr >> 2) + 4 * hh, k1 = 32 + k0;
        colb0[rr >> 2] |= (4u * (unsigned)(((unsigned)(k0 - c0) < 16u) ? k0 - c + 15 : 31)) << (8 * (rr & 3)); colb1[rr >> 2] |= (4u * (unsigned)(((unsigned)(k1 - c0) < 16u) ? k1 - c + 15 : 31)) << (8 * (rr & 3)); }
    const int npair = local ? 12 : 4;
    auto gl = [&](AttG& G, int i) { if (i < 8) att_gload(G, kc + (size_t)(32 * i) * 1024, vtc + 32 * i, CTX, lane);
                                    else { const int j = i - 8, t0 = (r0 + (j >> 1)) * 64 + 32 * (j & 1); att_gload(G, kl + (size_t)t0 * 1024, vtl + t0, SEQ, lane); } };
    const int nblk = 2 * npair;
    AttG G; gl(G, 0);
    att_lwrite(G, tile, lane);
    gl(G, 1);
    for (int p = 0; p < npair; ++p) {
        const bool loc = p >= 4; const unsigned rowb = tb + (loc ? (unsigned)((r0 + (p - 4) - r + 7) * 128) : 0u);
        { AttF F; LDS_WAIT(); asm volatile("" ::: "memory"); att_fread(F, tile, lane); LDS_WAIT(); asm volatile("" ::: "memory");
          att_lwrite(G, tile, lane); gl(G, 2 * p + 2 < nblk ? 2 * p + 2 : nblk - 1);
          att_compute(F, qf, o0, o1, mrun, lrun, loc, colb0, rowb); }
        { AttF F; LDS_WAIT(); asm volatile("" ::: "memory"); att_fread(F, tile, lane); LDS_WAIT(); asm volatile("" ::: "memory");
          att_lwrite(G, tile, lane); gl(G, 2 * p + 3 < nblk ? 2 * p + 3 : nblk - 1);
          att_compute(F, qf, o0, o1, mrun, lrun, loc, colb1, rowb); }
    }
    const float inv = 1.0f / (lrun + __shfl_xor(lrun, 32));
    bf16* op = P.O + (size_t)qrow * 1024 + h * 64 + 4 * hh;
#pragma unroll
    for (int g4 = 0; g4 < 4; ++g4) {
        v2u w0, w1; w0.x = pg8::cvt_pk_bf16(o0[4 * g4] * inv, o0[4 * g4 + 1] * inv); w0.y = pg8::cvt_pk_bf16(o0[4 * g4 + 2] * inv, o0[4 * g4 + 3] * inv);
        w1.x = pg8::cvt_pk_bf16(o1[4 * g4] * inv, o1[4 * g4 + 1] * inv); w1.y = pg8::cvt_pk_bf16(o1[4 * g4 + 2] * inv, o1[4 * g4 + 3] * inv);
        *(v2u*)(op + 8 * g4) = w0; *(v2u*)(op + 32 + 8 * g4) = w1; }
}

#ifndef REPEAT_MASK
#define REPEAT_MASK 0
#endif
#ifndef PROBE_SCAN_REP
#define PROBE_SCAN_REP 1
#endif
#ifndef PROBE_ATT_REP
#define PROBE_ATT_REP 1
#endif
#ifndef PHASE_MASK
#define PHASE_MASK 2047
#endif
constexpr int NPH = 2 + 9 * DEPTH;
struct Args { const float* in[26]; float* out; unsigned char* ws; int ph_lo, ph_hi, use_bar, pad; };
typedef const __attribute__((address_space(4))) Args* KArgs;
#define KARGS(ka) KArgs ka = (KArgs)__builtin_amdgcn_kernarg_segment_ptr(); asm volatile("" : "+s"(ka))

constexpr int I_IN = (DM / 64) * (PW / 32), I_VG = (SSMW / 64) * (DM / 32), I_NA = (NAW / 64) * (DM / 32), I_OUT = (DM / 64) * (DM / 32), I_F1 = (DM / 64) * (DFF / 32), I_F2 = (DFF / 64) * (DM / 32);
constexpr int I_MIX = I_IN + 2 * I_VG + I_NA + I_OUT, I_LAYER = I_MIX + I_F1 + I_F2;
__device__ __forceinline__ void conv_item(KArgs ka, unsigned char* ws, int l, int r, LAS float* scr, int lane) {
    unsigned char* wb = ws + WS_W + (size_t)l * W_LAYER;
    const float* src; int K, N, mode; size_t wo;
    if (r < I_IN) { src = ka->in[10] + (size_t)l * DM * PW; K = DM; N = PW; mode = 0; wo = WO_IN; }
    else if ((r -= I_IN) < I_VG) { src = ka->in[19] + (size_t)l * SSMW * DM; K = SSMW; N = DM; mode = 1; wo = WO_VG; }
    else if ((r -= I_VG) < I_VG) { src = ka->in[20] + (size_t)l * SSMW * DM; K = SSMW; N = DM; mode = 2; wo = WO_VG; }
    else if ((r -= I_VG) < I_NA) { src = ka->in[22] + (size_t)l * NAW * DM; K = NAW; N = DM; mode = 0; wo = WO_NA; }
    else if ((r -= I_NA) < I_OUT) { src = ka->in[23] + (size_t)l * DM * DM; K = DM; N = DM; mode = 0; wo = WO_OUT; }
    else if ((r -= I_OUT) < I_F1) { src = ka->in[24] + (size_t)l * DM * DFF; K = DM; N = DFF; mode = 0; wo = WO_FC1; }
    else { r -= I_F1; src = ka->in[25] + (size_t)l * DFF * DM; K = DFF; N = DM; mode = 0; wo = WO_FC2; }
    p0_transpose_item(src, K, N, (bf16*)(wb + wo), mode, scr, r, lane);
}

__device__ __forceinline__ void mod_gemv_items(KArgs ka, unsigned char* ws, LAS unsigned char* lds, int tid, int lane, int wave, int it0, int it1, int step) {
        {
            const float* c_in = ka->in[1]; const float* cctx_in = ka->in[3]; const float* w_mod = ka->in[4]; const float* b_mod = ka->in[5]; float* MOD = (float*)(ws + WS_MOD);
            LAS float* SIL = (LAS float*)(lds + 71680); LAS float* PART = (LAS float*)(lds + 112640);
            for (int i = tid; i < 5 * DM; i += NWAVES * 64) { const int r = i >> 11, k = i & 2047; const float v = r < 4 ? c_in[r * DM + k] : cctx_in[k]; SIL[i] = v / (1.0f + expf(-v)); }
            __syncthreads();
            for (int it = it0; it < it1; it += step) {
                const int l = it / 192, jn = it % 192, col = jn * 64 + lane, k0 = wave * 256;
                const float* W = w_mod + (size_t)l * DM * (NMOD * DM) + (size_t)k0 * (NMOD * DM) + col;
                float a0 = 0.f, a1 = 0.f, a2 = 0.f, a3 = 0.f, a4 = 0.f;
#pragma unroll 4
                for (int kk = 0; kk < 256; kk += 4) {
                    const float w0 = W[(size_t)(kk + 0) * (NMOD * DM)], w1 = W[(size_t)(kk + 1) * (NMOD * DM)], w2 = W[(size_t)(kk + 2) * (NMOD * DM)], w3 = W[(size_t)(kk + 3) * (NMOD * DM)];
                    const f32x4 s0 = *(const LAS f32x4*)(SIL + 0 * DM + k0 + kk), s1 = *(const LAS f32x4*)(SIL + 1 * DM + k0 + kk), s2 = *(const LAS f32x4*)(SIL + 2 * DM + k0 + kk),
                                s3 = *(const LAS f32x4*)(SIL + 3 * DM + k0 + kk), s4 = *(const LAS f32x4*)(SIL + 4 * DM + k0 + kk);
                    a0 += s0.x * w0 + s0.y * w1 + s0.z * w2 + s0.w * w3; a1 += s1.x * w0 + s1.y * w1 + s1.z * w2 + s1.w * w3; a2 += s2.x * w0 + s2.y * w1 + s2.z * w2 + s2.w * w3;
                    a3 += s3.x * w0 + s3.y * w1 + s3.z * w2 + s3.w * w3; a4 += s4.x * w0 + s4.y * w1 + s4.z * w2 + s4.w * w3;
                }
                PART[(wave * 5 + 0) * 64 + lane] = a0; PART[(wave * 5 + 1) * 64 + lane] = a1; PART[(wave * 5 + 2) * 64 + lane] = a2; PART[(wave * 5 + 3) * 64 + lane] = a3; PART[(wave * 5 + 4) * 64 + lane] = a4;
                __syncthreads();
                if (wave < 5) { float s = b_mod[l * (NMOD * DM) + col];
#pragma unroll
                    for (int w = 0; w < 8; ++w) s += PART[(w * 5 + wave) * 64 + lane];
                    const int kidx = jn >> 5, c = col & (DM - 1);
                    if (kidx == 1) s = ka->in[6][l * DM + c] * (1.0f + s); else if (kidx == 2) s *= ka->in[7][l * DM + c];
                    else if (kidx == 4) s = ka->in[8][l * DM + c] * (1.0f + s); else if (kidx == 5) s *= ka->in[9][l * DM + c];
                    MOD[(size_t)(l * 5 + wave) * (NMOD * DM) + col] = s; }
                __syncthreads();
            }
        }
}
#define IDLE_COPY(nun, cl, lo_, hi_) do { const int first_ = (nun) % G; if (first_ != 0 && bx >= first_) { const int nid_ = G - first_, j_ = bx - first_, per_ = ((hi_) - (lo_) + nid_ - 1) / nid_; \
        const int a_ = (lo_) + j_ * per_, b_ = (a_ + per_ < (hi_)) ? a_ + per_ : (hi_); LAS float* scr_ = (LAS float*)(lds + wave * 8704); \
        for (int it_ = a_ + wave; it_ < b_; it_ += NWAVES) conv_item(ka, ws, cl, it_, scr_, lane); } } while (0)
__global__ void __launch_bounds__(NWAVES * 64, 2) mega_fwd(Args args_unused) {
    extern __shared__ __attribute__((aligned(16))) unsigned char lds_raw[];
    LAS unsigned char* lds = (LAS unsigned char*)lds_raw;
    const int tid0 = threadIdx.x, wave = __builtin_amdgcn_readfirstlane(tid0 >> 6);
    const int G = gridDim.x, bx = blockIdx.x;
    const int vcu = (G % 8 == 0) ? (bx % 8) * (G / 8) + bx / 8 : bx;
    const int gw = vcu * NWAVES + wave, NGW = G * NWAVES;
    for (int u = tid0; u < (LDS_BYTES - RING_BYTES) / 4; u += NWAVES * 64) ((LAS unsigned*)(lds + RING_BYTES))[u] = 0u;
    __syncthreads();
    int lo, hi, use_bar;
    { KARGS(ka); lo = ka->ph_lo; hi = ka->ph_hi; use_bar = ka->use_bar;
      if (use_bar) (void)xcd_barrier_post((unsigned*)(ka->ws + WS_CTL) + CW_BAR, (volatile LAS unsigned*)(lds + MISC_OFF) + 8); }
    for (int ph = lo; ph < hi; ++ph) {
    const int l = ph >= 2 ? (ph - 2) / 9 : 0, pk = ph >= 2 ? (ph - 2) % 9 : -1; const bool last = (l == DEPTH - 1);
    const int Mrows = last ? RL : RT;
    const int pbit = ph == 0 ? 512 : (ph == 1 ? 1024 : (1 << pk)); const int nrep = (REPEAT_MASK & pbit) ? 2 : 1;
    for (int rep = 0; rep < nrep; ++rep) {
    int tid = threadIdx.x; asm volatile("" : "+v"(tid)); const int lane = tid & 63;
    if (ph == 0 && (PHASE_MASK & 512)) {
        KARGS(ka); unsigned char* ws = ka->ws;
        {
            mod_gemv_items(ka, ws, lds, tid, lane, wave, bx, 64, G);
            float* ROPE = (float*)(ws + WS_ROPE);
            if (bx == G - 1) for (int i = tid; i < 64 * 16; i += NWAVES * 64) { const int pos = i >> 4, f = i & 15; const float inv = powf(10000.0f, -(float)f / 16.0f); const float ang = (float)pos * inv;
                float sn, cs; sincosf(ang, &sn, &cs); ROPE[2 * i] = cs; ROPE[2 * i + 1] = sn; }
        }
        LAS float* scr = (LAS float*)(lds + wave * 8704);
        for (int it = gw; it < I_IN + 2 * I_VG; it += NGW) conv_item(ka, ws, 0, it, scr, lane);
    }
    else if (ph == 1 && (PHASE_MASK & 1024)) {
        KARGS(ka); unsigned char* ws = ka->ws; const float* x_in = ka->in[0]; const float* ctx_in = ka->in[2];
        const float* MOD = (const float*)(ws + WS_MOD); bf16* H = (bf16*)(ws + WS_H);
        rowpass_pipe<false, 0, true>(lane, gw, NGW, RL, x_in, false, nullptr, nullptr, H, nullptr, MOD, 1, 0, -1);
        rowpass_pipe<false, 0, true>(lane, (gw & 1) ? RC : (gw >> 1), NGW / 2, RC, ctx_in, false, nullptr, nullptr, H + (size_t)RL * DM, nullptr, MOD, 1, 0, 4);
    }
    else {
        if (pk == 0 && (PHASE_MASK & 1)) {
            KARGS(ka); unsigned char* ws = ka->ws; unsigned char* wb = ws + WS_W + (size_t)l * W_LAYER; unsigned char* pj = ws + WS_PROJ;
            pg8::Gemm g{(const bf16*)(ws + WS_H), (const bf16*)(wb + WO_IN), RT, PW, DM};
            pg8::EpiIn E{(bf16*)(pj + PO_U), (bf16*)(pj + PO_Q), (bf16*)(pj + PO_K), (bf16*)(pj + PO_VTL), (bf16*)(pj + PO_VTC), (bf16*)(pj + PO_GS), (bf16*)(pj + PO_GN), (const float*)(ws + WS_ROPE)};
            if (!last) { pg8::StaticOrder S; S.init(RT, PW, G, bx); pg8::gemm_phase<pg8::EpiIn, pg8::StaticOrder, true, true>(lds, g, S, E); IDLE_COPY((RT / 256) * (PW / 256), 0, I_MIX, I_LAYER); }
            else { pg8::OrderL1In S; S.init(RL, PW, G, bx); pg8::gemm_phase<pg8::EpiIn, pg8::OrderL1In, true, true>(lds, g, S, E); IDLE_COPY((RL / 256) * (PW / 256) + 48, 1, I_MIX, I_LAYER); }
        }
        else if (pk == 1 && (PHASE_MASK & 2)) {
            KARGS(ka); unsigned char* ws = ka->ws; unsigned char* pj = ws + WS_PROJ;
            const ScanPtrs SPp{ka->in[11], ka->in[12], ka->in[13], ka->in[14], ka->in[15], ka->in[16], ka->in[17], ka->in[18], (const bf16*)(pj + PO_U), (float*)(ws + WS_OUT), (bf16*)(ws + WS_ACT)};
            LAS unsigned* flagb = (LAS unsigned*)(lds + MISC_OFF) + 16;
            if (tid < 320) flagb[tid] = 0u;
            if (tid == 0) ((LAS unsigned*)(lds + MISC_OFF))[12] = 0u;
            LDS_WAIT(); __syncthreads();
            LAS unsigned* cctr = (LAS unsigned*)(lds + MISC_OFF) + 12;
            if (wave < 2) {
                __builtin_amdgcn_s_setprio(3);
                LAS unsigned char* sl = lds + wave * SCAN_LDS; int iter = 0;
                for (int rp = 0; rp < PROBE_SCAN_REP; ++rp)
                for (int pair = bx; pair < NB * SG; pair += G, ++iter) {
                    LAS unsigned* flags = flagb + (iter & 7) * 40;
                    if (wave == 0) scan_chain<false>(sl, flags, l, pair >> 6, pair & 63, SPp, lane, !last);
                    else scan_chain<true>(sl, flags, l, pair >> 6, pair & 63, SPp, lane, !last);
                }
                __builtin_amdgcn_s_setprio(0);
            } else {
                LAS unsigned char* tile = lds + 2 * SCAN_LDS + (wave - 2) * ATT_TILE;
                {
                    const AttPtrs AP{(const bf16*)(pj + PO_Q), (const bf16*)(pj + PO_K), (const bf16*)(pj + PO_VTL), (const bf16*)(pj + PO_VTC), (bf16*)(ws + WS_ATT), ka->in[21]};
                    LAS float* btab = (LAS float*)(lds + 2 * SCAN_LDS + 6 * ATT_TILE + (wave - 2) * 2048); int tab_head = -1;
                    const int ipp = last ? 64 : 72, nq = 8 * ipp, xg = bx & 7, slot = (bx >> 3) * 6 + (wave - 2), nslot = (G >> 3) * 6;
                    const int ncl = last ? 4 : 8; int cpair = bx, citer = 0, cli = wave - 2;
                    for (int q = slot; ; q += nslot) {
                        const bool have = q < nq;
                        if (have) { const int pid = xg * 8 + q / ipp, w = q % ipp;
                            att_item(w < 64 ? pid * 64 + w : 4096 + pid * 8 + (w - 64), l, AP, tile, btab, tab_head, lane); }
                        while (cpair < NB * SG) {
                            if (cli >= ncl) { cli = wave - 2; cpair += G; ++citer; continue; }
                            const int cfc = last ? 18 + cli : (cli < 4 ? cli : 14 + cli);
                            volatile LAS unsigned* flags = (volatile LAS unsigned*)(flagb + (citer & 7) * 40);
                            if (flags[cfc] < 2u) { if (have) break;
                                unsigned spins = 0; while (flags[cfc] < 2u && ++spins < (1u << 24)) __builtin_amdgcn_s_sleep(8); }
                            asm volatile("" ::: "memory");
                            scan_combine(SPp, l, cpair >> 6, cpair & 63, cfc, lane);
                            cli += 6;
                        }
                        if (!have) break;
                    }
                }
            }
            __syncthreads();
        }
        else if (pk == 2 && (PHASE_MASK & 4)) {
            KARGS(ka); unsigned char* ws = ka->ws; unsigned char* wb = ws + WS_W + (size_t)l * W_LAYER;
            pg8::Gemm g{(const bf16*)(ws + WS_ACT), (const bf16*)(wb + WO_VG), Mrows, 2 * DM, SSMW}; pg8::StaticOrder S; S.init(Mrows, 2 * DM, G, bx);
            pg8::EpiD1 E{(const bf16*)(ws + WS_PROJ + PO_GS), (bf16*)(ws + WS_TM)};
            pg8::gemm_phase<pg8::EpiD1, pg8::StaticOrder, true, true>(lds, g, S, E);
            if (!last) { const int first = ((Mrows / 256) * (2 * DM / 256)) % G;
                if (first != 0 && bx >= first) mod_gemv_items(ka, ws, lds, tid, lane, wave, 192 + bx - first, 2 * 192, G - first); else if (first == 0) mod_gemv_items(ka, ws, lds, tid, lane, wave, 192 + bx, 2 * 192, G);
                if (first != 0) IDLE_COPY((Mrows / 256) * (2 * DM / 256), 0, I_IN + 2 * I_VG, I_IN + 2 * I_VG + I_NA);
                else { LAS float* scr = (LAS float*)(lds + wave * 8704); for (int it = I_IN + 2 * I_VG + gw; it < I_IN + 2 * I_VG + I_NA; it += NGW) conv_item(ka, ws, 0, it, scr, lane); } }
        }
        else if (pk == 3 && (PHASE_MASK & 8)) {
            KARGS(ka); unsigned char* ws = ka->ws; unsigned char* wb = ws + WS_W + (size_t)l * W_LAYER;
            pg8::Gemm g{(const bf16*)(ws + WS_ATT), (const bf16*)(wb + WO_NA), Mrows, DM, NAW}; pg8::StaticOrder S; S.init(Mrows, DM, G, bx);
            pg8::EpiD2 E{(const bf16*)(ws + WS_PROJ + PO_GN), (bf16*)(ws + WS_TM)};
            pg8::gemm_phase<pg8::EpiD2, pg8::StaticOrder, true, true>(lds, g, S, E);
            if (!last) { const int first = ((Mrows / 256) * (DM / 256)) % G;
                if (first != 0 && bx >= first) mod_gemv_items(ka, ws, lds, tid, lane, wave, 64 + bx - first, 192, G - first); else if (first == 0) mod_gemv_items(ka, ws, lds, tid, lane, wave, 64 + bx, 192, G);
                if (first != 0) IDLE_COPY((Mrows / 256) * (DM / 256), 0, I_IN + 2 * I_VG + I_NA, I_MIX);
                else { LAS float* scr = (LAS float*)(lds + wave * 8704); for (int it = I_IN + 2 * I_VG + I_NA + gw; it < I_MIX; it += NGW) conv_item(ka, ws, 0, it, scr, lane); } }
        }
        else if (pk == 4 && (PHASE_MASK & 16)) {
            KARGS(ka); unsigned char* ws = ka->ws; unsigned char* wb = ws + WS_W + (size_t)l * W_LAYER;
            pg8::Gemm g{(const bf16*)(ws + WS_TM), (const bf16*)(wb + WO_OUT), Mrows, DM, DM}; pg8::OrderSplitCtx S; S.init(RL, DM, G, bx); S.ksl = DM / 64 / 8; S.nctx = last ? 0 : 256;
            pg8::EpiF32S E{(bf16*)(ws + WS_OUT), (bf16*)(ws + WS_SLAB)};
            pg8::gemm_phase<pg8::EpiF32S, pg8::OrderSplitCtx, true, true>(lds, g, S, E);
        }
        else if ((pk == 5 && (PHASE_MASK & 32)) || (pk == 8 && (PHASE_MASK & 256))) {
            KARGS(ka); unsigned char* ws = ka->ws; const bool r2 = pk == 8;
            const float* mdl = (const float*)(ws + WS_MOD) + (size_t)(l * 5) * (NMOD * DM); const float* modg = mdl + (r2 ? 5 : 2) * DM;
            const float* modh = r2 ? mdl + (size_t)5 * (NMOD * DM) : mdl; const int kss = r2 ? 1 : 4, ksh = r2 ? 0 : 3;
            bf16* H = (bf16*)(ws + WS_H); bf16* XA = (bf16*)(ws + WS_XA); const bool xf = !r2 && l == 0;
            if (!last) rowpass_ctx8((LAS float*)(lds + MISC_OFF + 4096), lane, wave, vcu, G, xf ? (const void*)ka->in[2] : (const void*)(XA + (size_t)RL * DM), !xf, (const bf16*)(ws + WS_SLAB), XA + (size_t)RL * DM, H + (size_t)RL * DM,
                                    modg + (size_t)4 * (NMOD * DM), modh + (size_t)4 * (NMOD * DM) + kss * DM, modh + (size_t)4 * (NMOD * DM) + ksh * DM);
            if (!(r2 && last)) rowpass_pipe<true, 2, true>(lane, gw, NGW, RL, xf ? (const void*)ka->in[0] : (const void*)XA, !xf, (const bf16*)(ws + WS_OUT), XA, H, modg, modh, kss, ksh, -1);
            else rowpass_pipe<true, 1, false>(lane, gw, NGW, RL, XA, true, (const bf16*)(ws + WS_OUT), ka->out, nullptr, modg, nullptr, 0, 0, -1);
        }
        else if (pk == 6 && (PHASE_MASK & 64)) {
            KARGS(ka); unsigned char* ws = ka->ws; unsigned char* wb = ws + WS_W + (size_t)l * W_LAYER;
            pg8::Gemm g{(const bf16*)(ws + WS_H), (const bf16*)(wb + WO_FC1), Mrows, DFF, DM}; pg8::StaticOrder S; S.init(Mrows, DFF, G, bx);
            pg8::EpiRelu2 E{(bf16*)(ws + WS_PROJ), DFF};
            pg8::gemm_phase<pg8::EpiRelu2, pg8::StaticOrder, true, true>(lds, g, S, E);
            if (!last) IDLE_COPY((RT / 256) * (DFF / 256), 1, 0, I_MIX);
        }
        else if (pk == 7 && (PHASE_MASK & 128)) {
            KARGS(ka); unsigned char* ws = ka->ws; unsigned char* wb = ws + WS_W + (size_t)l * W_LAYER;
            pg8::Gemm g{(const bf16*)(ws + WS_PROJ), (const bf16*)(wb + WO_FC2), Mrows, DM, DFF}; pg8::OrderSplitCtx S; S.init(RL, DM, G, bx); S.ksl = DFF / 64 / 8; S.nctx = last ? 0 : 256;
            pg8::EpiF32S E{(bf16*)(ws + WS_OUT), (bf16*)(ws + WS_SLAB)};
            pg8::gemm_phase<pg8::EpiF32S, pg8::OrderSplitCtx, true, true>(lds, g, S, E);
        }
    }
    }
    if (ph + 1 < hi && use_bar) {
        KARGS(kb); XcdBarrier b2; b2.bar = (unsigned*)(kb->ws + WS_CTL) + CW_BAR; b2.x = xb_xcc_id(); b2.st = (volatile LAS unsigned*)(lds + MISC_OFF) + 8;
        xcd_barrier(b2);
    }
    }
}

extern "C" void kernel_launch(void* const* d_in, const int* in_sizes, int n_in, void* d_out, int out_size, void* d_ws, size_t ws_size, hipStream_t stream) {
    static int grid = 0;
    if (grid == 0) {
        if (n_in != 26 || in_sizes[0] != RL * DM || out_size != RL * DM || ws_size < WS_END) { fprintf(stderr, "kernel_launch: unexpected shapes / workspace (n_in %d, in0 %d, out %d, ws %zu < %zu); nothing launched\n", n_in, n_in > 0 ? in_sizes[0] : -1, out_size, ws_size, (size_t)WS_END); grid = -1; return; }
        int dev = 0, cus = 0, per_cu = 0;
        if (hipGetDevice(&dev) != hipSuccess || hipDeviceGetAttribute(&cus, hipDeviceAttributeMultiprocessorCount, dev) != hipSuccess) { grid = -1; return; }
        if (hipFuncSetAttribute((const void*)mega_fwd, hipFuncAttributeMaxDynamicSharedMemorySize, LDS_BYTES) != hipSuccess) { fprintf(stderr, "kernel_launch: hipFuncSetAttribute failed\n"); grid = -1; return; }
        if (hipOccupancyMaxActiveBlocksPerMultiprocessor(&per_cu, (const void*)mega_fwd, NWAVES * 64, LDS_BYTES) != hipSuccess || per_cu < 1) { fprintf(stderr, "kernel_launch: occupancy query says %d blocks per CU; nothing launched\n", per_cu); (void)hipGetLastError(); grid = -1; return; }
        grid = cus;
    }
    if (grid < 0) return;
    (void)hipMemsetAsync((char*)d_ws + WS_CTL, 0, CTL_ZERO_BYTES, stream);
    Args a{};
    for (int i = 0; i < 26; ++i) a.in[i] = (const float*)d_in[i];
    a.out = (float*)d_out; a.ws = (unsigned char*)d_ws;
#if MK_PER_PHASE
    for (int p = 0; p < NPH; ++p) { a.ph_lo = p; a.ph_hi = p + 1; a.use_bar = 0; a.pad = 0; hipLaunchKernelGGL(mega_fwd, dim3(grid), dim3(NWAVES * 64), LDS_BYTES, stream, a); }
#else
    a.ph_lo = 0; a.ph_hi = NPH; a.use_bar = 1; a.pad = 0;
    hipLaunchKernelGGL(mega_fwd, dim3(grid), dim3(NWAVES * 64), LDS_BYTES, stream, a);
#endif
}
```

```cpp
#include <hip/hip_runtime.h>
#include <cstdio>
#include <cstdint>
#ifndef MK_PER_PHASE
#define MK_PER_PHASE 0
#endif
namespace pg8 {
#define PG8_LAS __attribute__((address_space(3)))
typedef unsigned short bf16_t;
typedef short bf16x8 __attribute__((ext_vector_type(8)));
typedef float f32x4 __attribute__((ext_vector_type(4)));
typedef unsigned u32x4 __attribute__((ext_vector_type(4)));
constexpr int BM = 256, BK = 64, HALF = 128, HTB = HALF * BK * 2  , STAGE_BYTES = 8 * HTB, NXCD = 8, WGM = 8;

__host__ __device__ __forceinline__ int lds_byte(int r, int c) { const int st = (r >> 4) * 2 + (c >> 5), rr = r & 15, cc = c & 31, ob = rr * 64 + cc * 2; return st * 1024 + (ob ^ (((ob >> 9) & 1) << 5)); }
__host__ __device__ __forceinline__ void stage_rc(int b, int& R, int& C) { const int st = b / 1024, sb = b % 1024, swz = sb ^ (((sb >> 9) & 1) << 5); R = (st >> 1) * 16 + swz / 64; C = (st & 1) * 32 + (swz % 64) / 2; }
__host__ __device__ __forceinline__ int perm32(int rho) { const int n = rho >> 4, i = rho & 15; return 8 * (i >> 2) + 4 * n + (i & 3); }

struct Unit { int pm, pn, nt, ks; };
struct Gemm { const bf16_t* A; const bf16_t* Bt; int M, N, K; };

struct StaticOrder {
    int nM, nN, nwg, G, c;
    __host__ __device__ void init(int M, int N, int G_, int c_) { nM = M / BM; nN = N / BM; nwg = nM * nN; G = G_; c = c_; }
    __host__ __device__ __forceinline__ bool next(int i, Unit& u, int ntdef) const {
        u.nt = ntdef; u.ks = 0; u.pm = 0; u.pn = 0;
        const long L = (long)i * G + c; if (L >= nwg) return false;
        int wgid = (int)L; { const int q = nwg / NXCD, r = nwg % NXCD, xcd = wgid % NXCD, off = wgid / NXCD; wgid = (xcd < r ? xcd * (q + 1) : r * (q + 1) + (xcd - r) * q) + off; }
        const int nig = WGM * nN, gid = wgid / nig, fm = gid * WGM, gsz = (nM - fm) < WGM ? (nM - fm) : WGM;
        u.pm = fm + ((wgid % nig) % gsz); u.pn = (wgid % nig) / gsz; return true;
    }
    __device__ __forceinline__ void a_ready(const Unit&) const {}
    __device__ __forceinline__ void done(const Unit&, int) const {}
};


__device__ __forceinline__ unsigned cvt_pk_bf16(float lo, float hi) { unsigned r; asm volatile("v_cvt_pk_bf16_f32 %0, %1, %2" : "=v"(r) : "v"(lo), "v"(hi)); return r; }
typedef unsigned u32x2 __attribute__((ext_vector_type(2)));
__device__ __forceinline__ float sigm(float x) { return __builtin_amdgcn_rcpf(1.0f + __builtin_amdgcn_exp2f(-1.4426950408889634f * x)); }
__device__ __forceinline__ float bflo(unsigned w) { return __uint_as_float(w << 16); }
__device__ __forceinline__ float bfhi(unsigned w) { return __uint_as_float(w & 0xffff0000u); }
__device__ __forceinline__ u32x2 pack4(f32x4 v) { u32x2 w; w.x = cvt_pk_bf16(v[0], v[1]); w.y = cvt_pk_bf16(v[2], v[3]); return w; }

constexpr float QSCALE = 0.125f * 1.4426950408889634f;

struct EpiIn {
    static constexpr bool PERM = false, AFTER_DRAIN = false;
    bf16_t *U, *Q, *Kb, *VTl, *VTc, *GS, *GN; const float* rope;
    __device__ __forceinline__ void operator()(const f32x4 (&acc)[2][2][4][2], const Unit& u, int wr, int wc, int fr, int fq) const {
        const int pn = u.pn; const bool lat = u.pm < 32;
        const int row0 = u.pm * BM + wr * 64 + fr;
        if (pn < 4 || pn >= 16) {
            bf16_t* base; int ld, colt; bool sg;
            if (pn < 4) { base = U; ld = 1024; colt = pn * 256; sg = false; }
            else if (pn < 24) { base = GS; ld = 2048; colt = (pn - 16) * 256; sg = true; }
            else { base = GN; ld = 2048; colt = (pn - 24) * 256; sg = true; }
            const int col0 = colt + wc * 32 + 4 * fq;
#pragma unroll
            for (int ai = 0; ai < 2; ++ai)
#pragma unroll
                for (int m = 0; m < 4; ++m) { bf16_t* rowp = base + (size_t)(row0 + ai * HALF + m * 16) * ld + col0;
#pragma unroll
                    for (int bj = 0; bj < 2; ++bj)
#pragma unroll
                        for (int n = 0; n < 2; ++n) { f32x4 v = acc[ai][bj][m][n];
                            if (sg) { v[0] = sigm(v[0]); v[1] = sigm(v[1]); v[2] = sigm(v[2]); v[3] = sigm(v[3]); }
                            *(u32x2*)(rowp + bj * HALF + n * 16) = pack4(v); } }
        } else if (pn < 12) {
            const bool isq = pn < 8; bf16_t* base = isq ? Q : Kb; const int colt = (pn - (isq ? 4 : 8)) * 256;
            const float sc = isq ? QSCALE : 1.0f; const int col0 = colt + wc * 32 + 4 * fq; const int colsel = wc & 1;
#pragma unroll
            for (int ai = 0; ai < 2; ++ai)
#pragma unroll
                for (int m = 0; m < 4; ++m) { const int row = row0 + ai * HALF + m * 16; bf16_t* rowp = base + (size_t)row * 1024 + col0;
                    f32x4 cA = (f32x4){1.f, 0.f, 1.f, 0.f}, cB = cA;
                    if (lat) { const int t = row & 2047, pos = colsel ? (t & 63) : (t >> 6); const f32x4* rp = (const f32x4*)(rope + (pos * 16 + 4 * fq) * 2); cA = rp[0]; cB = rp[1]; }
#pragma unroll
                    for (int bj = 0; bj < 2; ++bj) { const f32x4 x1 = acc[ai][bj][m][0], x2 = acc[ai][bj][m][1]; f32x4 o1, o2;
                        o1[0] = x1[0] * cA[0] - x2[0] * cA[1]; o2[0] = x1[0] * cA[1] + x2[0] * cA[0];
                        o1[1] = x1[1] * cA[2] - x2[1] * cA[3]; o2[1] = x1[1] * cA[3] + x2[1] * cA[2];
                        o1[2] = x1[2] * cB[0] - x2[2] * cB[1]; o2[2] = x1[2] * cB[1] + x2[2] * cB[0];
                        o1[3] = x1[3] * cB[2] - x2[3] * cB[3]; o2[3] = x1[3] * cB[3] + x2[3] * cB[2];
                        o1 = o1 * sc; o2 = o2 * sc;
                        *(u32x2*)(rowp + bj * HALF) = pack4(o1); *(u32x2*)(rowp + bj * HALF + 16) = pack4(o2); } }
        } else {
            const int colt = (pn - 12) * 256;
#pragma unroll
            for (int ai = 0; ai < 2; ++ai)
#pragma unroll
                for (int m = 0; m < 4; ++m) { const int row = row0 + ai * HALF + m * 16;
                    bf16_t* bp; int tstride;
                    if (lat) { const int b = row >> 11, t = row & 2047; bp = VTl + (size_t)b * (16 * 64 * 2048) + t; tstride = 2048; }
                    else { const int rr = row - 8192, b = rr >> 8, l = rr & 255; bp = VTc + (size_t)b * (16 * 64 * 256) + l; tstride = 256; }
#pragma unroll
                    for (int bj = 0; bj < 2; ++bj)
#pragma unroll
                        for (int n = 0; n < 2; ++n) { const int c = colt + bj * HALF + wc * 32 + n * 16 + 4 * fq; const f32x4 v = acc[ai][bj][m][n];
                            const u32x2 w = pack4(v);
                            bp[(size_t)(c + 0) * tstride] = (bf16_t)(w.x & 0xffffu); bp[(size_t)(c + 1) * tstride] = (bf16_t)(w.x >> 16);
                            bp[(size_t)(c + 2) * tstride] = (bf16_t)(w.y & 0xffffu); bp[(size_t)(c + 3) * tstride] = (bf16_t)(w.y >> 16); } }
        }
    }
};
struct EpiD1 {
    static constexpr bool PERM = false, AFTER_DRAIN = false;
    const bf16_t* GS; bf16_t* T1;
    __device__ __forceinline__ void operator()(const f32x4 (&acc)[2][2][4][2], const Unit& u, int wr, int wc, int fr, int fq) const {
        const int row0 = u.pm * BM + wr * 64 + fr, L0 = u.pn * 128 + wc * 16 + 4 * fq;
#pragma unroll
        for (int ai = 0; ai < 2; ++ai)
#pragma unroll
            for (int m = 0; m < 4; ++m) { const size_t off = (size_t)(row0 + ai * HALF + m * 16) * 2048 + L0;
#pragma unroll
                for (int bj = 0; bj < 2; ++bj) { const f32x4 val = acc[ai][bj][m][0], glu = acc[ai][bj][m][1]; const u32x2 g = *(const u32x2*)(GS + off + bj * 64); f32x4 t;
                    t[0] = bflo(g.x) * val[0] * sigm(glu[0]); t[1] = bfhi(g.x) * val[1] * sigm(glu[1]); t[2] = bflo(g.y) * val[2] * sigm(glu[2]); t[3] = bfhi(g.y) * val[3] * sigm(glu[3]);
                    *(u32x2*)(T1 + off + bj * 64) = pack4(t); } }
    }
};
struct EpiD2 {
    static constexpr bool PERM = true, AFTER_DRAIN = false;
    const bf16_t* GN; bf16_t* TM;
    __device__ __forceinline__ void operator()(const f32x4 (&acc)[2][2][4][2], const Unit& u, int wr, int wc, int fr, int fq) const {
        const int row0 = u.pm * BM + wr * 64 + fr, col0 = u.pn * BM + wc * 32 + 8 * fq;
#pragma unroll
        for (int ai = 0; ai < 2; ++ai)
#pragma unroll
            for (int m = 0; m < 4; ++m) { const size_t off = (size_t)(row0 + ai * HALF + m * 16) * 2048 + col0;
#pragma unroll
                for (int bj = 0; bj < 2; ++bj) { const f32x4 v0 = acc[ai][bj][m][0], v1 = acc[ai][bj][m][1];
                    const u32x4 t = *(const u32x4*)(TM + off + bj * HALF), g = *(const u32x4*)(GN + off + bj * HALF); u32x4 w;
                    w.x = cvt_pk_bf16(bflo(t.x) + bflo(g.x) * v0[0], bfhi(t.x) + bfhi(g.x) * v0[1]); w.y = cvt_pk_bf16(bflo(t.y) + bflo(g.y) * v0[2], bfhi(t.y) + bfhi(g.y) * v0[3]);
                    w.z = cvt_pk_bf16(bflo(t.z) + bflo(g.z) * v1[0], bfhi(t.z) + bfhi(g.z) * v1[1]); w.w = cvt_pk_bf16(bflo(t.w) + bflo(g.w) * v1[2], bfhi(t.w) + bfhi(g.w) * v1[3]);
                    *(u32x4*)(TM + off + bj * HALF) = w; } }
    }
};
struct EpiD12 {
    static constexpr bool PERM = false, AFTER_DRAIN = false;
    const bf16_t* GS; const bf16_t* GN; bf16_t* TM; unsigned* ctr;
    __device__ __forceinline__ void operator()(const f32x4 (&acc)[2][2][4][2], const Unit& u, int wr, int wc, int fr, int fq) const {
        if (u.pn < 16) {
            const int row0 = u.pm * BM + wr * 64 + fr, L0 = u.pn * 128 + wc * 16 + 4 * fq;
#pragma unroll
            for (int ai = 0; ai < 2; ++ai)
#pragma unroll
                for (int m = 0; m < 4; ++m) { const size_t off = (size_t)(row0 + ai * HALF + m * 16) * 2048 + L0;
#pragma unroll
                    for (int bj = 0; bj < 2; ++bj) { const f32x4 val = acc[ai][bj][m][0], glu = acc[ai][bj][m][1]; const u32x2 g = *(const u32x2*)(GS + off + bj * 64); f32x4 t;
                        t[0] = bflo(g.x) * val[0] * sigm(glu[0]); t[1] = bfhi(g.x) * val[1] * sigm(glu[1]); t[2] = bflo(g.y) * val[2] * sigm(glu[2]); t[3] = bfhi(g.y) * val[3] * sigm(glu[3]);
                        *(u32x2*)(TM + off + bj * 64) = pack4(t); } }
        } else {
            const int pm = u.pm - 36, pn = u.pn - 16;
            if (fr == 0 && fq == 0) { unsigned spins = 0; while (__hip_atomic_load(ctr + pm * 8 + pn, __ATOMIC_RELAXED, __HIP_MEMORY_SCOPE_AGENT) < 16u && ++spins < (1u << 22)) __builtin_amdgcn_s_sleep(4); }
            asm volatile("" ::: "memory");
            const int row0 = pm * BM + wr * 64 + fr, col0 = pn * BM + wc * 32 + 4 * fq;
#pragma unroll
            for (int ai = 0; ai < 2; ++ai)
#pragma unroll
                for (int m = 0; m < 4; ++m) { const size_t off = (size_t)(row0 + ai * HALF + m * 16) * 2048 + col0;
#pragma unroll
                    for (int bj = 0; bj < 2; ++bj)
#pragma unroll
                        for (int n = 0; n < 2; ++n) { const f32x4 v = acc[ai][bj][m][n]; const size_t o2 = off + bj * HALF + n * 16;
                            const u32x2 t = *(const u32x2*)(TM + o2), g = *(const u32x2*)(GN + o2); u32x2 w;
                            w.x = cvt_pk_bf16(bflo(t.x) + bflo(g.x) * v[0], bfhi(t.x) + bfhi(g.x) * v[1]); w.y = cvt_pk_bf16(bflo(t.y) + bflo(g.y) * v[2], bfhi(t.y) + bfhi(g.y) * v[3]);
                            *(u32x2*)(TM + o2) = w; } }
        }
    }
};
struct OrderD12 {
    int nM, k, npop, r, n, total, blocked, nctx1, cnt; unsigned* ctr;
    __device__ __forceinline__ void init(int M, int k_, int npop_, int r_, int n_) { nM = M / BM; k = k_; npop = npop_; r = r_; n = n_;
        blocked = (npop == 8 && (nM == 32 || nM == 36)) ? 1 : 0; nctx1 = nM == 36 ? 8 : 0;
        const int T = nM * 8; cnt = k < T ? (T - k + npop - 1) / npop : 0; total = blocked ? 96 + nctx1 + (nctx1 >> 1) : 3 * cnt; }
    __device__ __forceinline__ bool next(int i, Unit& u, int ntdef) const {
        u.nt = ntdef; u.ks = 0; u.pm = 0; u.pn = 0;
        const long sL = (long)i * n + r; if (sL >= total) return false;
        const int sq = (int)sL;
        if (blocked) {
            if (sq < 64) { const int w = sq & 31; u.pm = 4 * k + (w & 3); u.pn = (sq >> 5) * 8 + (w >> 2); }
            else if (sq < 64 + nctx1) { u.pm = 32 + (k >> 1); u.pn = (k & 1) * 8 + (sq - 64); }
            else if (sq < 96 + nctx1) { const int w = sq - 64 - nctx1; u.pm = 36 + 4 * k + (w & 3); u.pn = 16 + (w >> 2); }
            else { u.pm = 36 + 32 + (k >> 1); u.pn = 16 + (k & 1) * 4 + (sq - 96 - nctx1); }
        } else {
            const bool d1 = sq < 2 * cnt; const int j = d1 ? (sq >> 1) : (sq - 2 * cnt), t = k + j * npop, pm = t % nM, pn = t / nM;
            if (d1) { u.pm = pm; u.pn = 2 * pn + (sq & 1); } else { u.pm = 36 + pm; u.pn = 16 + pn; }
        }
        return true;
    }
    __device__ __forceinline__ void a_ready(const Unit&) const {}
    __device__ __forceinline__ void done(const Unit& u, int lane) const {
        if (u.pn < 16) { asm volatile("s_waitcnt vmcnt(0)" ::: "memory");
            if (lane == 0) (void)__hip_atomic_fetch_add(ctr + u.pm * 8 + (u.pn >> 1), 1u, __ATOMIC_RELAXED, __HIP_MEMORY_SCOPE_AGENT); }
    }
};
struct EpiF32 {
    static constexpr bool PERM = false, AFTER_DRAIN = false;
    float* O; int ldc;
    __device__ __forceinline__ void operator()(const f32x4 (&acc)[2][2][4][2], const Unit& u, int wr, int wc, int fr, int fq) const {
        const int row0 = u.pm * BM + wr * 64 + fr, col0 = u.pn * BM + wc * 32 + 4 * fq;
#pragma unroll
        for (int ai = 0; ai < 2; ++ai)
#pragma unroll
            for (int m = 0; m < 4; ++m) { float* rowp = O + (size_t)(row0 + ai * HALF + m * 16) * ldc + col0;
#pragma unroll
                for (int bj = 0; bj < 2; ++bj)
#pragma unroll
                    for (int n = 0; n < 2; ++n) *(f32x4*)(rowp + bj * HALF + n * 16) = acc[ai][bj][m][n]; }
    }
};
struct EpiF32S {
    static constexpr bool PERM = true, AFTER_DRAIN = false;
    bf16_t* O; bf16_t* SL;
    __device__ __forceinline__ void operator()(const f32x4 (&acc)[2][2][4][2], const Unit& u, int wr, int wc, int fr, int fq) const {
        const int row0 = u.pm * BM + wr * 64 + fr, col0 = u.pn * BM + wc * 32 + 8 * fq;
        if (u.pm < 32) {
#pragma unroll
            for (int ai = 0; ai < 2; ++ai)
#pragma unroll
                for (int m = 0; m < 4; ++m) { bf16_t* rowp = O + (size_t)(row0 + ai * HALF + m * 16) * 2048 + col0;
#pragma unroll
                    for (int bj = 0; bj < 2; ++bj) { const f32x4 v0 = acc[ai][bj][m][0], v1 = acc[ai][bj][m][1];
                        u32x4 w; w.x = cvt_pk_bf16(v0[0], v0[1]); w.y = cvt_pk_bf16(v0[2], v0[3]); w.z = cvt_pk_bf16(v1[0], v1[1]); w.w = cvt_pk_bf16(v1[2], v1[3]);
                        *(u32x4*)(rowp + bj * HALF) = w; } }
        } else {
            bf16_t* base = SL + ((size_t)u.ks * 1024 + (row0 - 8192)) * 2048;
#pragma unroll
            for (int ai = 0; ai < 2; ++ai)
#pragma unroll
                for (int m = 0; m < 4; ++m) { bf16_t* rowp = base + (size_t)(ai * HALF + m * 16) * 2048 + col0;
#pragma unroll
                    for (int bj = 0; bj < 2; ++bj) { const f32x4 v0 = acc[ai][bj][m][0], v1 = acc[ai][bj][m][1];
                        u32x4 w; w.x = cvt_pk_bf16(v0[0], v0[1]); w.y = cvt_pk_bf16(v0[2], v0[3]); w.z = cvt_pk_bf16(v1[0], v1[1]); w.w = cvt_pk_bf16(v1[2], v1[3]);
                        *(u32x4*)(rowp + bj * HALF) = w; } }
        }
    }
};
struct OrderSplitCtx : StaticOrder {
    int ksl, nctx;
    __device__ __forceinline__ bool next(int i, Unit& u, int ntdef) const {
        if (StaticOrder::next(i, u, ntdef)) return true;
        const long L = (long)i * G + c - nwg; if (L >= nctx) return false;
        const int unit = (int)L >> 3; u.pm = 32 + (unit & 3); u.pn = unit >> 2; u.ks = (int)L & 7; u.nt = ksl; return true;
    }
};
struct EpiRelu2 {
    static constexpr bool PERM = true, AFTER_DRAIN = false;
    bf16_t* O; int ldc;
    __device__ __forceinline__ void operator()(const f32x4 (&acc)[2][2][4][2], const Unit& u, int wr, int wc, int fr, int fq) const {
        const int row0 = u.pm * BM + wr * 64 + fr, col0 = u.pn * BM + wc * 32 + 8 * fq;
#pragma unroll
        for (int ai = 0; ai < 2; ++ai)
#pragma unroll
            for (int m = 0; m < 4; ++m) { bf16_t* rowp = O + (size_t)(row0 + ai * HALF + m * 16) * ldc + col0;
#pragma unroll
                for (int bj = 0; bj < 2; ++bj) { f32x4 v0 = acc[ai][bj][m][0], v1 = acc[ai][bj][m][1];
                    v0 = __builtin_elementwise_max(v0, (f32x4){0.f, 0.f, 0.f, 0.f}); v1 = __builtin_elementwise_max(v1, (f32x4){0.f, 0.f, 0.f, 0.f}); v0 = v0 * v0; v1 = v1 * v1;
                    u32x4 w; w.x = cvt_pk_bf16(v0[0], v0[1]); w.y = cvt_pk_bf16(v0[2], v0[3]); w.z = cvt_pk_bf16(v1[0], v1[1]); w.w = cvt_pk_bf16(v1[2], v1[3]);
                    *(u32x4*)(rowp + bj * HALF) = w; } }
    }
};
struct OrderL1In : StaticOrder {
    __device__ __forceinline__ bool next(int i, Unit& u, int ntdef) const {
        if (StaticOrder::next(i, u, ntdef)) return true;
        const long L = (long)i * G + c - nwg; if (L >= 48) return false;
        const int k = (int)L >> 2; u.pm = 32 + ((int)L & 3); u.pn = k < 4 ? k : k + 4; return true;
    }
};

template <class Epi, class Sched, bool ALIGN_EPI = false, bool SP2 = false>
__device__ __forceinline__ void gemm_phase(PG8_LAS unsigned char* lds, const Gemm g, const Sched& S, const Epi& E) {
    int tid_o = threadIdx.x; asm volatile("" : "+v"(tid_o));
    const int tid = tid_o, wid = __builtin_amdgcn_readfirstlane(tid >> 6), lane = tid & 63, wr = wid >> 2, wc = wid & 3, fr = lane & 15, fq = lane >> 4;
    const int K = g.K, nt = K / BK;
    unsigned voffA[2], voffB[2];
#pragma unroll
    for (int i = 0; i < 2; ++i) { int R, C; stage_rc(tid * 16 + i * 8192, R, C); const int Rb = Epi::PERM ? ((R & ~31) + perm32(R & 31)) : R;
        voffA[i] = (unsigned)(R * K + C) * 2u; voffB[i] = (unsigned)(Rb * K + C) * 2u; }
    const size_t kstep = (size_t)(BK * 2);
    const size_t hstep = (size_t)HALF * K * 2;
    const size_t tstep = 2 * hstep;
    const unsigned ldsw = (unsigned)wid * 1024u;
    const int aoff = lds_byte(wr * 64 + fr, fq * 8), boff = lds_byte(wc * 32 + fr, fq * 8);
#define PG8_SA(b, h) (((b) * 2 + (h)) * HTB)
#define PG8_SB(b, h) ((4 + (b) * 2 + (h)) * HTB)
#define PG8_STAGE(bufoff, gbase, voff) do { _Pragma("unroll") for (int _i = 0; _i < 2; ++_i) \
        __builtin_amdgcn_global_load_lds((const unsigned*)((const char*)(gbase) + (voff)[_i]), (PG8_LAS unsigned*)(lds + (bufoff) + ldsw + _i * 8192), 16, 0, 0); } while (0)
#define PG8_LDA(dst, b, h) do { _Pragma("unroll") for (int m = 0; m < 4; ++m) _Pragma("unroll") for (int k = 0; k < 2; ++k) dst[m][k] = *(const PG8_LAS bf16x8*)(lds + PG8_SA(b, h) + aoff + m * 2048 + k * 1024); } while (0)
#define PG8_LDB(dst, b, h) do { _Pragma("unroll") for (int n = 0; n < 2; ++n) _Pragma("unroll") for (int k = 0; k < 2; ++k) dst[n][k] = *(const PG8_LAS bf16x8*)(lds + PG8_SB(b, h) + boff + n * 2048 + k * 1024); } while (0)
#define PG8_MMA(ai, bj, At, Bt) do { __builtin_amdgcn_s_setprio(1); _Pragma("unroll") for (int m = 0; m < 4; ++m) _Pragma("unroll") for (int n = 0; n < 2; ++n) _Pragma("unroll") for (int k = 0; k < 2; ++k) \
        acc[ai][bj][m][n] = __builtin_amdgcn_mfma_f32_16x16x32_bf16(Bt[n][k], At[m][k], acc[ai][bj][m][n], 0, 0, 0); __builtin_amdgcn_s_setprio(0); } while (0)
#define PG8_WAIT_V(n) asm volatile("s_waitcnt vmcnt(" #n ")" ::: "memory")
#define PG8_WAIT_L(n) asm volatile("s_waitcnt lgkmcnt(" #n ")" ::: "memory")
#define PG8_BAR __builtin_amdgcn_s_barrier()
#define PG8_SCHED __builtin_amdgcn_sched_barrier(0)
    Unit cur, nxt; int ui = 0;
    if (!S.next(0, cur, nt)) return;
    f32x4 acc[2][2][4][2];
#pragma unroll
    for (int a = 0; a < 2; ++a)
#pragma unroll
        for (int b = 0; b < 2; ++b)
#pragma unroll
            for (int m = 0; m < 4; ++m)
#pragma unroll
                for (int n = 0; n < 2; ++n) acc[a][b][m][n] = (f32x4){0.f, 0.f, 0.f, 0.f};
    bf16x8 At[4][2], B0[2][2], B1[2][2];
    const char* cA = (const char*)g.A + (size_t)cur.pm * tstep + (size_t)(cur.ks * cur.nt) * (BK * 2); const char* cB = (const char*)g.Bt + (size_t)cur.pn * tstep + (size_t)(cur.ks * cur.nt) * (BK * 2);
    S.a_ready(cur);
    if constexpr (SP2) {
        PG8_STAGE(PG8_SB(0, 0), cB, voffB); PG8_STAGE(PG8_SB(0, 1), cB + hstep, voffB); PG8_STAGE(PG8_SA(0, 0), cA, voffA); PG8_STAGE(PG8_SA(0, 1), cA + hstep, voffA);
        if (wr == 1) PG8_BAR;
        PG8_WAIT_V(2); PG8_BAR;
        PG8_STAGE(PG8_SB(1, 0), cB + kstep, voffB); PG8_STAGE(PG8_SA(1, 0), cA + kstep, voffA); PG8_STAGE(PG8_SB(1, 1), cB + hstep + kstep, voffB);
        PG8_WAIT_V(6); PG8_BAR;
    } else {
        PG8_STAGE(PG8_SB(0, 0), cB, voffB); PG8_STAGE(PG8_SA(0, 0), cA, voffA); PG8_STAGE(PG8_SB(0, 1), cB + hstep, voffB); PG8_STAGE(PG8_SA(0, 1), cA + hstep, voffA);
        if (wr == 1) PG8_BAR;
        PG8_WAIT_V(4); PG8_BAR;
        PG8_STAGE(PG8_SB(1, 0), cB + kstep, voffB); PG8_STAGE(PG8_SA(1, 0), cA + kstep, voffA); PG8_STAGE(PG8_SB(1, 1), cB + hstep + kstep, voffB);
        PG8_WAIT_V(6); PG8_BAR;
    }
    for (;;) {
        const bool has_next = S.next(ui + 1, nxt, nt);
        const int ntu = cur.nt;
        const char* nA = has_next ? (const char*)g.A + (size_t)nxt.pm * tstep + (size_t)(nxt.ks * nxt.nt) * (BK * 2) : cA; const char* nB = has_next ? (const char*)g.Bt + (size_t)nxt.pn * tstep + (size_t)(nxt.ks * nxt.nt) * (BK * 2) : cB;
        for (int t = 0; t < ntu; t += 2) {
            const bool last = (t == ntu - 2);
            const char* a1 = cA + (size_t)(t + 1) * kstep;
            const char* a2 = last ? nA : cA + (size_t)(t + 2) * kstep; const char* b2 = last ? nB : cB + (size_t)(t + 2) * kstep;
            const char* a3 = a2 + kstep; const char* b3 = b2 + kstep;
            if (last && has_next) S.a_ready(nxt);
            if constexpr (SP2) {
            PG8_LDB(B0, 0, 0); PG8_LDB(B1, 0, 1); PG8_SCHED; PG8_LDA(At, 0, 0); PG8_STAGE(PG8_SA(1, 1), a1 + hstep, voffA);
            PG8_WAIT_V(8); PG8_WAIT_L(0); PG8_BAR; PG8_MMA(0, 0, At, B0); PG8_MMA(0, 1, At, B1); PG8_BAR; PG8_SCHED;
            PG8_LDA(At, 0, 1); PG8_STAGE(PG8_SB(0, 0), b2, voffB); PG8_STAGE(PG8_SB(0, 1), b2 + hstep, voffB); PG8_STAGE(PG8_SA(0, 0), a2, voffA);
            PG8_WAIT_V(8); PG8_WAIT_L(0); PG8_BAR; PG8_MMA(1, 0, At, B0); PG8_MMA(1, 1, At, B1); PG8_BAR; PG8_SCHED;
            PG8_LDB(B0, 1, 0); PG8_LDB(B1, 1, 1); PG8_SCHED; PG8_LDA(At, 1, 0); PG8_STAGE(PG8_SA(0, 1), a2 + hstep, voffA);
            PG8_WAIT_V(8); PG8_WAIT_L(0); PG8_BAR; PG8_MMA(0, 0, At, B0); PG8_MMA(0, 1, At, B1); PG8_BAR; PG8_SCHED;
            PG8_LDA(At, 1, 1); PG8_STAGE(PG8_SB(1, 0), b3, voffB); PG8_STAGE(PG8_SB(1, 1), b3 + hstep, voffB); PG8_STAGE(PG8_SA(1, 0), a3, voffA);
            PG8_WAIT_V(8); PG8_WAIT_L(0); PG8_BAR; PG8_MMA(1, 0, At, B0); PG8_MMA(1, 1, At, B1); PG8_BAR; PG8_SCHED;
            } else {
            PG8_LDB(B0, 0, 0); PG8_SCHED; PG8_LDA(At, 0, 0); PG8_STAGE(PG8_SA(1, 1), a1 + hstep, voffA);
            PG8_WAIT_L(8); PG8_BAR; PG8_WAIT_L(0); PG8_MMA(0, 0, At, B0); PG8_BAR; PG8_SCHED;
            PG8_LDB(B1, 0, 1); PG8_STAGE(PG8_SB(0, 0), b2, voffB);
            PG8_BAR; PG8_WAIT_L(0); PG8_MMA(0, 1, At, B1); PG8_BAR;
            PG8_LDA(At, 0, 1); PG8_STAGE(PG8_SA(0, 0), a2, voffA);
            PG8_BAR; PG8_WAIT_L(0); PG8_MMA(1, 0, At, B0); PG8_BAR; PG8_SCHED;
            PG8_STAGE(PG8_SB(0, 1), b2 + hstep, voffB);
            PG8_WAIT_V(6); PG8_BAR; PG8_MMA(1, 1, At, B1); PG8_BAR;
            PG8_LDB(B0, 1, 0); PG8_SCHED; PG8_LDA(At, 1, 0); PG8_STAGE(PG8_SA(0, 1), a2 + hstep, voffA);
            PG8_WAIT_L(8); PG8_BAR; PG8_WAIT_L(0); PG8_MMA(0, 0, At, B0); PG8_BAR; PG8_SCHED;
            PG8_LDB(B1, 1, 1); PG8_STAGE(PG8_SB(1, 0), b3, voffB);
            PG8_BAR; PG8_WAIT_L(0); PG8_MMA(0, 1, At, B1); PG8_BAR;
            PG8_LDA(At, 1, 1); PG8_STAGE(PG8_SA(1, 0), a3, voffA);
            PG8_BAR; PG8_WAIT_L(0); PG8_MMA(1, 0, At, B0); PG8_BAR; PG8_SCHED;
            PG8_STAGE(PG8_SB(1, 1), b3 + hstep, voffB);
            PG8_WAIT_V(6); PG8_BAR; PG8_MMA(1, 1, At, B1); PG8_BAR;
            }
        }
        if constexpr (ALIGN_EPI) { if (wr == 0) PG8_BAR; }
        if constexpr (!Epi::AFTER_DRAIN) { E(acc, cur, wr, wc, fr, fq); S.done(cur, lane); }
        if (!has_next) break;
#pragma unroll
        for (int a = 0; a < 2; ++a)
#pragma unroll
            for (int b = 0; b < 2; ++b)
#pragma unroll
                for (int m = 0; m < 4; ++m)
#pragma unroll
                    for (int n = 0; n < 2; ++n) acc[a][b][m][n] = (f32x4){0.f, 0.f, 0.f, 0.f};
        cur = nxt; cA = nA; cB = nB; ++ui;
        if constexpr (ALIGN_EPI) { if (wr == 1) PG8_BAR; }
    }
    PG8_WAIT_V(0);
    if constexpr (!ALIGN_EPI) { if (wr == 0) PG8_BAR; }
    PG8_BAR;
    if constexpr (Epi::AFTER_DRAIN) { E.fused(acc, cur, wr, wc, fr, fq, lds, wid, lane); S.done(cur, lane); }
#undef PG8_SA
#undef PG8_SB
#undef PG8_STAGE
#undef PG8_LDA
#undef PG8_LDB
#undef PG8_MMA
#undef PG8_WAIT_V
#undef PG8_WAIT_L
#undef PG8_BAR
#undef PG8_SCHED
}
}

constexpr int NWAVES = 8;
constexpr int DM = 2048, NB = 4, SEQ = 2048, CTX = 256, DEPTH = 2, NHEAD = 16, HD = 64, GRIDW = 64, NMOD = 6;
constexpr int RL = NB * SEQ, RC = NB * CTX, RT = RL + RC;
constexpr int SSMW = 1024, NAW = 1024, PW = 8192, DFF = 8192, SG = 64, SP = 64, SC = 16;
constexpr float NORM_EPS = 1e-6f;
constexpr float LOG2E = 1.4426950408889634f;

constexpr size_t MiB = 1u << 20;
constexpr size_t WS_CTL = 0, CTL_ZERO_BYTES = 1 * MiB;
constexpr size_t WS_MOD = 1 * MiB;
constexpr size_t WS_ROPE = 1 * MiB + 512 * 1024;
constexpr size_t WS_W = 2 * MiB, W_LAYER = 116 * MiB;
constexpr size_t WO_IN = 0, WO_VG = 32 * MiB, WO_NA = 40 * MiB, WO_OUT = 44 * MiB, WO_FC1 = 52 * MiB, WO_FC2 = 84 * MiB;
constexpr size_t WS_XA = 234 * MiB;
constexpr size_t WS_H = 306 * MiB;
constexpr size_t WS_PROJ = 342 * MiB;
constexpr size_t PO_U = 0, PO_Q = 18 * MiB, PO_K = 36 * MiB, PO_VTL = 54 * MiB, PO_VTC = 70 * MiB, PO_GS = 72 * MiB, PO_GN = 108 * MiB;
constexpr size_t WS_ACT = 486 * MiB;
constexpr size_t WS_ATT = 504 * MiB;
constexpr size_t WS_TM = 522 * MiB;
constexpr size_t WS_OUT = 558 * MiB;
constexpr size_t WS_SLAB = 630 * MiB;
constexpr size_t WS_END = 694 * MiB;
constexpr int CW_BAR = 4096, CW_D12 = 65536, CW_GQ = 69632;

constexpr int RING_BYTES = 131072, MISC_OFF = RING_BYTES + 320, LDS_BYTES = 147456;
constexpr int SCAN_LDS = 17408;
#define GAS __attribute__((address_space(1)))
#define LAS __attribute__((address_space(3)))
typedef unsigned short bf16;
typedef unsigned v4u __attribute__((ext_vector_type(4)));
typedef unsigned v2u __attribute__((ext_vector_type(2)));
typedef float f32x4 __attribute__((ext_vector_type(4)));
typedef float f32x16 __attribute__((ext_vector_type(16)));
typedef short bf16x8 __attribute__((ext_vector_type(8)));
typedef GAS unsigned gu32;
#define RLX_AGENT __ATOMIC_RELAXED, __HIP_MEMORY_SCOPE_AGENT
#define LDS_WAIT() asm volatile("s_waitcnt lgkmcnt(0)" ::: "memory")
#define VM_WAIT() asm volatile("s_waitcnt vmcnt(0)" ::: "memory")
__device__ __forceinline__ unsigned f2bf(float f) { unsigned u = __builtin_bit_cast(unsigned, f); return (u + 0x7fffu + ((u >> 16) & 1u)) >> 16; }
__device__ __forceinline__ unsigned pk2(float lo, float hi) { return f2bf(lo) | (f2bf(hi) << 16); }
__device__ __forceinline__ float bf2f(bf16 v) { return __uint_as_float((unsigned)v << 16); }
__device__ __forceinline__ float wave_sum(float v) {
#pragma unroll
    for (int o = 1; o < 64; o <<= 1) v += __shfl_xor(v, o);
    return v;
}
#define XB_TMO      128
#define XB_XCNT(j)  (256  + 64 * (j))
#define XB_XSUB(j)  (1280 + 64 * (j))
#define XB_XGEN(j)  (2304 + 64 * (j))
#define XB_TOP      3328
#define XB_TOPGEN   3392
#define XCD_BAR_WORDS 3456
#define XB_SPIN_CAP (1u << 18)

__device__ __forceinline__ unsigned xb_ld(unsigned* p)              { return __hip_atomic_load(p, __ATOMIC_RELAXED, __HIP_MEMORY_SCOPE_AGENT); }
__device__ __forceinline__ unsigned xb_add(unsigned* p, unsigned v) { return __hip_atomic_fetch_add(p, v, __ATOMIC_RELAXED, __HIP_MEMORY_SCOPE_AGENT); }
__device__ __forceinline__ unsigned xb_xcc_id() { return (unsigned)__builtin_amdgcn_s_getreg((3 << 11) | 20) & 0xFu; }
#define XB_SPIN(cond, bar) do { unsigned _sp = 0; while (cond) { __builtin_amdgcn_s_sleep(1); \
    if ((++_sp & 255u) == 0u) { if (xb_ld(&(bar)[XB_TMO])) break; if (_sp > XB_SPIN_CAP) { atomicAdd(&(bar)[XB_TMO], 1u); break; } } } } while (0)

struct XcdBarrier {
    unsigned* bar; unsigned x;
    volatile LAS unsigned* st;
};

__device__ __forceinline__ XcdBarrier xcd_barrier_post(unsigned* bar, volatile LAS unsigned* st) {
    XcdBarrier b; b.bar = bar; b.x = xb_xcc_id(); b.st = st;
    if (threadIdx.x == 0) st[2] = xb_add(&bar[XB_XCNT(b.x)], 1u);
    return b;
}
__device__ __forceinline__ void xcd_barrier_complete(unsigned* bar, unsigned x, unsigned& nloc, unsigned& nx) {
    const unsigned G = gridDim.x * gridDim.y * gridDim.z;
    unsigned sum, cnt, mine, sp = 0u;
    for (;;) {
        sum = 0u; cnt = 0u; mine = 0u;
#pragma unroll
        for (unsigned j = 0; j < 16; ++j) { const unsigned c = xb_ld(&bar[XB_XCNT(j)]); sum += c; cnt += (c > 0u) ? 1u : 0u; mine = (j == x) ? c : mine; }
        if (sum == G) break;
        __builtin_amdgcn_s_sleep(1);
        if ((++sp & 255u) == 0u) { if (xb_ld(&bar[XB_TMO])) break; if (sp > XB_SPIN_CAP) { atomicAdd(&bar[XB_TMO], 1u); break; } }
    }
    nloc = mine > 0u ? mine : 1u; nx = cnt > 0u ? cnt : 1u;
}

__device__ __forceinline__ void xcd_barrier(const XcdBarrier& b) {
    asm volatile("s_waitcnt vmcnt(0)" ::: "memory");
    __syncthreads();
    if (threadIdx.x == 0) {
        unsigned* bar = b.bar;
        __builtin_amdgcn_s_waitcnt(0);
        unsigned nloc = b.st[0], nx = b.st[1];
        if (nloc == 0u) { xcd_barrier_complete(bar, b.x, nloc, nx); b.st[0] = nloc; b.st[1] = nx; }
        const unsigned old = xb_add(&bar[XB_XSUB(b.x)], 1u);
        const unsigned gen = old / nloc;
        if (old + 1u == (gen + 1u) * nloc) {
            __builtin_amdgcn_fence(__ATOMIC_RELEASE, "agent");
            asm volatile("s_waitcnt vmcnt(0)" ::: "memory");
            const unsigned og = xb_add(&bar[XB_TOP], 1u);
            const unsigned tg = og / nx;
            if (og + 1u == (tg + 1u) * nx) xb_add(&bar[XB_TOPGEN], 1u);
            else XB_SPIN(xb_ld(&bar[XB_TOPGEN]) == tg, bar);
            __builtin_amdgcn_fence(__ATOMIC_ACQUIRE, "agent");
            xb_add(&bar[XB_XGEN(b.x)], 1u);
            asm volatile("s_waitcnt vmcnt(0)" ::: "memory");
        } else {
            XB_SPIN(xb_ld(&bar[XB_XGEN(b.x)]) == gen, bar);
            __builtin_amdgcn_fence(__ATOMIC_ACQUIRE, "agent");
            asm volatile("s_waitcnt vmcnt(0)" ::: "memory");
        }
    }
    __syncthreads();
}

__device__ __forceinline__ void p0_transpose_item(const float* W, int K, int N, bf16* WT, int mode, LAS float* scr, int item, int lane) {
    const int nblk = N / 32, kb = item / nblk, nb = item % nblk, k0 = 64 * kb, n0 = 32 * nb;
    float wv[32];
    const float* wp = W + (size_t)(k0 + (lane >> 5)) * N + n0 + (lane & 31);
#pragma unroll
    for (int i = 0; i < 32; ++i) wv[i] = wp[(size_t)(2 * i) * N];
#pragma unroll
    for (int i = 0; i < 32; ++i) scr[(2 * i + (lane >> 5)) * 33 + (lane & 31)] = wv[i];
    LDS_WAIT(); asm volatile("" ::: "memory");
    const int c = lane & 7;
#pragma unroll
    for (int j = 0; j < 4; ++j) { const int n = (lane >> 3) + 8 * j; const LAS float* s = scr + (8 * c) * 33 + n;
        v4u o; o.x = pk2(s[0 * 33], s[1 * 33]); o.y = pk2(s[2 * 33], s[3 * 33]); o.z = pk2(s[4 * 33], s[5 * 33]); o.w = pk2(s[6 * 33], s[7 * 33]);
        const int ng = n0 + n; const int drow = mode == 0 ? ng : (32 * (ng >> 4) + (ng & 15) + (mode == 2 ? 16 : 0));
        *(GAS v4u*)(WT + (size_t)drow * K + k0 + 8 * c) = o; }
    LDS_WAIT(); asm volatile("" ::: "memory");
}

template <bool HASY, int XOUT, bool HOUT>
__device__ __forceinline__ void rowpass_pipe(int lane, int first, int step, int M, const void* xin, bool xbf, const bf16* yin, void* xout, bf16* hout,
                                             const float* modg, const float* modh, int kss, int ksh, int mr_fixed) {
    int m = first; if (m >= M) return;
    f32x4 xr_[8]; v2u yc[8];
#pragma unroll
    for (int j = 0; j < 8; ++j) { xr_[j] = (f32x4){0.f, 0.f, 0.f, 0.f}; yc[j] = (v2u){0u, 0u}; }
    if (xbf) { const GAS v2u* xb = (const GAS v2u*)((const bf16*)xin + (size_t)m * DM) + lane;
#pragma unroll
        for (int j = 0; j < 8; ++j) { const v2u t = xb[64 * j]; xr_[j].x = __uint_as_float(t.x); xr_[j].y = __uint_as_float(t.y); } }
    else { const GAS f32x4* xr = (const GAS f32x4*)((const float*)xin + (size_t)m * DM) + lane;
#pragma unroll
        for (int j = 0; j < 8; ++j) xr_[j] = xr[64 * j]; }
    if (HASY) { const GAS v2u* yb = (const GAS v2u*)(yin + (size_t)m * DM) + lane;
#pragma unroll
        for (int j = 0; j < 8; ++j) yc[j] = yb[64 * j]; }
    for (;;) {
        const int mn = m + step; const bool hn = mn < M;
        const int mr = mr_fixed >= 0 ? mr_fixed : (m >> 11);
        f32x4 gg[8], sv[8], hv[8];
        if (HASY) { const GAS f32x4* p = (const GAS f32x4*)(modg + (size_t)mr * (NMOD * DM)) + lane;
#pragma unroll
            for (int j = 0; j < 8; ++j) gg[j] = p[64 * j]; }
        f32x4 xn[8]; v2u yn[8];
#pragma unroll
        for (int j = 0; j < 8; ++j) { xn[j] = xr_[j]; yn[j] = yc[j]; }
        if (hn) {
            if (xbf) { const GAS v2u* xb = (const GAS v2u*)((const bf16*)xin + (size_t)mn * DM) + lane;
#pragma unroll
                for (int j = 0; j < 8; ++j) { const v2u t = xb[64 * j]; xn[j].x = __uint_as_float(t.x); xn[j].y = __uint_as_float(t.y); } }
            else { const GAS f32x4* xr = (const GAS f32x4*)((const float*)xin + (size_t)mn * DM) + lane;
#pragma unroll
                for (int j = 0; j < 8; ++j) xn[j] = xr[64 * j]; }
            if (HASY) { const GAS v2u* yb = (const GAS v2u*)(yin + (size_t)mn * DM) + lane;
#pragma unroll
                for (int j = 0; j < 8; ++j) yn[j] = yb[64 * j]; } }
        f32x4 xc[8];
#pragma unroll
        for (int j = 0; j < 8; ++j) { const unsigned w0 = __float_as_uint(xr_[j].x), w1 = __float_as_uint(xr_[j].y);
            xc[j] = xbf ? (f32x4){pg8::bflo(w0), pg8::bfhi(w0), pg8::bflo(w1), pg8::bfhi(w1)} : xr_[j]; }
        if (HASY) { f32x4 yv[8]; float ss = 0.f;
#pragma unroll
            for (int j = 0; j < 8; ++j) { yv[j] = (f32x4){pg8::bflo(yc[j].x), pg8::bfhi(yc[j].x), pg8::bflo(yc[j].y), pg8::bfhi(yc[j].y)};
                ss += (yv[j].x * yv[j].x + yv[j].y * yv[j].y) + (yv[j].z * yv[j].z + yv[j].w * yv[j].w); }
            const float r = 1.0f / sqrtf(wave_sum(ss) * (1.0f / DM) + NORM_EPS);
#pragma unroll
            for (int j = 0; j < 8; ++j) xc[j] = xc[j] + gg[j] * (yv[j] * r); }
        if (XOUT == 1) { GAS f32x4* xo = (GAS f32x4*)((float*)xout + (size_t)m * DM) + lane;
#pragma unroll
            for (int j = 0; j < 8; ++j) xo[64 * j] = xc[j]; }
        if (XOUT == 2) { GAS v2u* xo = (GAS v2u*)((bf16*)xout + (size_t)m * DM) + lane;
#pragma unroll
            for (int j = 0; j < 8; ++j) { v2u w; w.x = pg8::cvt_pk_bf16(xc[j].x, xc[j].y); w.y = pg8::cvt_pk_bf16(xc[j].z, xc[j].w); xo[64 * j] = w; } }
        if (HOUT) { float ss = 0.f;
            if (HASY) __builtin_amdgcn_sched_barrier(0);
            { const GAS f32x4* p = (const GAS f32x4*)(modh + (size_t)mr * (NMOD * DM) + kss * DM) + lane; const GAS f32x4* q = (const GAS f32x4*)(modh + (size_t)mr * (NMOD * DM) + ksh * DM) + lane;
#pragma unroll
              for (int j = 0; j < 8; ++j) { sv[j] = p[64 * j]; hv[j] = q[64 * j]; } }
#pragma unroll
            for (int j = 0; j < 8; ++j) ss += (xc[j].x * xc[j].x + xc[j].y * xc[j].y) + (xc[j].z * xc[j].z + xc[j].w * xc[j].w);
            const float r = 1.0f / sqrtf(wave_sum(ss) * (1.0f / DM) + NORM_EPS);
            GAS v2u* ho = (GAS v2u*)(hout + (size_t)m * DM) + lane;
#pragma unroll
            for (int j = 0; j < 8; ++j) { const f32x4 h = (xc[j] * r) * sv[j] + hv[j];
                v2u w; w.x = pg8::cvt_pk_bf16(h.x, h.y); w.y = pg8::cvt_pk_bf16(h.z, h.w); ho[64 * j] = w; } }
        if (!hn) break;
#pragma unroll
        for (int j = 0; j < 8; ++j) { xr_[j] = xn[j]; yc[j] = yn[j]; }
        m = mn;
    }
}
__device__ __forceinline__ void rowpass_ctx8(LAS float* red, int lane, int wave, int vcu, int G, const void* xin, bool xbf, const bf16* slab, bf16* xout, bf16* hout,
                                             const float* gg, const float* sv, const float* hv) {
    for (int base = vcu * 4; base < RC; base += G * 4) {
        const int row = base + (wave >> 1); const size_t off = (size_t)row * DM + (wave & 1) * 1024; const int co = (wave & 1) * 1024;
        f32x4 xv[4], yv[4];
        v2u yb[8][4];
#pragma unroll
        for (int sl = 0; sl < 8; ++sl) { const GAS v2u* ys = (const GAS v2u*)(slab + (size_t)sl * RC * DM + off) + lane;
#pragma unroll
            for (int j = 0; j < 4; ++j) yb[sl][j] = ys[64 * j]; }
        if (xbf) { const GAS v2u* xb = (const GAS v2u*)((const bf16*)xin + off) + lane;
#pragma unroll
            for (int j = 0; j < 4; ++j) { const v2u t = xb[64 * j]; xv[j] = (f32x4){pg8::bflo(t.x), pg8::bfhi(t.x), pg8::bflo(t.y), pg8::bfhi(t.y)}; } }
        else { const GAS f32x4* xr = (const GAS f32x4*)((const float*)xin + off) + lane;
#pragma unroll
            for (int j = 0; j < 4; ++j) xv[j] = xr[64 * j]; }
#pragma unroll
        for (int j = 0; j < 4; ++j) { yv[j] = (f32x4){0.f, 0.f, 0.f, 0.f};
#pragma unroll
            for (int sl = 0; sl < 8; ++sl) yv[j] = yv[j] + (f32x4){pg8::bflo(yb[sl][j].x), pg8::bfhi(yb[sl][j].x), pg8::bflo(yb[sl][j].y), pg8::bfhi(yb[sl][j].y)}; }
        float ss = 0.f;
#pragma unroll
        for (int j = 0; j < 4; ++j) ss += (yv[j].x * yv[j].x + yv[j].y * yv[j].y) + (yv[j].z * yv[j].z + yv[j].w * yv[j].w);
        ss = wave_sum(ss); if (lane == 0) red[wave] = ss;
        LDS_WAIT(); __syncthreads();
        float r = 1.0f / sqrtf((red[wave] + red[wave ^ 1]) * (1.0f / DM) + NORM_EPS);
        const GAS f32x4* gp = (const GAS f32x4*)(gg + co) + lane;
#pragma unroll
        for (int j = 0; j < 4; ++j) xv[j] = xv[j] + gp[64 * j] * (yv[j] * r);
        GAS v2u* xo = (GAS v2u*)(xout + off) + lane;
#pragma unroll
        for (int j = 0; j < 4; ++j) { v2u w; w.x = pg8::cvt_pk_bf16(xv[j].x, xv[j].y); w.y = pg8::cvt_pk_bf16(xv[j].z, xv[j].w); xo[64 * j] = w; }
        ss = 0.f;
#pragma unroll
        for (int j = 0; j < 4; ++j) ss += (xv[j].x * xv[j].x + xv[j].y * xv[j].y) + (xv[j].z * xv[j].z + xv[j].w * xv[j].w);
        ss = wave_sum(ss); if (lane == 0) red[8 + wave] = ss;
        LDS_WAIT(); __syncthreads();
        r = 1.0f / sqrtf((red[8 + wave] + red[8 + (wave ^ 1)]) * (1.0f / DM) + NORM_EPS);
        const GAS f32x4* sp = (const GAS f32x4*)(sv + co) + lane; const GAS f32x4* hp = (const GAS f32x4*)(hv + co) + lane; GAS v2u* ho = (GAS v2u*)(hout + off) + lane;
#pragma unroll
        for (int j = 0; j < 4; ++j) { const f32x4 h = (xv[j] * r) * sp[64 * j] + hp[64 * j];
            v2u w; w.x = pg8::cvt_pk_bf16(h.x, h.y); w.y = pg8::cvt_pk_bf16(h.z, h.w); ho[64 * j] = w; }
        LDS_WAIT();
    }
}

#define MFMA32(a, b, c) __builtin_amdgcn_mfma_f32_32x32x16_bf16(a, b, c, 0, 0, 0)
#define MFMA16(a, b, c) __builtin_amdgcn_mfma_f32_16x16x32_bf16(a, b, c, 0, 0, 0)
struct ScanPtrs { const float *lam_re, *lam_im, *log_dt, *b_re, *b_im, *c_re, *c_im, *dsk; const bf16* U; float* YP; bf16* ACT; };

__device__ __forceinline__ void s5_disc(const float* lam_re, const float* lam_im, int ldg, int pp, float dt, float& lbr, float& lbi, float& cr, float& ci) {
    const float lr = lam_re[ldg * 64 + pp], li = lam_im[ldg * 64 + pp];
    const float a = lr * dt, th = li * dt; float sn, cs; sincosf(th, &sn, &cs);
    const float em1 = expm1f(a), mag = em1 + 1.0f; float sh_, ch_; sincosf(0.5f * th, &sh_, &ch_);
    lbr = mag * cs; lbi = mag * sn;
    const float nr = em1 * cs - 2.0f * sh_ * sh_, ni = lbi;
    const float den = 1.0f / (lr * lr + li * li);
    cr = (nr * lr + ni * li) * den; ci = (ni * lr - nr * li) * den;
}
__device__ __forceinline__ float gelu_tanh(float y) { const float z = 0.7978845608028654f * (y + 0.044715f * y * y * y); return y * pg8::sigm(2.0f * z); }

constexpr int SELF_CI = 22;
template <bool REV>
__device__ __forceinline__ void scan_chain(LAS unsigned char* sl, LAS unsigned* flags, int layer, int b, int g, const ScanPtrs P, int lane, bool ctx_out) {
    const int d = REV ? 1 : 0, ldg = (layer * 2 + d) * 64 + g, hh = lane >> 5, l31 = lane & 31;
    const float dt = expf(P.log_dt[ldg]);
    float lb0r, lb0i, c0r, c0i, lb1r, lb1i, c1r, c1i;
    s5_disc(P.lam_re, P.lam_im, ldg, l31, dt, lb0r, lb0i, c0r, c0i);
    s5_disc(P.lam_re, P.lam_im, ldg, 32 + l31, dt, lb1r, lb1i, c1r, c1i);
    const float lr = hh ? lb1r : lb0r, li = hh ? lb1i : lb0i;
    bf16x8 bfr[4];
#pragma unroll
    for (int j = 0; j < 4; ++j) { const int pp = l31 + 32 * (j & 1); const float cr = (j & 1) ? c1r : c0r, ci = (j & 1) ? c1i : c0i;
        const float* br = P.b_re + ((size_t)ldg * 64 + pp) * 16 + 8 * hh; const float* bi = P.b_im + ((size_t)ldg * 64 + pp) * 16 + 8 * hh;
        const f32x4 r0 = *(const f32x4*)br, r1 = *(const f32x4*)(br + 4), i0 = *(const f32x4*)bi, i1 = *(const f32x4*)(bi + 4);
        f32x4 v0, v1; if (j < 2) { v0 = r0 * cr - i0 * ci; v1 = r1 * cr - i1 * ci; } else { v0 = i0 * cr + r0 * ci; v1 = i1 * cr + r1 * ci; }
        v4u w; w.x = pk2(v0.x, v0.y); w.y = pk2(v0.z, v0.w); w.z = pk2(v1.x, v1.y); w.w = pk2(v1.z, v1.w); bfr[j] = __builtin_bit_cast(bf16x8, w); }
    const int cc = lane & 15, kq = lane >> 4;
    bf16x8 cfr[4];
#pragma unroll
    for (int s = 0; s < 4; ++s) { const size_t o = ((size_t)ldg * 16 + cc) * 64 + 16 * s + 4 * kq; const f32x4 re = *(const f32x4*)(P.c_re + o), im = *(const f32x4*)(P.c_im + o);
        v4u w; w.x = pk2(re.x, -im.x); w.y = pk2(re.y, -im.y); w.z = pk2(re.z, -im.z); w.w = pk2(re.w, -im.w); cfr[s] = __builtin_bit_cast(bf16x8, w); }
    LAS unsigned char* SB = sl;
    float sr = 0.f, si = 0.f; int pend0 = -1, pend1 = -1;
    auto rowbase_of = [&](int ci) -> int { if (ci < 4) { const int c4 = REV ? 3 - ci : ci; return RL + b * CTX + c4 * 64; } const int lc = ci - 4, c32 = REV ? 31 - lc : lc; return b * SEQ + c32 * 64; };
    bf16x8 ufr[2], un1[2], un2[2];
    { const int rb = rowbase_of(0), r1 = rowbase_of(1);
#pragma unroll
      for (int i = 0; i < 2; ++i) { ufr[i] = *(const bf16x8*)(P.U + (size_t)(rb + 32 * i + l31) * 1024 + g * 16 + 8 * hh); un1[i] = *(const bf16x8*)(P.U + (size_t)(r1 + 32 * i + l31) * 1024 + g * 16 + 8 * hh); } }
    un2[0] = un1[0]; un2[1] = un1[1];
    const f32x4 dk4 = *(const f32x4*)(P.dsk + layer * 1024 + g * 16 + 4 * kq);
    for (int ci = 0; ci < 36; ++ci) {
        const int rb = rowbase_of(ci);
        const int fidx = ci < 4 ? (REV ? 3 - ci : ci) : 4 + (REV ? 35 - ci : ci - 4);
        const bool selfc = ci >= SELF_CI;
        unsigned long long op[8]; v2u uu[4];
#pragma unroll
        for (int e = 0; e < 4; ++e) { op[2 * e] = 0ull; op[2 * e + 1] = 0ull; uu[e] = (v2u){0u, 0u}; }
        if (selfc) {
            while (__hip_atomic_load(flags + fidx, __ATOMIC_RELAXED, __HIP_MEMORY_SCOPE_WORKGROUP) < 1u) __builtin_amdgcn_s_sleep(2);
            asm volatile("" ::: "memory");
            const size_t eo = (size_t)(rb + cc) * 1024 + g * 16 + 4 * kq;
            const unsigned long long* opp = (const unsigned long long*)(P.YP + (size_t)(1 - d) * RT * 1024 + eo); const bf16* upp = P.U + eo;
#pragma unroll
            for (int f = 0; f < 4; ++f) { op[2 * f] = __hip_atomic_load(opp + (size_t)f * 8192, RLX_AGENT); op[2 * f + 1] = __hip_atomic_load(opp + (size_t)f * 8192 + 1, RLX_AGENT); uu[f] = *(const v2u*)(upp + (size_t)f * 16384); }
        }
        if (ci + 2 < 36) { const int rn = rowbase_of(ci + 2);
#pragma unroll
            for (int i = 0; i < 2; ++i) un2[i] = *(const bf16x8*)(P.U + (size_t)(rn + 32 * i + l31) * 1024 + g * 16 + 8 * hh); }
#pragma unroll
        for (int ib = 0; ib < 2; ++ib) { const int i = REV ? 1 - ib : ib;
            const f32x16 z = {0.f, 0.f, 0.f, 0.f, 0.f, 0.f, 0.f, 0.f, 0.f, 0.f, 0.f, 0.f, 0.f, 0.f, 0.f, 0.f};
            f32x16 x0 = MFMA32(ufr[i], bfr[0], z), x1 = MFMA32(ufr[i], bfr[1], z), x2 = MFMA32(ufr[i], bfr[2], z), x3 = MFMA32(ufr[i], bfr[3], z);
#pragma unroll
            for (int r = 0; r < 16; ++r) {
                auto pa = __builtin_amdgcn_permlane32_swap(__float_as_uint(x0[r]), __float_as_uint(x1[r]), false, false); x0[r] = __uint_as_float(pa[0]); x1[r] = __uint_as_float(pa[1]);
                auto pc = __builtin_amdgcn_permlane32_swap(__float_as_uint(x2[r]), __float_as_uint(x3[r]), false, false); x2[r] = __uint_as_float(pc[0]); x3[r] = __uint_as_float(pc[1]);
            }
#pragma unroll
            for (int k = 0; k < 32; ++k) { const int t = REV ? 31 - k : k; const int tg = (t >> 2) & 1, rg = (t & 3) + 4 * (t >> 3);
                const float xr = tg ? x1[rg] : x0[rg], xi = tg ? x3[rg] : x2[rg];
                const float nr = fmaf(-li, si, fmaf(lr, sr, xr)), ni = fmaf(li, sr, fmaf(lr, si, xi)); sr = nr; si = ni;
                *(LAS unsigned*)(SB + (32 * i + t) * 272 + lane * 4) = pg8::cvt_pk_bf16(sr, si); }
        }
        LDS_WAIT(); asm volatile("" ::: "memory");
        if (ci >= 4 || ctx_out) {
            f32x4 ya[4];
#pragma unroll
            for (int f = 0; f < 4; ++f) { f32x4 a = {0.f, 0.f, 0.f, 0.f};
#pragma unroll
                for (int s = 0; s < 4; ++s) { const bf16x8 af = *(const LAS bf16x8*)(SB + (16 * f + cc) * 272 + (32 * s + 8 * kq) * 2); a = MFMA16(cfr[s], af, a); }
                ya[f] = a; }
            if (!selfc) {
            asm volatile("s_waitcnt vmcnt(6)" ::: "memory");
            if (pend1 >= 0 && lane == 0) (void)__hip_atomic_fetch_add(flags + pend1, 1u, __ATOMIC_RELAXED, __HIP_MEMORY_SCOPE_WORKGROUP);
            pend1 = pend0; pend0 = fidx;
            float* myp = P.YP + ((size_t)d * RT + rb + cc) * 1024 + g * 16 + 4 * kq;
#pragma unroll
            for (int f = 0; f < 4; ++f) *(f32x4*)(myp + (size_t)f * 16384) = ya[f];
            } else {
                VM_WAIT();
                if (lane == 0) { if (pend1 >= 0) (void)__hip_atomic_fetch_add(flags + pend1, 1u, __ATOMIC_RELAXED, __HIP_MEMORY_SCOPE_WORKGROUP);
                                 if (pend0 >= 0) (void)__hip_atomic_fetch_add(flags + pend0, 1u, __ATOMIC_RELAXED, __HIP_MEMORY_SCOPE_WORKGROUP); }
                pend1 = -1; pend0 = -1;
                bf16* ap = P.ACT + (size_t)(rb + cc) * 1024 + g * 16 + 4 * kq;
#pragma unroll
                for (int f = 0; f < 4; ++f) {
                    const float y0 = ya[f][0] + __uint_as_float((unsigned)op[2 * f]) + dk4[0] * pg8::bflo(uu[f].x), y1 = ya[f][1] + __uint_as_float((unsigned)(op[2 * f] >> 32)) + dk4[1] * pg8::bfhi(uu[f].x);
                    const float y2 = ya[f][2] + __uint_as_float((unsigned)op[2 * f + 1]) + dk4[2] * pg8::bflo(uu[f].y), y3 = ya[f][3] + __uint_as_float((unsigned)(op[2 * f + 1] >> 32)) + dk4[3] * pg8::bfhi(uu[f].y);
                    v2u w; w.x = pg8::cvt_pk_bf16(gelu_tanh(y0), gelu_tanh(y1)); w.y = pg8::cvt_pk_bf16(gelu_tanh(y2), gelu_tanh(y3)); *(v2u*)(ap + (size_t)f * 16384) = w; }
            }
        }
        ufr[0] = un1[0]; ufr[1] = un1[1]; un1[0] = un2[0]; un1[1] = un2[1];
    }
    VM_WAIT();
    if (lane == 0) { if (pend1 >= 0) (void)__hip_atomic_fetch_add(flags + pend1, 1u, __ATOMIC_RELAXED, __HIP_MEMORY_SCOPE_WORKGROUP);
                     if (pend0 >= 0) (void)__hip_atomic_fetch_add(flags + pend0, 1u, __ATOMIC_RELAXED, __HIP_MEMORY_SCOPE_WORKGROUP); }
}


__device__ __forceinline__ void scan_combine(const ScanPtrs P, int layer, int b, int g, int fidx, int lane) {
    const int rb = fidx < 4 ? RL + b * CTX + fidx * 64 : b * SEQ + (fidx - 4) * 64;
    const size_t ro = (size_t)(rb + lane) * 1024 + g * 16;
    const unsigned long long* p0 = (const unsigned long long*)(P.YP + ro); const unsigned long long* p1 = (const unsigned long long*)(P.YP + (size_t)RT * 1024 + ro);
    unsigned long long a[8], c[8];
#pragma unroll
    for (int i = 0; i < 8; ++i) { a[i] = __hip_atomic_load(p0 + i, RLX_AGENT); c[i] = __hip_atomic_load(p1 + i, RLX_AGENT); }
    const v4u u0 = *(const v4u*)(P.U + ro), u1 = *(const v4u*)(P.U + ro + 8);
    const unsigned uw[8] = {u0.x, u0.y, u0.z, u0.w, u1.x, u1.y, u1.z, u1.w};
    const float* dk = P.dsk + layer * 1024 + g * 16;
    unsigned ow[8];
#pragma unroll
    for (int i = 0; i < 8; ++i) {
        const float y0 = __uint_as_float((unsigned)a[i]) + __uint_as_float((unsigned)c[i]) + dk[2 * i] * pg8::bflo(uw[i]);
        const float y1 = __uint_as_float((unsigned)(a[i] >> 32)) + __uint_as_float((unsigned)(c[i] >> 32)) + dk[2 * i + 1] * pg8::bfhi(uw[i]);
        ow[i] = pg8::cvt_pk_bf16(gelu_tanh(y0), gelu_tanh(y1)); }
    v4u o0 = {ow[0], ow[1], ow[2], ow[3]}, o1 = {ow[4], ow[5], ow[6], ow[7]};
    *(v4u*)(P.ACT + ro) = o0; *(v4u*)(P.ACT + ro + 8) = o1;
}
struct AttPtrs { const bf16 *Q, *K, *VTl, *VTc; bf16* O; const float* rpb; };
constexpr int ATT_KS = 144, ATT_VS = 80, ATT_TILE = 32 * ATT_KS + 64 * ATT_VS;
struct AttG { v4u k[4], v[4]; };
__device__ __forceinline__ void att_gload(AttG& G, const bf16* kblk, const bf16* vblk, int vstride, int lane) {
#pragma unroll
    for (int i = 0; i < 4; ++i) { G.k[i] = *(const v4u*)(kblk + (size_t)(8 * i + (lane >> 3)) * 1024 + (lane & 7) * 8);
                                  G.v[i] = *(const v4u*)(vblk + (size_t)(16 * i + (lane >> 2)) * vstride + (lane & 3) * 8); }
}
__device__ __forceinline__ void att_lwrite(const AttG& G, LAS unsigned char* tile, int lane) {
#pragma unroll
    for (int i = 0; i < 4; ++i) { *(LAS v4u*)(tile + (8 * i + (lane >> 3)) * ATT_KS + (lane & 7) * 16) = G.k[i];
        LAS unsigned char* vp = tile + 32 * ATT_KS + (16 * i + (lane >> 2)) * ATT_VS + 32 * ((lane & 3) >> 1) + 8 * (lane & 1); v2u lo = {G.v[i].x, G.v[i].y}, hi = {G.v[i].z, G.v[i].w}; *(LAS v2u*)vp = lo; *(LAS v2u*)(vp + 16) = hi; }
}
struct AttF { bf16x8 k[4]; v2u v[8]; };
__device__ __forceinline__ void att_fread(AttF& F, const LAS unsigned char* tile, int lane) {
    const int q = lane & 31, hh = lane >> 5;
#pragma unroll
    for (int ss = 0; ss < 4; ++ss) F.k[ss] = *(const LAS bf16x8*)(tile + q * ATT_KS + (16 * ss + 8 * hh) * 2);
#pragma unroll
    for (int f = 0; f < 2; ++f)
#pragma unroll
        for (int s2 = 0; s2 < 2; ++s2) { const v4u w = *(const LAS v4u*)(tile + 32 * ATT_KS + (32 * f + q) * ATT_VS + 32 * s2 + 16 * hh); F.v[(f * 2 + s2) * 2] = (v2u){w.x, w.y}; F.v[(f * 2 + s2) * 2 + 1] = (v2u){w.z, w.w}; }
}
__device__ __forceinline__ void att_compute(const AttF& B, const bf16x8 (&qf)[4], f32x16& o0, f32x16& o1, float& mrun, float& lrun, bool local, const unsigned (&colb)[4], unsigned rowb) {
    f32x16 s = {0.f, 0.f, 0.f, 0.f, 0.f, 0.f, 0.f, 0.f, 0.f, 0.f, 0.f, 0.f, 0.f, 0.f, 0.f, 0.f};
#pragma unroll
    for (int ss = 0; ss < 4; ++ss) s = MFMA32(B.k[ss], qf[ss], s);
    if (local) {
        float bs[16];
#pragma unroll
        for (int r = 0; r < 16; ++r) bs[r] = *(const LAS float*)(size_t)(((colb[r >> 2] >> (8 * (r & 3))) & 0xffu) + rowb);
#pragma unroll
        for (int r = 0; r < 16; ++r) s[r] += bs[r];
    }
    float bm = s[0];
#pragma unroll
    for (int r = 1; r < 16; ++r) bm = fmaxf(bm, s[r]);
    bm = fmaxf(bm, __shfl_xor(bm, 32));
    if (__any(bm > mrun)) {
        const float mn = fmaxf(mrun, bm), alpha = __builtin_amdgcn_exp2f(mrun - mn); mrun = mn;
        lrun = lrun * alpha; o0 = o0 * alpha; o1 = o1 * alpha;
    }
    float p[16]; float ps = 0.f;
#pragma unroll
    for (int r = 0; r < 16; ++r) { p[r] = __builtin_amdgcn_exp2f(s[r] - mrun); ps += p[r]; }
    lrun += ps;
#pragma unroll
    for (int s2 = 0; s2 < 2; ++s2) { v4u w; w.x = pg8::cvt_pk_bf16(p[8 * s2], p[8 * s2 + 1]); w.y = pg8::cvt_pk_bf16(p[8 * s2 + 2], p[8 * s2 + 3]);
        w.z = pg8::cvt_pk_bf16(p[8 * s2 + 4], p[8 * s2 + 5]); w.w = pg8::cvt_pk_bf16(p[8 * s2 + 6], p[8 * s2 + 7]); const bf16x8 pf = __builtin_bit_cast(bf16x8, w);
        { v4u a = {B.v[s2 * 2].x, B.v[s2 * 2].y, B.v[s2 * 2 + 1].x, B.v[s2 * 2 + 1].y}; o0 = MFMA32(__builtin_bit_cast(bf16x8, a), pf, o0); }
        { v4u a = {B.v[(2 + s2) * 2].x, B.v[(2 + s2) * 2].y, B.v[(2 + s2) * 2 + 1].x, B.v[(2 + s2) * 2 + 1].y}; o1 = MFMA32(__builtin_bit_cast(bf16x8, a), pf, o1); } }
}
__device__ __forceinline__ void att_item(int item, int layer, const AttPtrs P, LAS unsigned char* tile, LAS float* btab, int& tab_head, int lane) {
    const int q = lane & 31, hh = lane >> 5;
    const bool local = item < 4096;
    int b, h, r = 0, half = 0, qrow;
    if (local) { half = item & 1; r = (item >> 1) & 31; h = (item >> 6) & 15; b = item >> 10; qrow = b * SEQ + r * 64 + half * 32 + q; }
    else { const int it = item - 4096; const int qb = it & 7; h = (it >> 3) & 15; b = it >> 7; qrow = RL + b * CTX + qb * 32 + q; }
    if (local && tab_head != h) {
        LDS_WAIT(); asm volatile("" ::: "memory");
        const float* src = P.rpb + ((size_t)layer * NHEAD + h) * 465;
        for (int i = lane; i < 480; i += 64) { const int ro = i >> 5, j = i & 31; btab[i] = j < 31 ? src[ro * 31 + j] * LOG2E : -1e30f; }
        LDS_WAIT(); asm volatile("" ::: "memory");
        tab_head = h;
    }
    bf16x8 qf[4];
#pragma unroll
    for (int s = 0; s < 4; ++s) qf[s] = *(const bf16x8*)(P.Q + (size_t)qrow * 1024 + h * 64 + 16 * s + 8 * hh);
    f32x16 o0 = {0.f, 0.f, 0.f, 0.f, 0.f, 0.f, 0.f, 0.f, 0.f, 0.f, 0.f, 0.f, 0.f, 0.f, 0.f, 0.f}, o1 = o0; float mrun = -1e30f, lrun = 0.f;
    const bf16* vtc = P.VTc + (size_t)(b * 16 + h) * 64 * CTX;
    const bf16* kc = P.K + (size_t)(RL + b * CTX) * 1024 + h * 64;
    int r0 = r - 4; r0 = r0 < 0 ? 0 : (r0 > 24 ? 24 : r0);
    const int c = half * 32 + q; int c0 = c - 8; c0 = c0 < 0 ? 0 : (c0 > 48 ? 48 : c0);
    const bf16* vtl = P.VTl + (size_t)(b * 16 + h) * 64 * SEQ;
    const bf16* kl = P.K + (size_t)(b * SEQ) * 1024 + h * 64;
    unsigned colb0[4] = {0u, 0u, 0u, 0u}, colb1[4] = {0u, 0u, 0u, 0u}; const unsigned tb = (unsigned)(size_t)btab;
#pragma unroll
    for (int rr = 0; rr < 16; ++rr) { const int k0 = (rr & 3) + 8 * (rr >> 2) + 4 * hh, k1 = 32 + k0;
        colb0[rr >> 2] |= (4u * (unsigned)(((unsigned)(k0 - c0) < 16u) ? k0 - c + 15 : 31)) << (8 * (rr & 3)); colb1[rr >> 2] |= (4u * (unsigned)(((unsigned)(k1 - c0) < 16u) ? k1 - c + 15 : 31)) << (8 * (rr & 3)); }
    const int npair = local ? 12 : 4;
    auto gl = [&](AttG& G, int i) { if (i < 8) att_gload(G, kc + (size_t)(32 * i) * 1024, vtc + 32 * i, CTX, lane);
                                    else { const int j = i - 8, t0 = (r0 + (j >> 1)) * 64 + 32 * (j & 1); att_gload(G, kl + (size_t)t0 * 1024, vtl + t0, SEQ, lane); } };
    const int nblk = 2 * npair;
    AttG G; gl(G, 0);
    att_lwrite(G, tile, lane);
    gl(G, 1);
    for (int p = 0; p < npair; ++p) {
        const bool loc = p >= 4; const unsigned rowb = tb + (loc ? (unsigned)((r0 + (p - 4) - r + 7) * 128) : 0u);
        { AttF F; LDS_WAIT(); asm volatile("" ::: "memory"); att_fread(F, tile, lane); LDS_WAIT(); asm volatile("" ::: "memory");
          att_lwrite(G, tile, lane); gl(G, 2 * p + 2 < nblk ? 2 * p + 2 : nblk - 1);
          att_compute(F, qf, o0, o1, mrun, lrun, loc, colb0, rowb); }
        { AttF F; LDS_WAIT(); asm volatile("" ::: "memory"); att_fread(F, tile, lane); LDS_WAIT(); asm volatile("" ::: "memory");
          att_lwrite(G, tile, lane); gl(G, 2 * p + 3 < nblk ? 2 * p + 3 : nblk - 1);
          att_compute(F, qf, o0, o1, mrun, lrun, loc, colb1, rowb); }
    }
    const float inv = 1.0f / (lrun + __shfl_xor(lrun, 32));
    bf16* op = P.O + (size_t)qrow * 1024 + h * 64 + 4 * hh;
#pragma unroll
    for (int g4 = 0; g4 < 4; ++g4) {
        v2u w0, w1; w0.x = pg8::cvt_pk_bf16(o0[4 * g4] * inv, o0[4 * g4 + 1] * inv); w0.y = pg8::cvt_pk_bf16(o0[4 * g4 + 2] * inv, o0[4 * g4 + 3] * inv);
        w1.x = pg8::cvt_pk_bf16(o1[4 * g4] * inv, o1[4 * g4 + 1] * inv); w1.y = pg8::cvt_pk_bf16(o1[4 * g4 + 2] * inv, o1[4 * g4 + 3] * inv);
        *(v2u*)(op + 8 * g4) = w0; *(v2u*)(op + 32 + 8 * g4) = w1; }
}

#ifndef REPEAT_MASK
#define REPEAT_MASK 0
#endif
#ifndef PROBE_SCAN_REP
#define PROBE_SCAN_REP 1
#endif
#ifndef PROBE_ATT_REP
#define PROBE_ATT_REP 1
#endif
#ifndef PHASE_MASK
#define PHASE_MASK 2047
#endif
constexpr int NPH = 2 + 8 * DEPTH;
struct Args { const float* in[26]; float* out; unsigned char* ws; int ph_lo, ph_hi, use_bar, pad; };
typedef const __attribute__((address_space(4))) Args* KArgs;
#define KARGS(ka) KArgs ka = (KArgs)__builtin_amdgcn_kernarg_segment_ptr(); asm volatile("" : "+s"(ka))

constexpr int I_IN = (DM / 64) * (PW / 32), I_VG = (SSMW / 64) * (DM / 32), I_NA = (NAW / 64) * (DM / 32), I_OUT = (DM / 64) * (DM / 32), I_F1 = (DM / 64) * (DFF / 32), I_F2 = (DFF / 64) * (DM / 32);
constexpr int I_MIX = I_IN + 2 * I_VG + I_NA + I_OUT, I_LAYER = I_MIX + I_F1 + I_F2;
__device__ __forceinline__ void conv_item(KArgs ka, unsigned char* ws, int l, int r, LAS float* scr, int lane) {
    unsigned char* wb = ws + WS_W + (size_t)l * W_LAYER;
    const float* src; int K, N, mode; size_t wo;
    if (r < I_IN) { src = ka->in[10] + (size_t)l * DM * PW; K = DM; N = PW; mode = 0; wo = WO_IN; }
    else if ((r -= I_IN) < I_VG) { src = ka->in[19] + (size_t)l * SSMW * DM; K = SSMW; N = DM; mode = 1; wo = WO_VG; }
    else if ((r -= I_VG) < I_VG) { src = ka->in[20] + (size_t)l * SSMW * DM; K = SSMW; N = DM; mode = 2; wo = WO_VG; }
    else if ((r -= I_VG) < I_NA) { src = ka->in[22] + (size_t)l * NAW * DM; K = NAW; N = DM; mode = 0; wo = WO_NA; }
    else if ((r -= I_NA) < I_OUT) { src = ka->in[23] + (size_t)l * DM * DM; K = DM; N = DM; mode = 0; wo = WO_OUT; }
    else if ((r -= I_OUT) < I_F1) { src = ka->in[24] + (size_t)l * DM * DFF; K = DM; N = DFF; mode = 0; wo = WO_FC1; }
    else { r -= I_F1; src = ka->in[25] + (size_t)l * DFF * DM; K = DFF; N = DM; mode = 0; wo = WO_FC2; }
    p0_transpose_item(src, K, N, (bf16*)(wb + wo), mode, scr, r, lane);
}

__device__ __forceinline__ void mod_gemv_items(KArgs ka, unsigned char* ws, LAS unsigned char* lds, int tid, int lane, int wave, int it0, int it1, int step, unsigned* qctr, int skip_lo, int skip_n) {
        {
            const float* c_in = ka->in[1]; const float* cctx_in = ka->in[3]; const float* w_mod = ka->in[4]; const float* b_mod = ka->in[5]; float* MOD = (float*)(ws + WS_MOD);
            LAS float* SIL = (LAS float*)(lds + 71680); LAS float* PART = (LAS float*)(lds + 112640);
            for (int i = tid; i < 5 * DM; i += NWAVES * 64) { const int r = i >> 11, k = i & 2047; const float v = r < 4 ? c_in[r * DM + k] : cctx_in[k]; SIL[i] = v / (1.0f + expf(-v)); }
            __syncthreads();
            for (int it = it0; ; ) {
                if (qctr) { LAS int* qs = (LAS int*)(lds + MISC_OFF + 4096 + 128);
                    if (tid == 0) *qs = it0 + (int)__hip_atomic_fetch_add(qctr, 1u, __ATOMIC_RELAXED, __HIP_MEMORY_SCOPE_AGENT);
                    LDS_WAIT(); __syncthreads(); it = __builtin_amdgcn_readfirstlane(*qs); }
                if (it >= it1) break;
                const int itm = it < skip_lo ? it : it + skip_n;
                const int l = itm / 192, jn = itm % 192, col = jn * 64 + lane, k0 = wave * 256;
                const float* W = w_mod + (size_t)l * DM * (NMOD * DM) + (size_t)k0 * (NMOD * DM) + col;
                float a0 = 0.f, a1 = 0.f, a2 = 0.f, a3 = 0.f, a4 = 0.f;
#pragma unroll 4
                for (int kk = 0; kk < 256; kk += 4) {
                    const float w0 = W[(size_t)(kk + 0) * (NMOD * DM)], w1 = W[(size_t)(kk + 1) * (NMOD * DM)], w2 = W[(size_t)(kk + 2) * (NMOD * DM)], w3 = W[(size_t)(kk + 3) * (NMOD * DM)];
                    const f32x4 s0 = *(const LAS f32x4*)(SIL + 0 * DM + k0 + kk), s1 = *(const LAS f32x4*)(SIL + 1 * DM + k0 + kk), s2 = *(const LAS f32x4*)(SIL + 2 * DM + k0 + kk),
                                s3 = *(const LAS f32x4*)(SIL + 3 * DM + k0 + kk), s4 = *(const LAS f32x4*)(SIL + 4 * DM + k0 + kk);
                    a0 += s0.x * w0 + s0.y * w1 + s0.z * w2 + s0.w * w3; a1 += s1.x * w0 + s1.y * w1 + s1.z * w2 + s1.w * w3; a2 += s2.x * w0 + s2.y * w1 + s2.z * w2 + s2.w * w3;
                    a3 += s3.x * w0 + s3.y * w1 + s3.z * w2 + s3.w * w3; a4 += s4.x * w0 + s4.y * w1 + s4.z * w2 + s4.w * w3;
                }
                PART[(wave * 5 + 0) * 64 + lane] = a0; PART[(wave * 5 + 1) * 64 + lane] = a1; PART[(wave * 5 + 2) * 64 + lane] = a2; PART[(wave * 5 + 3) * 64 + lane] = a3; PART[(wave * 5 + 4) * 64 + lane] = a4;
                __syncthreads();
                if (wave < 5) { float s = b_mod[l * (NMOD * DM) + col];
#pragma unroll
                    for (int w = 0; w < 8; ++w) s += PART[(w * 5 + wave) * 64 + lane];
                    const int kidx = jn >> 5, c = col & (DM - 1);
                    if (kidx == 1) s = ka->in[6][l * DM + c] * (1.0f + s); else if (kidx == 2) s *= ka->in[7][l * DM + c];
                    else if (kidx == 4) s = ka->in[8][l * DM + c] * (1.0f + s); else if (kidx == 5) s *= ka->in[9][l * DM + c];
                    MOD[(size_t)(l * 5 + wave) * (NMOD * DM) + col] = s; }
                __syncthreads();
                if (!qctr) it += step;
            }
        }
}
#define IDLE_COPY(nun, cl, lo_, hi_) do { const int first_ = (nun) % G; if (first_ != 0 && bx >= first_) { const int nid_ = G - first_, j_ = bx - first_, per_ = ((hi_) - (lo_) + nid_ - 1) / nid_; \
        const int a_ = (lo_) + j_ * per_, b_ = (a_ + per_ < (hi_)) ? a_ + per_ : (hi_); LAS float* scr_ = (LAS float*)(lds + wave * 8704); \
        for (int it_ = a_ + wave; it_ < b_; it_ += NWAVES) conv_item(ka, ws, cl, it_, scr_, lane); } } while (0)
__global__ void __launch_bounds__(NWAVES * 64, 2) mega_fwd(Args args_unused) {
    extern __shared__ __attribute__((aligned(16))) unsigned char lds_raw[];
    LAS unsigned char* lds = (LAS unsigned char*)lds_raw;
    const int tid0 = threadIdx.x, wave = __builtin_amdgcn_readfirstlane(tid0 >> 6);
    const int G = gridDim.x, bx = blockIdx.x;
    const int vcu = (G % 8 == 0) ? (bx % 8) * (G / 8) + bx / 8 : bx;
    const int gw = vcu * NWAVES + wave, NGW = G * NWAVES;
    for (int u = tid0; u < (LDS_BYTES - RING_BYTES) / 4; u += NWAVES * 64) ((LAS unsigned*)(lds + RING_BYTES))[u] = 0u;
    __syncthreads();
    int lo, hi, use_bar;
    { KARGS(ka); lo = ka->ph_lo; hi = ka->ph_hi; use_bar = ka->use_bar;
      if (use_bar) (void)xcd_barrier_post((unsigned*)(ka->ws + WS_CTL) + CW_BAR, (volatile LAS unsigned*)(lds + MISC_OFF) + 8); }
    for (int ph = lo; ph < hi; ++ph) {
    const int l = ph >= 2 ? (ph - 2) / 8 : 0, pq = ph >= 2 ? (ph - 2) % 8 : -1, pk = pq < 3 ? pq : pq + 1; const bool last = (l == DEPTH - 1);
    const int Mrows = last ? RL : RT;
    const int pbit = ph == 0 ? 512 : (ph == 1 ? 1024 : (1 << pk)); const int nrep = (REPEAT_MASK & pbit) ? 2 : 1;
    for (int rep = 0; rep < nrep; ++rep) {
    int tid = threadIdx.x; asm volatile("" : "+v"(tid)); const int lane = tid & 63;
    if (ph == 0 && (PHASE_MASK & 512)) {
        KARGS(ka); unsigned char* ws = ka->ws;
        {
            mod_gemv_items(ka, ws, lds, tid, lane, wave, bx, 224, G, nullptr, 192, 160);
            float* ROPE = (float*)(ws + WS_ROPE);
            if (bx == G - 1) for (int i = tid; i < 64 * 16; i += NWAVES * 64) { const int pos = i >> 4, f = i & 15; const float inv = powf(10000.0f, -(float)f / 16.0f); const float ang = (float)pos * inv;
                float sn, cs; sincosf(ang, &sn, &cs); ROPE[2 * i] = cs; ROPE[2 * i + 1] = sn; }
        }
        LAS float* scr = (LAS float*)(lds + wave * 8704);
        for (int it = gw; it < I_MIX; it += NGW) conv_item(ka, ws, 0, it, scr, lane);
    }
    else if (ph == 1 && (PHASE_MASK & 1024)) {
        KARGS(ka); unsigned char* ws = ka->ws; const float* x_in = ka->in[0]; const float* ctx_in = ka->in[2];
        const float* MOD = (const float*)(ws + WS_MOD); bf16* H = (bf16*)(ws + WS_H);
        rowpass_pipe<false, 0, true>(lane, gw, NGW, RL, x_in, false, nullptr, nullptr, H, nullptr, MOD, 1, 0, -1);
        rowpass_pipe<false, 0, true>(lane, (gw & 1) ? RC : (gw >> 1), NGW / 2, RC, ctx_in, false, nullptr, nullptr, H + (size_t)RL * DM, nullptr, MOD, 1, 0, 4);
    }
    else {
        if (pk == 0 && (PHASE_MASK & 1)) {
            KARGS(ka); unsigned char* ws = ka->ws; unsigned char* wb = ws + WS_W + (size_t)l * W_LAYER; unsigned char* pj = ws + WS_PROJ;
            pg8::Gemm g{(const bf16*)(ws + WS_H), (const bf16*)(wb + WO_IN), RT, PW, DM};
            pg8::EpiIn E{(bf16*)(pj + PO_U), (bf16*)(pj + PO_Q), (bf16*)(pj + PO_K), (bf16*)(pj + PO_VTL), (bf16*)(pj + PO_VTC), (bf16*)(pj + PO_GS), (bf16*)(pj + PO_GN), (const float*)(ws + WS_ROPE)};
            if (!last) { pg8::StaticOrder S; S.init(RT, PW, G, bx); pg8::gemm_phase<pg8::EpiIn, pg8::StaticOrder, true, true>(lds, g, S, E); IDLE_COPY((RT / 256) * (PW / 256), 0, I_MIX, I_LAYER); }
            else { pg8::OrderL1In S; S.init(RL, PW, G, bx); pg8::gemm_phase<pg8::EpiIn, pg8::OrderL1In, true, true>(lds, g, S, E); IDLE_COPY((RL / 256) * (PW / 256) + 48, 1, I_MIX, I_LAYER); }
        }
        else if (pk == 1 && (PHASE_MASK & 2)) {
            KARGS(ka); unsigned char* ws = ka->ws; unsigned char* pj = ws + WS_PROJ;
            const ScanPtrs SPp{ka->in[11], ka->in[12], ka->in[13], ka->in[14], ka->in[15], ka->in[16], ka->in[17], ka->in[18], (const bf16*)(pj + PO_U), (float*)(ws + WS_OUT), (bf16*)(ws + WS_ACT)};
            LAS unsigned* flagb = (LAS unsigned*)(lds + MISC_OFF) + 16;
            if (tid < 320) flagb[tid] = 0u;
            if (tid == 0) ((LAS unsigned*)(lds + MISC_OFF))[12] = 0u;
            LDS_WAIT(); __syncthreads();
            LAS unsigned* cctr = (LAS unsigned*)(lds + MISC_OFF) + 12;
            if (wave < 2) {
                __builtin_amdgcn_s_setprio(3);
                LAS unsigned char* sl = lds + wave * SCAN_LDS; int iter = 0;
                for (int rp = 0; rp < PROBE_SCAN_REP; ++rp)
                for (int pair = bx; pair < NB * SG; pair += G, ++iter) {
                    LAS unsigned* flags = flagb + (iter & 7) * 40;
                    if (wave == 0) scan_chain<false>(sl, flags, l, pair >> 6, pair & 63, SPp, lane, !last);
                    else scan_chain<true>(sl, flags, l, pair >> 6, pair & 63, SPp, lane, !last);
                }
                __builtin_amdgcn_s_setprio(0);
            } else {
                LAS unsigned char* tile = lds + 2 * SCAN_LDS + (wave - 2) * ATT_TILE;
                {
                    const AttPtrs AP{(const bf16*)(pj + PO_Q), (const bf16*)(pj + PO_K), (const bf16*)(pj + PO_VTL), (const bf16*)(pj + PO_VTC), (bf16*)(ws + WS_ATT), ka->in[21]};
                    LAS float* btab = (LAS float*)(lds + 2 * SCAN_LDS + 6 * ATT_TILE + (wave - 2) * 2048); int tab_head = -1;
                    const int ipp = last ? 64 : 72, nq = 8 * ipp, xg = bx & 7, slot = (bx >> 3) * 6 + (wave - 2), nslot = (G >> 3) * 6;
                    const int ncl = last ? 4 : 8; int cpair = bx, citer = 0, cli = wave - 2;
                    for (int q = slot; ; q += nslot) {
                        const bool have = q < nq;
                        if (have) { const int pid = xg * 8 + q / ipp, w = q % ipp;
                            att_item(w < 64 ? pid * 64 + w : 4096 + pid * 8 + (w - 64), l, AP, tile, btab, tab_head, lane); }
                        while (cpair < NB * SG) {
                            if (cli >= ncl) { cli = wave - 2; cpair += G; ++citer; continue; }
                            const int cfc = last ? 18 + cli : (cli < 4 ? cli : 14 + cli);
                            volatile LAS unsigned* flags = (volatile LAS unsigned*)(flagb + (citer & 7) * 40);
                            if (flags[cfc] < 2u) { if (have) break;
                                unsigned spins = 0; while (flags[cfc] < 2u && ++spins < (1u << 24)) __builtin_amdgcn_s_sleep(8); }
                            asm volatile("" ::: "memory");
                            scan_combine(SPp, l, cpair >> 6, cpair & 63, cfc, lane);
                            cli += 6;
                        }
                        if (!have) break;
                    }
                }
            }
            __syncthreads();
        }
        else if (pk == 2 && (PHASE_MASK & 4)) {
            KARGS(ka); unsigned char* ws = ka->ws; unsigned char* wb = ws + WS_W + (size_t)l * W_LAYER;
            static_assert(WS_ATT == WS_ACT + (size_t)36 * 256 * SSMW * 2 && WO_NA == WO_VG + (size_t)16 * 256 * SSMW * 2, "att / w_na must follow act / w_vg directly");
            pg8::Gemm g{(const bf16*)(ws + WS_ACT), (const bf16*)(wb + WO_VG), 2 * RT, 3 * DM, SSMW};
            LAS unsigned* xi = (LAS unsigned*)(lds + MISC_OFF + 4096);
            if (tid == 0) { unsigned* bar = (unsigned*)(ws + WS_CTL) + CW_BAR; const unsigned x = xb_xcc_id(); unsigned kk = 0u, np = 0u, nn = 1u;
                for (unsigned j = 0; j < 16; ++j) { const unsigned c = xb_ld(&bar[XB_XCNT(j)]); np += (c > 0u) ? 1u : 0u; kk += (c > 0u && j < x) ? 1u : 0u; nn = (j == x && c > 0u) ? c : nn; }
                xi[0] = kk; xi[1] = np > 0u ? np : 1u; xi[2] = nn; }
            LDS_WAIT(); __syncthreads();
            pg8::OrderD12 S; S.init(Mrows, __builtin_amdgcn_readfirstlane((int)xi[0]), __builtin_amdgcn_readfirstlane((int)xi[1]), __builtin_amdgcn_readfirstlane((int)((LAS unsigned*)(lds + MISC_OFF))[10]), __builtin_amdgcn_readfirstlane((int)xi[2]));
            S.ctr = (unsigned*)(ws + WS_CTL) + CW_D12 + l * 512;
            pg8::EpiD12 E{(const bf16*)(ws + WS_PROJ + PO_GS), (const bf16*)(ws + WS_PROJ + PO_GN), (bf16*)(ws + WS_TM), S.ctr};
            pg8::gemm_phase<pg8::EpiD12, pg8::OrderD12, true, true>(lds, g, S, E);
            if (!last) mod_gemv_items(ka, ws, lds, tid, lane, wave, 192, 352, 0, (unsigned*)(ws + WS_CTL) + CW_GQ, 1 << 30, 0);
        }
        else if (pk == 4 && (PHASE_MASK & 16)) {
            KARGS(ka); unsigned char* ws = ka->ws; unsigned char* wb = ws + WS_W + (size_t)l * W_LAYER;
            pg8::Gemm g{(const bf16*)(ws + WS_TM), (const bf16*)(wb + WO_OUT), Mrows, DM, DM}; pg8::OrderSplitCtx S; S.init(RL, DM, G, bx); S.ksl = DM / 64 / 8; S.nctx = last ? 0 : 256;
            pg8::EpiF32S E{(bf16*)(ws + WS_OUT), (bf16*)(ws + WS_SLAB)};
            pg8::gemm_phase<pg8::EpiF32S, pg8::OrderSplitCtx, true, true>(lds, g, S, E);
        }
        else if ((pk == 5 && (PHASE_MASK & 32)) || (pk == 8 && (PHASE_MASK & 256))) {
            KARGS(ka); unsigned char* ws = ka->ws; const bool r2 = pk == 8;
            const float* mdl = (const float*)(ws + WS_MOD) + (size_t)(l * 5) * (NMOD * DM); const float* modg = mdl + (r2 ? 5 : 2) * DM;
            const float* modh = r2 ? mdl + (size_t)5 * (NMOD * DM) : mdl; const int kss = r2 ? 1 : 4, ksh = r2 ? 0 : 3;
            bf16* H = (bf16*)(ws + WS_H); bf16* XA = (bf16*)(ws + WS_XA); const bool xf = !r2 && l == 0;
            if (!last) rowpass_ctx8((LAS float*)(lds + MISC_OFF + 4096), lane, wave, vcu, G, xf ? (const void*)ka->in[2] : (const void*)(XA + (size_t)RL * DM), !xf, (const bf16*)(ws + WS_SLAB), XA + (size_t)RL * DM, H + (size_t)RL * DM,
                                    modg + (size_t)4 * (NMOD * DM), modh + (size_t)4 * (NMOD * DM) + kss * DM, modh + (size_t)4 * (NMOD * DM) + ksh * DM);
            if (!(r2 && last)) rowpass_pipe<true, 2, true>(lane, gw, NGW, RL, xf ? (const void*)ka->in[0] : (const void*)XA, !xf, (const bf16*)(ws + WS_OUT), XA, H, modg, modh, kss, ksh, -1);
            else rowpass_pipe<true, 1, false>(lane, gw, NGW, RL, XA, true, (const bf16*)(ws + WS_OUT), ka->out, nullptr, modg, nullptr, 0, 0, -1);
        }
        else if (pk == 6 && (PHASE_MASK & 64)) {
            KARGS(ka); unsigned char* ws = ka->ws; unsigned char* wb = ws + WS_W + (size_t)l * W_LAYER;
            pg8::Gemm g{(const bf16*)(ws + WS_H), (const bf16*)(wb + WO_FC1), Mrows, DFF, DM}; pg8::StaticOrder S; S.init(Mrows, DFF, G, bx);
            pg8::EpiRelu2 E{(bf16*)(ws + WS_PROJ), DFF};
            pg8::gemm_phase<pg8::EpiRelu2, pg8::StaticOrder, true, true>(lds, g, S, E);
            if (!last) IDLE_COPY((RT / 256) * (DFF / 256), 1, 0, I_MIX);
        }
        else if (pk == 7 && (PHASE_MASK & 128)) {
            KARGS(ka); unsigned char* ws = ka->ws; unsigned char* wb = ws + WS_W + (size_t)l * W_LAYER;
            pg8::Gemm g{(const bf16*)(ws + WS_PROJ), (const bf16*)(wb + WO_FC2), Mrows, DM, DFF}; pg8::OrderSplitCtx S; S.init(RL, DM, G, bx); S.ksl = DFF / 64 / 8; S.nctx = last ? 0 : 256;
            pg8::EpiF32S E{(bf16*)(ws + WS_OUT), (bf16*)(ws + WS_SLAB)};
            pg8::gemm_phase<pg8::EpiF32S, pg8::OrderSplitCtx, true, true>(lds, g, S, E);
        }
    }
    }
    if (ph + 1 < hi && use_bar) {
        KARGS(kb); XcdBarrier b2; b2.bar = (unsigned*)(kb->ws + WS_CTL) + CW_BAR; b2.x = xb_xcc_id(); b2.st = (volatile LAS unsigned*)(lds + MISC_OFF) + 8;
        xcd_barrier(b2);
    }
    }
}

extern "C" void kernel_launch(void* const* d_in, const int* in_sizes, int n_in, void* d_out, int out_size, void* d_ws, size_t ws_size, hipStream_t stream) {
    static int grid = 0;
    if (grid == 0) {
        if (n_in != 26 || in_sizes[0] != RL * DM || out_size != RL * DM || ws_size < WS_END) { fprintf(stderr, "kernel_launch: unexpected shapes / workspace (n_in %d, in0 %d, out %d, ws %zu < %zu); nothing launched\n", n_in, n_in > 0 ? in_sizes[0] : -1, out_size, ws_size, (size_t)WS_END); grid = -1; return; }
        int dev = 0, cus = 0, per_cu = 0;
        if (hipGetDevice(&dev) != hipSuccess || hipDeviceGetAttribute(&cus, hipDeviceAttributeMultiprocessorCount, dev) != hipSuccess) { grid = -1; return; }
        if (hipFuncSetAttribute((const void*)mega_fwd, hipFuncAttributeMaxDynamicSharedMemorySize, LDS_BYTES) != hipSuccess) { fprintf(stderr, "kernel_launch: hipFuncSetAttribute failed\n"); grid = -1; return; }
        if (hipOccupancyMaxActiveBlocksPerMultiprocessor(&per_cu, (const void*)mega_fwd, NWAVES * 64, LDS_BYTES) != hipSuccess || per_cu < 1) { fprintf(stderr, "kernel_launch: occupancy query says %d blocks per CU; nothing launched\n", per_cu); (void)hipGetLastError(); grid = -1; return; }
        grid = cus;
    }
    if (grid < 0) return;
    (void)hipMemsetAsync((char*)d_ws + WS_CTL, 0, CTL_ZERO_BYTES, stream);
    Args a{};
    for (int i = 0; i < 26; ++i) a.in[i] = (const float*)d_in[i];
    a.out = (float*)d_out; a.ws = (unsigned char*)d_ws;
#if MK_PER_PHASE
    for (int p = 0; p < NPH; ++p) { a.ph_lo = p; a.ph_hi = p + 1; a.use_bar = 0; a.pad = 0; hipLaunchKernelGGL(mega_fwd, dim3(grid), dim3(NWAVES * 64), LDS_BYTES, stream, a); }
#else
    a.ph_lo = 0; a.ph_hi = NPH; a.use_bar = 1; a.pad = 0;
    hipLaunchKernelGGL(mega_fwd, dim3(grid), dim3(NWAVES * 64), LDS_BYTES, stream, a);
#endif
}
```

```cpp
#include <hip/hip_runtime.h>
#include <cstdio>
#include <cstdint>
#ifndef MK_PER_PHASE
#define MK_PER_PHASE 0
#endif
namespace pg8 {
#define PG8_LAS __attribute__((address_space(3)))
typedef unsigned short bf16_t;
typedef short bf16x8 __attribute__((ext_vector_type(8)));
typedef float f32x4 __attribute__((ext_vector_type(4)));
typedef unsigned u32x4 __attribute__((ext_vector_type(4)));
constexpr int BM = 256, BK = 64, HALF = 128, HTB = HALF * BK * 2  , STAGE_BYTES = 8 * HTB, NXCD = 8, WGM = 8;

__host__ __device__ __forceinline__ int lds_byte(int r, int c) { const int st = (r >> 4) * 2 + (c >> 5), rr = r & 15, cc = c & 31, ob = rr * 64 + cc * 2; return st * 1024 + (ob ^ (((ob >> 9) & 1) << 5)); }
__host__ __device__ __forceinline__ void stage_rc(int b, int& R, int& C) { const int st = b / 1024, sb = b % 1024, swz = sb ^ (((sb >> 9) & 1) << 5); R = (st >> 1) * 16 + swz / 64; C = (st & 1) * 32 + (swz % 64) / 2; }
__host__ __device__ __forceinline__ int perm32(int rho) { const int n = rho >> 4, i = rho & 15; return 8 * (i >> 2) + 4 * n + (i & 3); }

struct Unit { int pm, pn, nt, ks; };
struct Gemm { const bf16_t* A; const bf16_t* Bt; int M, N, K; };

struct StaticOrder {
    int nM, nN, nwg, G, c;
    __host__ __device__ void init(int M, int N, int G_, int c_) { nM = M / BM; nN = N / BM; nwg = nM * nN; G = G_; c = c_; }
    __host__ __device__ __forceinline__ bool next(int i, Unit& u, int ntdef) const {
        u.nt = ntdef; u.ks = 0; u.pm = 0; u.pn = 0;
        const long L = (long)i * G + c; if (L >= nwg) return false;
        int wgid = (int)L; { const int q = nwg / NXCD, r = nwg % NXCD, xcd = wgid % NXCD, off = wgid / NXCD; wgid = (xcd < r ? xcd * (q + 1) : r * (q + 1) + (xcd - r) * q) + off; }
        const int nig = WGM * nN, gid = wgid / nig, fm = gid * WGM, gsz = (nM - fm) < WGM ? (nM - fm) : WGM;
        u.pm = fm + ((wgid % nig) % gsz); u.pn = (wgid % nig) / gsz; return true;
    }
    __device__ __forceinline__ void a_ready(const Unit&) const {}
    __device__ __forceinline__ void done(const Unit&) const {}
};


__device__ __forceinline__ unsigned cvt_pk_bf16(float lo, float hi) { unsigned r; asm volatile("v_cvt_pk_bf16_f32 %0, %1, %2" : "=v"(r) : "v"(lo), "v"(hi)); return r; }
typedef unsigned u32x2 __attribute__((ext_vector_type(2)));
__device__ __forceinline__ float sigm(float x) { return __builtin_amdgcn_rcpf(1.0f + __builtin_amdgcn_exp2f(-1.4426950408889634f * x)); }
__device__ __forceinline__ float bflo(unsigned w) { return __uint_as_float(w << 16); }
__device__ __forceinline__ float bfhi(unsigned w) { return __uint_as_float(w & 0xffff0000u); }
__device__ __forceinline__ u32x2 pack4(f32x4 v) { u32x2 w; w.x = cvt_pk_bf16(v[0], v[1]); w.y = cvt_pk_bf16(v[2], v[3]); return w; }

constexpr float QSCALE = 0.125f * 1.4426950408889634f;

struct EpiIn {
    static constexpr bool PERM = false, AFTER_DRAIN = false;
    bf16_t *U, *Q, *Kb, *VTl, *VTc, *GS, *GN; const float* rope;
    __device__ __forceinline__ void operator()(const f32x4 (&acc)[2][2][4][2], const Unit& u, int wr, int wc, int fr, int fq) const {
        const int pn = u.pn; const bool lat = u.pm < 32;
        const int row0 = u.pm * BM + wr * 64 + fr;
        if (pn < 4 || pn >= 16) {
            bf16_t* base; int ld, colt; bool sg;
            if (pn < 4) { base = U; ld = 1024; colt = pn * 256; sg = false; }
            else if (pn < 24) { base = GS; ld = 2048; colt = (pn - 16) * 256; sg = true; }
            else { base = GN; ld = 2048; colt = (pn - 24) * 256; sg = true; }
            const int col0 = colt + wc * 32 + 4 * fq;
#pragma unroll
            for (int ai = 0; ai < 2; ++ai)
#pragma unroll
                for (int m = 0; m < 4; ++m) { bf16_t* rowp = base + (size_t)(row0 + ai * HALF + m * 16) * ld + col0;
#pragma unroll
                    for (int bj = 0; bj < 2; ++bj)
#pragma unroll
                        for (int n = 0; n < 2; ++n) { f32x4 v = acc[ai][bj][m][n];
                            if (sg) { v[0] = sigm(v[0]); v[1] = sigm(v[1]); v[2] = sigm(v[2]); v[3] = sigm(v[3]); }
                            *(u32x2*)(rowp + bj * HALF + n * 16) = pack4(v); } }
        } else if (pn < 12) {
            const bool isq = pn < 8; bf16_t* base = isq ? Q : Kb; const int colt = (pn - (isq ? 4 : 8)) * 256;
            const float sc = isq ? QSCALE : 1.0f; const int col0 = colt + wc * 32 + 4 * fq; const int colsel = wc & 1;
#pragma unroll
            for (int ai = 0; ai < 2; ++ai)
#pragma unroll
                for (int m = 0; m < 4; ++m) { const int row = row0 + ai * HALF + m * 16; bf16_t* rowp = base + (size_t)row * 1024 + col0;
                    f32x4 cA = (f32x4){1.f, 0.f, 1.f, 0.f}, cB = cA;
                    if (lat) { const int t = row & 2047, pos = colsel ? (t & 63) : (t >> 6); const f32x4* rp = (const f32x4*)(rope + (pos * 16 + 4 * fq) * 2); cA = rp[0]; cB = rp[1]; }
#pragma unroll
                    for (int bj = 0; bj < 2; ++bj) { const f32x4 x1 = acc[ai][bj][m][0], x2 = acc[ai][bj][m][1]; f32x4 o1, o2;
                        o1[0] = x1[0] * cA[0] - x2[0] * cA[1]; o2[0] = x1[0] * cA[1] + x2[0] * cA[0];
                        o1[1] = x1[1] * cA[2] - x2[1] * cA[3]; o2[1] = x1[1] * cA[3] + x2[1] * cA[2];
                        o1[2] = x1[2] * cB[0] - x2[2] * cB[1]; o2[2] = x1[2] * cB[1] + x2[2] * cB[0];
                        o1[3] = x1[3] * cB[2] - x2[3] * cB[3]; o2[3] = x1[3] * cB[3] + x2[3] * cB[2];
                        o1 = o1 * sc; o2 = o2 * sc;
                        *(u32x2*)(rowp + bj * HALF) = pack4(o1); *(u32x2*)(rowp + bj * HALF + 16) = pack4(o2); } }
        } else {
            const int colt = (pn - 12) * 256;
#pragma unroll
            for (int ai = 0; ai < 2; ++ai)
#pragma unroll
                for (int m = 0; m < 4; ++m) { const int row = row0 + ai * HALF + m * 16;
                    bf16_t* bp; int tstride;
                    if (lat) { const int b = row >> 11, t = row & 2047; bp = VTl + (size_t)b * (16 * 64 * 2048) + t; tstride = 2048; }
                    else { const int rr = row - 8192, b = rr >> 8, l = rr & 255; bp = VTc + (size_t)b * (16 * 64 * 256) + l; tstride = 256; }
#pragma unroll
                    for (int bj = 0; bj < 2; ++bj)
#pragma unroll
                        for (int n = 0; n < 2; ++n) { const int c = colt + bj * HALF + wc * 32 + n * 16 + 4 * fq; const f32x4 v = acc[ai][bj][m][n];
                            const u32x2 w = pack4(v);
                            bp[(size_t)(c + 0) * tstride] = (bf16_t)(w.x & 0xffffu); bp[(size_t)(c + 1) * tstride] = (bf16_t)(w.x >> 16);
                            bp[(size_t)(c + 2) * tstride] = (bf16_t)(w.y & 0xffffu); bp[(size_t)(c + 3) * tstride] = (bf16_t)(w.y >> 16); } }
        }
    }
};
struct EpiD1 {
    static constexpr bool PERM = false, AFTER_DRAIN = false;
    const bf16_t* GS; bf16_t* T1;
    __device__ __forceinline__ void operator()(const f32x4 (&acc)[2][2][4][2], const Unit& u, int wr, int wc, int fr, int fq) const {
        const int row0 = u.pm * BM + wr * 64 + fr, L0 = u.pn * 128 + wc * 16 + 4 * fq;
#pragma unroll
        for (int ai = 0; ai < 2; ++ai)
#pragma unroll
            for (int m = 0; m < 4; ++m) { const size_t off = (size_t)(row0 + ai * HALF + m * 16) * 2048 + L0;
#pragma unroll
                for (int bj = 0; bj < 2; ++bj) { const f32x4 val = acc[ai][bj][m][0], glu = acc[ai][bj][m][1]; const u32x2 g = *(const u32x2*)(GS + off + bj * 64); f32x4 t;
                    t[0] = bflo(g.x) * val[0] * sigm(glu[0]); t[1] = bfhi(g.x) * val[1] * sigm(glu[1]); t[2] = bflo(g.y) * val[2] * sigm(glu[2]); t[3] = bfhi(g.y) * val[3] * sigm(glu[3]);
                    *(u32x2*)(T1 + off + bj * 64) = pack4(t); } }
    }
};
struct EpiD2 {
    static constexpr bool PERM = true, AFTER_DRAIN = false;
    const bf16_t* GN; bf16_t* TM;
    __device__ __forceinline__ void operator()(const f32x4 (&acc)[2][2][4][2], const Unit& u, int wr, int wc, int fr, int fq) const {
        const int row0 = u.pm * BM + wr * 64 + fr, col0 = u.pn * BM + wc * 32 + 8 * fq;
#pragma unroll
        for (int ai = 0; ai < 2; ++ai)
#pragma unroll
            for (int m = 0; m < 4; ++m) { const size_t off = (size_t)(row0 + ai * HALF + m * 16) * 2048 + col0;
#pragma unroll
                for (int bj = 0; bj < 2; ++bj) { const f32x4 v0 = acc[ai][bj][m][0], v1 = acc[ai][bj][m][1];
                    const u32x4 t = *(const u32x4*)(TM + off + bj * HALF), g = *(const u32x4*)(GN + off + bj * HALF); u32x4 w;
                    w.x = cvt_pk_bf16(bflo(t.x) + bflo(g.x) * v0[0], bfhi(t.x) + bfhi(g.x) * v0[1]); w.y = cvt_pk_bf16(bflo(t.y) + bflo(g.y) * v0[2], bfhi(t.y) + bfhi(g.y) * v0[3]);
                    w.z = cvt_pk_bf16(bflo(t.z) + bflo(g.z) * v1[0], bfhi(t.z) + bfhi(g.z) * v1[1]); w.w = cvt_pk_bf16(bflo(t.w) + bflo(g.w) * v1[2], bfhi(t.w) + bfhi(g.w) * v1[3]);
                    *(u32x4*)(TM + off + bj * HALF) = w; } }
    }
};
struct EpiF32 {
    static constexpr bool PERM = false, AFTER_DRAIN = false;
    float* O; int ldc;
    __device__ __forceinline__ void operator()(const f32x4 (&acc)[2][2][4][2], const Unit& u, int wr, int wc, int fr, int fq) const {
        const int row0 = u.pm * BM + wr * 64 + fr, col0 = u.pn * BM + wc * 32 + 4 * fq;
#pragma unroll
        for (int ai = 0; ai < 2; ++ai)
#pragma unroll
            for (int m = 0; m < 4; ++m) { float* rowp = O + (size_t)(row0 + ai * HALF + m * 16) * ldc + col0;
#pragma unroll
                for (int bj = 0; bj < 2; ++bj)
#pragma unroll
                    for (int n = 0; n < 2; ++n) *(f32x4*)(rowp + bj * HALF + n * 16) = acc[ai][bj][m][n]; }
    }
};
struct EpiF32S {
    static constexpr bool PERM = true, AFTER_DRAIN = false;
    bf16_t* O; bf16_t* SL;
    __device__ __forceinline__ void operator()(const f32x4 (&acc)[2][2][4][2], const Unit& u, int wr, int wc, int fr, int fq) const {
        const int row0 = u.pm * BM + wr * 64 + fr, col0 = u.pn * BM + wc * 32 + 8 * fq;
        if (u.pm < 32) {
#pragma unroll
            for (int ai = 0; ai < 2; ++ai)
#pragma unroll
                for (int m = 0; m < 4; ++m) { bf16_t* rowp = O + (size_t)(row0 + ai * HALF + m * 16) * 2048 + col0;
#pragma unroll
                    for (int bj = 0; bj < 2; ++bj) { const f32x4 v0 = acc[ai][bj][m][0], v1 = acc[ai][bj][m][1];
                        u32x4 w; w.x = cvt_pk_bf16(v0[0], v0[1]); w.y = cvt_pk_bf16(v0[2], v0[3]); w.z = cvt_pk_bf16(v1[0], v1[1]); w.w = cvt_pk_bf16(v1[2], v1[3]);
                        *(u32x4*)(rowp + bj * HALF) = w; } }
        } else {
            bf16_t* base = SL + ((size_t)u.ks * 1024 + (row0 - 8192)) * 2048;
#pragma unroll
            for (int ai = 0; ai < 2; ++ai)
#pragma unroll
                for (int m = 0; m < 4; ++m) { bf16_t* rowp = base + (size_t)(ai * HALF + m * 16) * 2048 + col0;
#pragma unroll
                    for (int bj = 0; bj < 2; ++bj) { const f32x4 v0 = acc[ai][bj][m][0], v1 = acc[ai][bj][m][1];
                        u32x4 w; w.x = cvt_pk_bf16(v0[0], v0[1]); w.y = cvt_pk_bf16(v0[2], v0[3]); w.z = cvt_pk_bf16(v1[0], v1[1]); w.w = cvt_pk_bf16(v1[2], v1[3]);
                        *(u32x4*)(rowp + bj * HALF) = w; } }
        }
    }
};
struct OrderSplitCtx : StaticOrder {
    int ksl, nctx;
    __device__ __forceinline__ bool next(int i, Unit& u, int ntdef) const {
        if (StaticOrder::next(i, u, ntdef)) return true;
        const long L = (long)i * G + c - nwg; if (L >= nctx) return false;
        const int unit = (int)L >> 3; u.pm = 32 + (unit & 3); u.pn = unit >> 2; u.ks = (int)L & 7; u.nt = ksl; return true;
    }
};
struct EpiRelu2 {
    static constexpr bool PERM = true, AFTER_DRAIN = false;
    bf16_t* O; int ldc;
    __device__ __forceinline__ void operator()(const f32x4 (&acc)[2][2][4][2], const Unit& u, int wr, int wc, int fr, int fq) const {
        const int row0 = u.pm * BM + wr * 64 + fr, col0 = u.pn * BM + wc * 32 + 8 * fq;
#pragma unroll
        for (int ai = 0; ai < 2; ++ai)
#pragma unroll
            for (int m = 0; m < 4; ++m) { bf16_t* rowp = O + (size_t)(row0 + ai * HALF + m * 16) * ldc + col0;
#pragma unroll
                for (int bj = 0; bj < 2; ++bj) { f32x4 v0 = acc[ai][bj][m][0], v1 = acc[ai][bj][m][1];
                    v0 = __builtin_elementwise_max(v0, (f32x4){0.f, 0.f, 0.f, 0.f}); v1 = __builtin_elementwise_max(v1, (f32x4){0.f, 0.f, 0.f, 0.f}); v0 = v0 * v0; v1 = v1 * v1;
                    u32x4 w; w.x = cvt_pk_bf16(v0[0], v0[1]); w.y = cvt_pk_bf16(v0[2], v0[3]); w.z = cvt_pk_bf16(v1[0], v1[1]); w.w = cvt_pk_bf16(v1[2], v1[3]);
                    *(u32x4*)(rowp + bj * HALF) = w; } }
    }
};
struct OrderL1In : StaticOrder {
    __device__ __forceinline__ bool next(int i, Unit& u, int ntdef) const {
        if (StaticOrder::next(i, u, ntdef)) return true;
        const long L = (long)i * G + c - nwg; if (L >= 48) return false;
        const int k = (int)L >> 2; u.pm = 32 + ((int)L & 3); u.pn = k < 4 ? k : k + 4; return true;
    }
};

template <class Epi, class Sched, bool ALIGN_EPI = false, bool SP2 = false>
__device__ __forceinline__ void gemm_phase(PG8_LAS unsigned char* lds, const Gemm g, const Sched& S, const Epi& E) {
    int tid_o = threadIdx.x; asm volatile("" : "+v"(tid_o));
    const int tid = tid_o, wid = __builtin_amdgcn_readfirstlane(tid >> 6), lane = tid & 63, wr = wid >> 2, wc = wid & 3, fr = lane & 15, fq = lane >> 4;
    const int K = g.K, nt = K / BK;
    unsigned voffA[2], voffB[2];
#pragma unroll
    for (int i = 0; i < 2; ++i) { int R, C; stage_rc(tid * 16 + i * 8192, R, C); const int Rb = Epi::PERM ? ((R & ~31) + perm32(R & 31)) : R;
        voffA[i] = (unsigned)(R * K + C) * 2u; voffB[i] = (unsigned)(Rb * K + C) * 2u; }
    const size_t kstep = (size_t)(BK * 2);
    const size_t hstep = (size_t)HALF * K * 2;
    const size_t tstep = 2 * hstep;
    const unsigned ldsw = (unsigned)wid * 1024u;
    const int aoff = lds_byte(wr * 64 + fr, fq * 8), boff = lds_byte(wc * 32 + fr, fq * 8);
#define PG8_SA(b, h) (((b) * 2 + (h)) * HTB)
#define PG8_SB(b, h) ((4 + (b) * 2 + (h)) * HTB)
#define PG8_STAGE(bufoff, gbase, voff) do { _Pragma("unroll") for (int _i = 0; _i < 2; ++_i) \
        __builtin_amdgcn_global_load_lds((const unsigned*)((const char*)(gbase) + (voff)[_i]), (PG8_LAS unsigned*)(lds + (bufoff) + ldsw + _i * 8192), 16, 0, 0); } while (0)
#define PG8_LDA(dst, b, h) do { _Pragma("unroll") for (int m = 0; m < 4; ++m) _Pragma("unroll") for (int k = 0; k < 2; ++k) dst[m][k] = *(const PG8_LAS bf16x8*)(lds + PG8_SA(b, h) + aoff + m * 2048 + k * 1024); } while (0)
#define PG8_LDB(dst, b, h) do { _Pragma("unroll") for (int n = 0; n < 2; ++n) _Pragma("unroll") for (int k = 0; k < 2; ++k) dst[n][k] = *(const PG8_LAS bf16x8*)(lds + PG8_SB(b, h) + boff + n * 2048 + k * 1024); } while (0)
#define PG8_MMA(ai, bj, At, Bt) do { __builtin_amdgcn_s_setprio(1); _Pragma("unroll") for (int m = 0; m < 4; ++m) _Pragma("unroll") for (int n = 0; n < 2; ++n) _Pragma("unroll") for (int k = 0; k < 2; ++k) \
        acc[ai][bj][m][n] = __builtin_amdgcn_mfma_f32_16x16x32_bf16(Bt[n][k], At[m][k], acc[ai][bj][m][n], 0, 0, 0); __builtin_amdgcn_s_setprio(0); } while (0)
#define PG8_WAIT_V(n) asm volatile("s_waitcnt vmcnt(" #n ")" ::: "memory")
#define PG8_WAIT_L(n) asm volatile("s_waitcnt lgkmcnt(" #n ")" ::: "memory")
#define PG8_BAR __builtin_amdgcn_s_barrier()
#define PG8_SCHED __builtin_amdgcn_sched_barrier(0)
    Unit cur, nxt; int ui = 0;
    if (!S.next(0, cur, nt)) return;
    f32x4 acc[2][2][4][2];
#pragma unroll
    for (int a = 0; a < 2; ++a)
#pragma unroll
        for (int b = 0; b < 2; ++b)
#pragma unroll
            for (int m = 0; m < 4; ++m)
#pragma unroll
                for (int n = 0; n < 2; ++n) acc[a][b][m][n] = (f32x4){0.f, 0.f, 0.f, 0.f};
    bf16x8 At[4][2], B0[2][2], B1[2][2];
    const char* cA = (const char*)g.A + (size_t)cur.pm * tstep + (size_t)(cur.ks * cur.nt) * (BK * 2); const char* cB = (const char*)g.Bt + (size_t)cur.pn * tstep + (size_t)(cur.ks * cur.nt) * (BK * 2);
    S.a_ready(cur);
    if constexpr (SP2) {
        PG8_STAGE(PG8_SB(0, 0), cB, voffB); PG8_STAGE(PG8_SB(0, 1), cB + hstep, voffB); PG8_STAGE(PG8_SA(0, 0), cA, voffA); PG8_STAGE(PG8_SA(0, 1), cA + hstep, voffA);
        if (wr == 1) PG8_BAR;
        PG8_WAIT_V(2); PG8_BAR;
        PG8_STAGE(PG8_SB(1, 0), cB + kstep, voffB); PG8_STAGE(PG8_SA(1, 0), cA + kstep, voffA); PG8_STAGE(PG8_SB(1, 1), cB + hstep + kstep, voffB);
        PG8_WAIT_V(6); PG8_BAR;
    } else {
        PG8_STAGE(PG8_SB(0, 0), cB, voffB); PG8_STAGE(PG8_SA(0, 0), cA, voffA); PG8_STAGE(PG8_SB(0, 1), cB + hstep, voffB); PG8_STAGE(PG8_SA(0, 1), cA + hstep, voffA);
        if (wr == 1) PG8_BAR;
        PG8_WAIT_V(4); PG8_BAR;
        PG8_STAGE(PG8_SB(1, 0), cB + kstep, voffB); PG8_STAGE(PG8_SA(1, 0), cA + kstep, voffA); PG8_STAGE(PG8_SB(1, 1), cB + hstep + kstep, voffB);
        PG8_WAIT_V(6); PG8_BAR;
    }
    for (;;) {
        const bool has_next = S.next(ui + 1, nxt, nt);
        const int ntu = cur.nt;
        const char* nA = has_next ? (const char*)g.A + (size_t)nxt.pm * tstep + (size_t)(nxt.ks * nxt.nt) * (BK * 2) : cA; const char* nB = has_next ? (const char*)g.Bt + (size_t)nxt.pn * tstep + (size_t)(nxt.ks * nxt.nt) * (BK * 2) : cB;
        for (int t = 0; t < ntu; t += 2) {
            const bool last = (t == ntu - 2);
            const char* a1 = cA + (size_t)(t + 1) * kstep;
            const char* a2 = last ? nA : cA + (size_t)(t + 2) * kstep; const char* b2 = last ? nB : cB + (size_t)(t + 2) * kstep;
            const char* a3 = a2 + kstep; const char* b3 = b2 + kstep;
            if (last && has_next) S.a_ready(nxt);
            if constexpr (SP2) {
            PG8_LDB(B0, 0, 0); PG8_LDB(B1, 0, 1); PG8_SCHED; PG8_LDA(At, 0, 0); PG8_STAGE(PG8_SA(1, 1), a1 + hstep, voffA);
            PG8_WAIT_V(8); PG8_WAIT_L(0); PG8_BAR; PG8_MMA(0, 0, At, B0); PG8_MMA(0, 1, At, B1); PG8_BAR; PG8_SCHED;
            PG8_LDA(At, 0, 1); PG8_STAGE(PG8_SB(0, 0), b2, voffB); PG8_STAGE(PG8_SB(0, 1), b2 + hstep, voffB); PG8_STAGE(PG8_SA(0, 0), a2, voffA);
            PG8_WAIT_V(8); PG8_WAIT_L(0); PG8_BAR; PG8_MMA(1, 0, At, B0); PG8_MMA(1, 1, At, B1); PG8_BAR; PG8_SCHED;
            PG8_LDB(B0, 1, 0); PG8_LDB(B1, 1, 1); PG8_SCHED; PG8_LDA(At, 1, 0); PG8_STAGE(PG8_SA(0, 1), a2 + hstep, voffA);
            PG8_WAIT_V(8); PG8_WAIT_L(0); PG8_BAR; PG8_MMA(0, 0, At, B0); PG8_MMA(0, 1, At, B1); PG8_BAR; PG8_SCHED;
            PG8_LDA(At, 1, 1); PG8_STAGE(PG8_SB(1, 0), b3, voffB); PG8_STAGE(PG8_SB(1, 1), b3 + hstep, voffB); PG8_STAGE(PG8_SA(1, 0), a3, voffA);
            PG8_WAIT_V(8); PG8_WAIT_L(0); PG8_BAR; PG8_MMA(1, 0, At, B0); PG8_MMA(1, 1, At, B1); PG8_BAR; PG8_SCHED;
            } else {
            PG8_LDB(B0, 0, 0); PG8_SCHED; PG8_LDA(At, 0, 0); PG8_STAGE(PG8_SA(1, 1), a1 + hstep, voffA);
            PG8_WAIT_L(8); PG8_BAR; PG8_WAIT_L(0); PG8_MMA(0, 0, At, B0); PG8_BAR; PG8_SCHED;
            PG8_LDB(B1, 0, 1); PG8_STAGE(PG8_SB(0, 0), b2, voffB);
            PG8_BAR; PG8_WAIT_L(0); PG8_MMA(0, 1, At, B1); PG8_BAR;
            PG8_LDA(At, 0, 1); PG8_STAGE(PG8_SA(0, 0), a2, voffA);
            PG8_BAR; PG8_WAIT_L(0); PG8_MMA(1, 0, At, B0); PG8_BAR; PG8_SCHED;
            PG8_STAGE(PG8_SB(0, 1), b2 + hstep, voffB);
            PG8_WAIT_V(6); PG8_BAR; PG8_MMA(1, 1, At, B1); PG8_BAR;
            PG8_LDB(B0, 1, 0); PG8_SCHED; PG8_LDA(At, 1, 0); PG8_STAGE(PG8_SA(0, 1), a2 + hstep, voffA);
            PG8_WAIT_L(8); PG8_BAR; PG8_WAIT_L(0); PG8_MMA(0, 0, At, B0); PG8_BAR; PG8_SCHED;
            PG8_LDB(B1, 1, 1); PG8_STAGE(PG8_SB(1, 0), b3, voffB);
            PG8_BAR; PG8_WAIT_L(0); PG8_MMA(0, 1, At, B1); PG8_BAR;
            PG8_LDA(At, 1, 1); PG8_STAGE(PG8_SA(1, 0), a3, voffA);
            PG8_BAR; PG8_WAIT_L(0); PG8_MMA(1, 0, At, B0); PG8_BAR; PG8_SCHED;
            PG8_STAGE(PG8_SB(1, 1), b3 + hstep, voffB);
            PG8_WAIT_V(6); PG8_BAR; PG8_MMA(1, 1, At, B1); PG8_BAR;
            }
        }
        if constexpr (ALIGN_EPI) { if (wr == 0) PG8_BAR; }
        if constexpr (!Epi::AFTER_DRAIN) { E(acc, cur, wr, wc, fr, fq); S.done(cur); }
        if (!has_next) break;
#pragma unroll
        for (int a = 0; a < 2; ++a)
#pragma unroll
            for (int b = 0; b < 2; ++b)
#pragma unroll
                for (int m = 0; m < 4; ++m)
#pragma unroll
                    for (int n = 0; n < 2; ++n) acc[a][b][m][n] = (f32x4){0.f, 0.f, 0.f, 0.f};
        cur = nxt; cA = nA; cB = nB; ++ui;
        if constexpr (ALIGN_EPI) { if (wr == 1) PG8_BAR; }
    }
    PG8_WAIT_V(0);
    if constexpr (!ALIGN_EPI) { if (wr == 0) PG8_BAR; }
    PG8_BAR;
    if constexpr (Epi::AFTER_DRAIN) { E.fused(acc, cur, wr, wc, fr, fq, lds, wid, lane); S.done(cur); }
#undef PG8_SA
#undef PG8_SB
#undef PG8_STAGE
#undef PG8_LDA
#undef PG8_LDB
#undef PG8_MMA
#undef PG8_WAIT_V
#undef PG8_WAIT_L
#undef PG8_BAR
#undef PG8_SCHED
}
}

constexpr int NWAVES = 8;
constexpr int DM = 2048, NB = 4, SEQ = 2048, CTX = 256, DEPTH = 2, NHEAD = 16, HD = 64, GRIDW = 64, NMOD = 6;
constexpr int RL = NB * SEQ, RC = NB * CTX, RT = RL + RC;
constexpr int SSMW = 1024, NAW = 1024, PW = 8192, DFF = 8192, SG = 64, SP = 64, SC = 16;
constexpr float NORM_EPS = 1e-6f;
constexpr float LOG2E = 1.4426950408889634f;

constexpr size_t MiB = 1u << 20;
constexpr size_t WS_CTL = 0, CTL_ZERO_BYTES = 1 * MiB;
constexpr size_t WS_MOD = 1 * MiB;
constexpr size_t WS_ROPE = 1 * MiB + 512 * 1024;
constexpr size_t WS_W = 2 * MiB, W_LAYER = 116 * MiB;
constexpr size_t WO_IN = 0, WO_VG = 32 * MiB, WO_NA = 40 * MiB, WO_OUT = 44 * MiB, WO_FC1 = 52 * MiB, WO_FC2 = 84 * MiB;
constexpr size_t WS_XA = 234 * MiB;
constexpr size_t WS_H = 306 * MiB;
constexpr size_t WS_PROJ = 342 * MiB;
constexpr size_t PO_U = 0, PO_Q = 18 * MiB, PO_K = 36 * MiB, PO_VTL = 54 * MiB, PO_VTC = 70 * MiB, PO_GS = 72 * MiB, PO_GN = 108 * MiB;
constexpr size_t WS_ACT = 486 * MiB;
constexpr size_t WS_ATT = 504 * MiB;
constexpr size_t WS_TM = 522 * MiB;
constexpr size_t WS_OUT = 558 * MiB;
constexpr size_t WS_SLAB = 630 * MiB;
constexpr size_t WS_END = 694 * MiB;
constexpr int CW_BAR = 4096;

constexpr int RING_BYTES = 131072, MISC_OFF = RING_BYTES + 320, LDS_BYTES = 147456;
constexpr int SCAN_LDS = 17408;
#define GAS __attribute__((address_space(1)))
#define LAS __attribute__((address_space(3)))
typedef unsigned short bf16;
typedef unsigned v4u __attribute__((ext_vector_type(4)));
typedef unsigned v2u __attribute__((ext_vector_type(2)));
typedef float f32x4 __attribute__((ext_vector_type(4)));
typedef float f32x16 __attribute__((ext_vector_type(16)));
typedef short bf16x8 __attribute__((ext_vector_type(8)));
typedef GAS unsigned gu32;
#define RLX_AGENT __ATOMIC_RELAXED, __HIP_MEMORY_SCOPE_AGENT
#define LDS_WAIT() asm volatile("s_waitcnt lgkmcnt(0)" ::: "memory")
#define VM_WAIT() asm volatile("s_waitcnt vmcnt(0)" ::: "memory")
__device__ __forceinline__ unsigned f2bf(float f) { unsigned u = __builtin_bit_cast(unsigned, f); return (u + 0x7fffu + ((u >> 16) & 1u)) >> 16; }
__device__ __forceinline__ unsigned pk2(float lo, float hi) { return f2bf(lo) | (f2bf(hi) << 16); }
__device__ __forceinline__ float bf2f(bf16 v) { return __uint_as_float((unsigned)v << 16); }
__device__ __forceinline__ float wave_sum(float v) {
#pragma unroll
    for (int o = 1; o < 64; o <<= 1) v += __shfl_xor(v, o);
    return v;
}
#define XB_TMO      128
#define XB_XCNT(j)  (256  + 64 * (j))
#define XB_XSUB(j)  (1280 + 64 * (j))
#define XB_XGEN(j)  (2304 + 64 * (j))
#define XB_TOP      3328
#define XB_TOPGEN   3392
#define XCD_BAR_WORDS 3456
#define XB_SPIN_CAP (1u << 18)

__device__ __forceinline__ unsigned xb_ld(unsigned* p)              { return __hip_atomic_load(p, __ATOMIC_RELAXED, __HIP_MEMORY_SCOPE_AGENT); }
__device__ __forceinline__ unsigned xb_add(unsigned* p, unsigned v) { return __hip_atomic_fetch_add(p, v, __ATOMIC_RELAXED, __HIP_MEMORY_SCOPE_AGENT); }
__device__ __forceinline__ unsigned xb_xcc_id() { return (unsigned)__builtin_amdgcn_s_getreg((3 << 11) | 20) & 0xFu; }
#define XB_SPIN(cond, bar) do { unsigned _sp = 0; while (cond) { __builtin_amdgcn_s_sleep(1); \
    if ((++_sp & 255u) == 0u) { if (xb_ld(&(bar)[XB_TMO])) break; if (_sp > XB_SPIN_CAP) { atomicAdd(&(bar)[XB_TMO], 1u); break; } } } } while (0)

struct XcdBarrier {
    unsigned* bar; unsigned x;
    volatile LAS unsigned* st;
};

__device__ __forceinline__ XcdBarrier xcd_barrier_post(unsigned* bar, volatile LAS unsigned* st) {
    XcdBarrier b; b.bar = bar; b.x = xb_xcc_id(); b.st = st;
    if (threadIdx.x == 0) (void)xb_add(&bar[XB_XCNT(b.x)], 1u);
    return b;
}
__device__ __forceinline__ void xcd_barrier_complete(unsigned* bar, unsigned x, unsigned& nloc, unsigned& nx) {
    const unsigned G = gridDim.x * gridDim.y * gridDim.z;
    unsigned sum, cnt, mine, sp = 0u;
    for (;;) {
        sum = 0u; cnt = 0u; mine = 0u;
#pragma unroll
        for (unsigned j = 0; j < 16; ++j) { const unsigned c = xb_ld(&bar[XB_XCNT(j)]); sum += c; cnt += (c > 0u) ? 1u : 0u; mine = (j == x) ? c : mine; }
        if (sum == G) break;
        __builtin_amdgcn_s_sleep(1);
        if ((++sp & 255u) == 0u) { if (xb_ld(&bar[XB_TMO])) break; if (sp > XB_SPIN_CAP) { atomicAdd(&bar[XB_TMO], 1u); break; } }
    }
    nloc = mine > 0u ? mine : 1u; nx = cnt > 0u ? cnt : 1u;
}

__device__ __forceinline__ void xcd_barrier(const XcdBarrier& b) {
    asm volatile("s_waitcnt vmcnt(0)" ::: "memory");
    __syncthreads();
    if (threadIdx.x == 0) {
        unsigned* bar = b.bar;
        __builtin_amdgcn_s_waitcnt(0);
        unsigned nloc = b.st[0], nx = b.st[1];
        if (nloc == 0u) { xcd_barrier_complete(bar, b.x, nloc, nx); b.st[0] = nloc; b.st[1] = nx; }
        const unsigned old = xb_add(&bar[XB_XSUB(b.x)], 1u);
        const unsigned gen = old / nloc;
        if (old + 1u == (gen + 1u) * nloc) {
            __builtin_amdgcn_fence(__ATOMIC_RELEASE, "agent");
            asm volatile("s_waitcnt vmcnt(0)" ::: "memory");
            const unsigned og = xb_add(&bar[XB_TOP], 1u);
            const unsigned tg = og / nx;
            if (og + 1u == (tg + 1u) * nx) xb_add(&bar[XB_TOPGEN], 1u);
            else XB_SPIN(xb_ld(&bar[XB_TOPGEN]) == tg, bar);
            __builtin_amdgcn_fence(__ATOMIC_ACQUIRE, "agent");
            xb_add(&bar[XB_XGEN(b.x)], 1u);
            asm volatile("s_waitcnt vmcnt(0)" ::: "memory");
        } else {
            XB_SPIN(xb_ld(&bar[XB_XGEN(b.x)]) == gen, bar);
            __builtin_amdgcn_fence(__ATOMIC_ACQUIRE, "agent");
            asm volatile("s_waitcnt vmcnt(0)" ::: "memory");
        }
    }
    __syncthreads();
}

__device__ __forceinline__ void p0_transpose_item(const float* W, int K, int N, bf16* WT, int mode, LAS float* scr, int item, int lane) {
    const int nblk = N / 32, kb = item / nblk, nb = item % nblk, k0 = 64 * kb, n0 = 32 * nb;
    float wv[32];
    const float* wp = W + (size_t)(k0 + (lane >> 5)) * N + n0 + (lane & 31);
#pragma unroll
    for (int i = 0; i < 32; ++i) wv[i] = __builtin_nontemporal_load(wp + (size_t)(2 * i) * N);
#pragma unroll
    for (int i = 0; i < 32; ++i) scr[(2 * i + (lane >> 5)) * 33 + (lane & 31)] = wv[i];
    LDS_WAIT(); asm volatile("" ::: "memory");
    const int c = lane & 7;
#pragma unroll
    for (int j = 0; j < 4; ++j) { const int n = (lane >> 3) + 8 * j; const LAS float* s = scr + (8 * c) * 33 + n;
        v4u o; o.x = pk2(s[0 * 33], s[1 * 33]); o.y = pk2(s[2 * 33], s[3 * 33]); o.z = pk2(s[4 * 33], s[5 * 33]); o.w = pk2(s[6 * 33], s[7 * 33]);
        const int ng = n0 + n; const int drow = mode == 0 ? ng : (32 * (ng >> 4) + (ng & 15) + (mode == 2 ? 16 : 0));
        __builtin_nontemporal_store(o, (GAS v4u*)(WT + (size_t)drow * K + k0 + 8 * c)); }
    LDS_WAIT(); asm volatile("" ::: "memory");
}

template <bool HASY, int XOUT, bool HOUT>
__device__ __forceinline__ void rowpass_pipe(int lane, int first, int step, int M, const void* xin, bool xbf, const bf16* yin, void* xout, bf16* hout,
                                             const float* modg, const float* modh, int kss, int ksh, int mr_fixed) {
    int m = first; if (m >= M) return;
    f32x4 xr_[8]; v2u yc[8];
#pragma unroll
    for (int j = 0; j < 8; ++j) { xr_[j] = (f32x4){0.f, 0.f, 0.f, 0.f}; yc[j] = (v2u){0u, 0u}; }
    if (xbf) { const GAS v2u* xb = (const GAS v2u*)((const bf16*)xin + (size_t)m * DM) + lane;
#pragma unroll
        for (int j = 0; j < 8; ++j) { const v2u t = xb[64 * j]; xr_[j].x = __uint_as_float(t.x); xr_[j].y = __uint_as_float(t.y); } }
    else { const GAS f32x4* xr = (const GAS f32x4*)((const float*)xin + (size_t)m * DM) + lane;
#pragma unroll
        for (int j = 0; j < 8; ++j) xr_[j] = xr[64 * j]; }
    if (HASY) { const GAS v2u* yb = (const GAS v2u*)(yin + (size_t)m * DM) + lane;
#pragma unroll
        for (int j = 0; j < 8; ++j) yc[j] = yb[64 * j]; }
    for (;;) {
        const int mn = m + step; const bool hn = mn < M;
        const int mr = mr_fixed >= 0 ? mr_fixed : (m >> 11);
        f32x4 gg[8], sv[8], hv[8];
        if (HASY) { const GAS f32x4* p = (const GAS f32x4*)(modg + (size_t)mr * (NMOD * DM)) + lane;
#pragma unroll
            for (int j = 0; j < 8; ++j) gg[j] = p[64 * j]; }
        f32x4 xn[8]; v2u yn[8];
#pragma unroll
        for (int j = 0; j < 8; ++j) { xn[j] = xr_[j]; yn[j] = yc[j]; }
        if (hn) {
            if (xbf) { const GAS v2u* xb = (const GAS v2u*)((const bf16*)xin + (size_t)mn * DM) + lane;
#pragma unroll
                for (int j = 0; j < 8; ++j) { const v2u t = xb[64 * j]; xn[j].x = __uint_as_float(t.x); xn[j].y = __uint_as_float(t.y); } }
            else { const GAS f32x4* xr = (const GAS f32x4*)((const float*)xin + (size_t)mn * DM) + lane;
#pragma unroll
                for (int j = 0; j < 8; ++j) xn[j] = xr[64 * j]; }
            if (HASY) { const GAS v2u* yb = (const GAS v2u*)(yin + (size_t)mn * DM) + lane;
#pragma unroll
                for (int j = 0; j < 8; ++j) yn[j] = yb[64 * j]; } }
        f32x4 xc[8];
#pragma unroll
        for (int j = 0; j < 8; ++j) { const unsigned w0 = __float_as_uint(xr_[j].x), w1 = __float_as_uint(xr_[j].y);
            xc[j] = xbf ? (f32x4){pg8::bflo(w0), pg8::bfhi(w0), pg8::bflo(w1), pg8::bfhi(w1)} : xr_[j]; }
        if (HASY) { f32x4 yv[8]; float ss = 0.f;
#pragma unroll
            for (int j = 0; j < 8; ++j) { yv[j] = (f32x4){pg8::bflo(yc[j].x), pg8::bfhi(yc[j].x), pg8::bflo(yc[j].y), pg8::bfhi(yc[j].y)};
                ss += (yv[j].x * yv[j].x + yv[j].y * yv[j].y) + (yv[j].z * yv[j].z + yv[j].w * yv[j].w); }
            const float r = 1.0f / sqrtf(wave_sum(ss) * (1.0f / DM) + NORM_EPS);
#pragma unroll
            for (int j = 0; j < 8; ++j) xc[j] = xc[j] + gg[j] * (yv[j] * r); }
        if (XOUT == 1) { GAS f32x4* xo = (GAS f32x4*)((float*)xout + (size_t)m * DM) + lane;
#pragma unroll
            for (int j = 0; j < 8; ++j) xo[64 * j] = xc[j]; }
        if (XOUT == 2) { GAS v2u* xo = (GAS v2u*)((bf16*)xout + (size_t)m * DM) + lane;
#pragma unroll
            for (int j = 0; j < 8; ++j) { v2u w; w.x = pg8::cvt_pk_bf16(xc[j].x, xc[j].y); w.y = pg8::cvt_pk_bf16(xc[j].z, xc[j].w); xo[64 * j] = w; } }
        if (HOUT) { float ss = 0.f;
            if (HASY) __builtin_amdgcn_sched_barrier(0);
            { const GAS f32x4* p = (const GAS f32x4*)(modh + (size_t)mr * (NMOD * DM) + kss * DM) + lane; const GAS f32x4* q = (const GAS f32x4*)(modh + (size_t)mr * (NMOD * DM) + ksh * DM) + lane;
#pragma unroll
              for (int j = 0; j < 8; ++j) { sv[j] = p[64 * j]; hv[j] = q[64 * j]; } }
#pragma unroll
            for (int j = 0; j < 8; ++j) ss += (xc[j].x * xc[j].x + xc[j].y * xc[j].y) + (xc[j].z * xc[j].z + xc[j].w * xc[j].w);
            const float r = 1.0f / sqrtf(wave_sum(ss) * (1.0f / DM) + NORM_EPS);
            GAS v2u* ho = (GAS v2u*)(hout + (size_t)m * DM) + lane;
#pragma unroll
            for (int j = 0; j < 8; ++j) { const f32x4 h = (xc[j] * r) * sv[j] + hv[j];
                v2u w; w.x = pg8::cvt_pk_bf16(h.x, h.y); w.y = pg8::cvt_pk_bf16(h.z, h.w); ho[64 * j] = w; } }
        if (!hn) break;
#pragma unroll
        for (int j = 0; j < 8; ++j) { xr_[j] = xn[j]; yc[j] = yn[j]; }
        m = mn;
    }
}
__device__ __forceinline__ void rowpass_ctx8(LAS float* red, int lane, int wave, int vcu, int G, const void* xin, bool xbf, const bf16* slab, bf16* xout, bf16* hout,
                                             const float* gg, const float* sv, const float* hv) {
    for (int base = vcu * 4; base < RC; base += G * 4) {
        const int row = base + (wave >> 1); const size_t off = (size_t)row * DM + (wave & 1) * 1024; const int co = (wave & 1) * 1024;
        f32x4 xv[4], yv[4];
        v2u yb[8][4];
#pragma unroll
        for (int sl = 0; sl < 8; ++sl) { const GAS v2u* ys = (const GAS v2u*)(slab + (size_t)sl * RC * DM + off) + lane;
#pragma unroll
            for (int j = 0; j < 4; ++j) yb[sl][j] = ys[64 * j]; }
        if (xbf) { const GAS v2u* xb = (const GAS v2u*)((const bf16*)xin + off) + lane;
#pragma unroll
            for (int j = 0; j < 4; ++j) { const v2u t = xb[64 * j]; xv[j] = (f32x4){pg8::bflo(t.x), pg8::bfhi(t.x), pg8::bflo(t.y), pg8::bfhi(t.y)}; } }
        else { const GAS f32x4* xr = (const GAS f32x4*)((const float*)xin + off) + lane;
#pragma unroll
            for (int j = 0; j < 4; ++j) xv[j] = xr[64 * j]; }
#pragma unroll
        for (int j = 0; j < 4; ++j) { yv[j] = (f32x4){0.f, 0.f, 0.f, 0.f};
#pragma unroll
            for (int sl = 0; sl < 8; ++sl) yv[j] = yv[j] + (f32x4){pg8::bflo(yb[sl][j].x), pg8::bfhi(yb[sl][j].x), pg8::bflo(yb[sl][j].y), pg8::bfhi(yb[sl][j].y)}; }
        float ss = 0.f;
#pragma unroll
        for (int j = 0; j < 4; ++j) ss += (yv[j].x * yv[j].x + yv[j].y * yv[j].y) + (yv[j].z * yv[j].z + yv[j].w * yv[j].w);
        ss = wave_sum(ss); if (lane == 0) red[wave] = ss;
        LDS_WAIT(); __syncthreads();
        float r = 1.0f / sqrtf((red[wave] + red[wave ^ 1]) * (1.0f / DM) + NORM_EPS);
        const GAS f32x4* gp = (const GAS f32x4*)(gg + co) + lane;
#pragma unroll
        for (int j = 0; j < 4; ++j) xv[j] = xv[j] + gp[64 * j] * (yv[j] * r);
        GAS v2u* xo = (GAS v2u*)(xout + off) + lane;
#pragma unroll
        for (int j = 0; j < 4; ++j) { v2u w; w.x = pg8::cvt_pk_bf16(xv[j].x, xv[j].y); w.y = pg8::cvt_pk_bf16(xv[j].z, xv[j].w); xo[64 * j] = w; }
        ss = 0.f;
#pragma unroll
        for (int j = 0; j < 4; ++j) ss += (xv[j].x * xv[j].x + xv[j].y * xv[j].y) + (xv[j].z * xv[j].z + xv[j].w * xv[j].w);
        ss = wave_sum(ss); if (lane == 0) red[8 + wave] = ss;
        LDS_WAIT(); __syncthreads();
        r = 1.0f / sqrtf((red[8 + wave] + red[8 + (wave ^ 1)]) * (1.0f / DM) + NORM_EPS);
        const GAS f32x4* sp = (const GAS f32x4*)(sv + co) + lane; const GAS f32x4* hp = (const GAS f32x4*)(hv + co) + lane; GAS v2u* ho = (GAS v2u*)(hout + off) + lane;
#pragma unroll
        for (int j = 0; j < 4; ++j) { const f32x4 h = (xv[j] * r) * sp[64 * j] + hp[64 * j];
            v2u w; w.x = pg8::cvt_pk_bf16(h.x, h.y); w.y = pg8::cvt_pk_bf16(h.z, h.w); ho[64 * j] = w; }
        LDS_WAIT();
    }
}

#define MFMA32(a, b, c) __builtin_amdgcn_mfma_f32_32x32x16_bf16(a, b, c, 0, 0, 0)
#define MFMA16(a, b, c) __builtin_amdgcn_mfma_f32_16x16x32_bf16(a, b, c, 0, 0, 0)
struct ScanPtrs { const float *lam_re, *lam_im, *log_dt, *b_re, *b_im, *c_re, *c_im, *dsk; const bf16* U; float* YP; bf16* ACT; };

__device__ __forceinline__ void s5_disc(const float* lam_re, const float* lam_im, int ldg, int pp, float dt, float& lbr, float& lbi, float& cr, float& ci) {
    const float lr = lam_re[ldg * 64 + pp], li = lam_im[ldg * 64 + pp];
    const float a = lr * dt, th = li * dt; float sn, cs; sincosf(th, &sn, &cs);
    const float em1 = expm1f(a), mag = em1 + 1.0f; float sh_, ch_; sincosf(0.5f * th, &sh_, &ch_);
    lbr = mag * cs; lbi = mag * sn;
    const float nr = em1 * cs - 2.0f * sh_ * sh_, ni = lbi;
    const float den = 1.0f / (lr * lr + li * li);
    cr = (nr * lr + ni * li) * den; ci = (ni * lr - nr * li) * den;
}
__device__ __forceinline__ float gelu_tanh(float y) { const float z = 0.7978845608028654f * (y + 0.044715f * y * y * y); return y * pg8::sigm(2.0f * z); }

constexpr int SELF_CI = 22;
template <bool REV>
__device__ __forceinline__ void scan_chain(LAS unsigned char* sl, LAS unsigned* flags, int layer, int b, int g, const ScanPtrs P, int lane, bool ctx_out) {
    const int d = REV ? 1 : 0, ldg = (layer * 2 + d) * 64 + g, hh = lane >> 5, l31 = lane & 31;
    const float dt = expf(P.log_dt[ldg]);
    float lb0r, lb0i, c0r, c0i, lb1r, lb1i, c1r, c1i;
    s5_disc(P.lam_re, P.lam_im, ldg, l31, dt, lb0r, lb0i, c0r, c0i);
    s5_disc(P.lam_re, P.lam_im, ldg, 32 + l31, dt, lb1r, lb1i, c1r, c1i);
    const float lr = hh ? lb1r : lb0r, li = hh ? lb1i : lb0i;
    bf16x8 bfr[4];
#pragma unroll
    for (int j = 0; j < 4; ++j) { const int pp = l31 + 32 * (j & 1); const float cr = (j & 1) ? c1r : c0r, ci = (j & 1) ? c1i : c0i;
        const float* br = P.b_re + ((size_t)ldg * 64 + pp) * 16 + 8 * hh; const float* bi = P.b_im + ((size_t)ldg * 64 + pp) * 16 + 8 * hh;
        const f32x4 r0 = *(const f32x4*)br, r1 = *(const f32x4*)(br + 4), i0 = *(const f32x4*)bi, i1 = *(const f32x4*)(bi + 4);
        f32x4 v0, v1; if (j < 2) { v0 = r0 * cr - i0 * ci; v1 = r1 * cr - i1 * ci; } else { v0 = i0 * cr + r0 * ci; v1 = i1 * cr + r1 * ci; }
        v4u w; w.x = pk2(v0.x, v0.y); w.y = pk2(v0.z, v0.w); w.z = pk2(v1.x, v1.y); w.w = pk2(v1.z, v1.w); bfr[j] = __builtin_bit_cast(bf16x8, w); }
    const int cc = lane & 15, kq = lane >> 4;
    bf16x8 cfr[4];
#pragma unroll
    for (int s = 0; s < 4; ++s) { const size_t o = ((size_t)ldg * 16 + cc) * 64 + 16 * s + 4 * kq; const f32x4 re = *(const f32x4*)(P.c_re + o), im = *(const f32x4*)(P.c_im + o);
        v4u w; w.x = pk2(re.x, -im.x); w.y = pk2(re.y, -im.y); w.z = pk2(re.z, -im.z); w.w = pk2(re.w, -im.w); cfr[s] = __builtin_bit_cast(bf16x8, w); }
    LAS unsigned char* SB = sl;
    float sr = 0.f, si = 0.f; int pend0 = -1, pend1 = -1;
    auto rowbase_of = [&](int ci) -> int { if (ci < 4) { const int c4 = REV ? 3 - ci : ci; return RL + b * CTX + c4 * 64; } const int lc = ci - 4, c32 = REV ? 31 - lc : lc; return b * SEQ + c32 * 64; };
    bf16x8 ufr[2], un1[2], un2[2];
    { const int rb = rowbase_of(0), r1 = rowbase_of(1);
#pragma unroll
      for (int i = 0; i < 2; ++i) { ufr[i] = *(const bf16x8*)(P.U + (size_t)(rb + 32 * i + l31) * 1024 + g * 16 + 8 * hh); un1[i] = *(const bf16x8*)(P.U + (size_t)(r1 + 32 * i + l31) * 1024 + g * 16 + 8 * hh); } }
    un2[0] = un1[0]; un2[1] = un1[1];
    const f32x4 dk4 = *(const f32x4*)(P.dsk + layer * 1024 + g * 16 + 4 * kq);
    for (int ci = 0; ci < 36; ++ci) {
        const int rb = rowbase_of(ci);
        const int fidx = ci < 4 ? (REV ? 3 - ci : ci) : 4 + (REV ? 35 - ci : ci - 4);
        const bool selfc = ci >= SELF_CI;
        unsigned long long op[8]; v2u uu[4];
#pragma unroll
        for (int e = 0; e < 4; ++e) { op[2 * e] = 0ull; op[2 * e + 1] = 0ull; uu[e] = (v2u){0u, 0u}; }
        if (selfc) {
            while (__hip_atomic_load(flags + fidx, __ATOMIC_RELAXED, __HIP_MEMORY_SCOPE_WORKGROUP) < 1u) __builtin_amdgcn_s_sleep(2);
            asm volatile("" ::: "memory");
            const size_t eo = (size_t)(rb + cc) * 1024 + g * 16 + 4 * kq;
            const unsigned long long* opp = (const unsigned long long*)(P.YP + (size_t)(1 - d) * RT * 1024 + eo); const bf16* upp = P.U + eo;
#pragma unroll
            for (int f = 0; f < 4; ++f) { op[2 * f] = __hip_atomic_load(opp + (size_t)f * 8192, RLX_AGENT); op[2 * f + 1] = __hip_atomic_load(opp + (size_t)f * 8192 + 1, RLX_AGENT); uu[f] = *(const v2u*)(upp + (size_t)f * 16384); }
        }
        if (ci + 2 < 36) { const int rn = rowbase_of(ci + 2);
#pragma unroll
            for (int i = 0; i < 2; ++i) un2[i] = *(const bf16x8*)(P.U + (size_t)(rn + 32 * i + l31) * 1024 + g * 16 + 8 * hh); }
#pragma unroll
        for (int ib = 0; ib < 2; ++ib) { const int i = REV ? 1 - ib : ib;
            const f32x16 z = {0.f, 0.f, 0.f, 0.f, 0.f, 0.f, 0.f, 0.f, 0.f, 0.f, 0.f, 0.f, 0.f, 0.f, 0.f, 0.f};
            f32x16 x0 = MFMA32(ufr[i], bfr[0], z), x1 = MFMA32(ufr[i], bfr[1], z), x2 = MFMA32(ufr[i], bfr[2], z), x3 = MFMA32(ufr[i], bfr[3], z);
#pragma unroll
            for (int r = 0; r < 16; ++r) {
                auto pa = __builtin_amdgcn_permlane32_swap(__float_as_uint(x0[r]), __float_as_uint(x1[r]), false, false); x0[r] = __uint_as_float(pa[0]); x1[r] = __uint_as_float(pa[1]);
                auto pc = __builtin_amdgcn_permlane32_swap(__float_as_uint(x2[r]), __float_as_uint(x3[r]), false, false); x2[r] = __uint_as_float(pc[0]); x3[r] = __uint_as_float(pc[1]);
            }
#pragma unroll
            for (int k = 0; k < 32; ++k) { const int t = REV ? 31 - k : k; const int tg = (t >> 2) & 1, rg = (t & 3) + 4 * (t >> 3);
                const float xr = tg ? x1[rg] : x0[rg], xi = tg ? x3[rg] : x2[rg];
                const float nr = fmaf(-li, si, fmaf(lr, sr, xr)), ni = fmaf(li, sr, fmaf(lr, si, xi)); sr = nr; si = ni;
                *(LAS unsigned*)(SB + (32 * i + t) * 272 + lane * 4) = pg8::cvt_pk_bf16(sr, si); }
        }
        LDS_WAIT(); asm volatile("" ::: "memory");
        if (ci >= 4 || ctx_out) {
            f32x4 ya[4];
#pragma unroll
            for (int f = 0; f < 4; ++f) { f32x4 a = {0.f, 0.f, 0.f, 0.f};
#pragma unroll
                for (int s = 0; s < 4; ++s) { const bf16x8 af = *(const LAS bf16x8*)(SB + (16 * f + cc) * 272 + (32 * s + 8 * kq) * 2); a = MFMA16(cfr[s], af, a); }
                ya[f] = a; }
            if (!selfc) {
            asm volatile("s_waitcnt vmcnt(6)" ::: "memory");
            if (pend1 >= 0 && lane == 0) (void)__hip_atomic_fetch_add(flags + pend1, 1u, __ATOMIC_RELAXED, __HIP_MEMORY_SCOPE_WORKGROUP);
            pend1 = pend0; pend0 = fidx;
            float* myp = P.YP + ((size_t)d * RT + rb + cc) * 1024 + g * 16 + 4 * kq;
#pragma unroll
            for (int f = 0; f < 4; ++f) *(f32x4*)(myp + (size_t)f * 16384) = ya[f];
            } else {
                VM_WAIT();
                if (lane == 0) { if (pend1 >= 0) (void)__hip_atomic_fetch_add(flags + pend1, 1u, __ATOMIC_RELAXED, __HIP_MEMORY_SCOPE_WORKGROUP);
                                 if (pend0 >= 0) (void)__hip_atomic_fetch_add(flags + pend0, 1u, __ATOMIC_RELAXED, __HIP_MEMORY_SCOPE_WORKGROUP); }
                pend1 = -1; pend0 = -1;
                bf16* ap = P.ACT + (size_t)(rb + cc) * 1024 + g * 16 + 4 * kq;
#pragma unroll
                for (int f = 0; f < 4; ++f) {
                    const float y0 = ya[f][0] + __uint_as_float((unsigned)op[2 * f]) + dk4[0] * pg8::bflo(uu[f].x), y1 = ya[f][1] + __uint_as_float((unsigned)(op[2 * f] >> 32)) + dk4[1] * pg8::bfhi(uu[f].x);
                    const float y2 = ya[f][2] + __uint_as_float((unsigned)op[2 * f + 1]) + dk4[2] * pg8::bflo(uu[f].y), y3 = ya[f][3] + __uint_as_float((unsigned)(op[2 * f + 1] >> 32)) + dk4[3] * pg8::bfhi(uu[f].y);
                    v2u w; w.x = pg8::cvt_pk_bf16(gelu_tanh(y0), gelu_tanh(y1)); w.y = pg8::cvt_pk_bf16(gelu_tanh(y2), gelu_tanh(y3)); *(v2u*)(ap + (size_t)f * 16384) = w; }
            }
        }
        ufr[0] = un1[0]; ufr[1] = un1[1]; un1[0] = un2[0]; un1[1] = un2[1];
    }
    VM_WAIT();
    if (lane == 0) { if (pend1 >= 0) (void)__hip_atomic_fetch_add(flags + pend1, 1u, __ATOMIC_RELAXED, __HIP_MEMORY_SCOPE_WORKGROUP);
                     if (pend0 >= 0) (void)__hip_atomic_fetch_add(flags + pend0, 1u, __ATOMIC_RELAXED, __HIP_MEMORY_SCOPE_WORKGROUP); }
}


__device__ __forceinline__ void scan_combine(const ScanPtrs P, int layer, int b, int g, int fidx, int lane) {
    const int rb = fidx < 4 ? RL + b * CTX + fidx * 64 : b * SEQ + (fidx - 4) * 64;
    const size_t ro = (size_t)(rb + lane) * 1024 + g * 16;
    const unsigned long long* p0 = (const unsigned long long*)(P.YP + ro); const unsigned long long* p1 = (const unsigned long long*)(P.YP + (size_t)RT * 1024 + ro);
    unsigned long long a[8], c[8];
#pragma unroll
    for (int i = 0; i < 8; ++i) { a[i] = __hip_atomic_load(p0 + i, RLX_AGENT); c[i] = __hip_atomic_load(p1 + i, RLX_AGENT); }
    const v4u u0 = *(const v4u*)(P.U + ro), u1 = *(const v4u*)(P.U + ro + 8);
    const unsigned uw[8] = {u0.x, u0.y, u0.z, u0.w, u1.x, u1.y, u1.z, u1.w};
    const float* dk = P.dsk + layer * 1024 + g * 16;
    unsigned ow[8];
#pragma unroll
    for (int i = 0; i < 8; ++i) {
        const float y0 = __uint_as_float((unsigned)a[i]) + __uint_as_float((unsigned)c[i]) + dk[2 * i] * pg8::bflo(uw[i]);
        const float y1 = __uint_as_float((unsigned)(a[i] >> 32)) + __uint_as_float((unsigned)(c[i] >> 32)) + dk[2 * i + 1] * pg8::bfhi(uw[i]);
        ow[i] = pg8::cvt_pk_bf16(gelu_tanh(y0), gelu_tanh(y1)); }
    v4u o0 = {ow[0], ow[1], ow[2], ow[3]}, o1 = {ow[4], ow[5], ow[6], ow[7]};
    *(v4u*)(P.ACT + ro) = o0; *(v4u*)(P.ACT + ro + 8) = o1;
}
struct AttPtrs { const bf16 *Q, *K, *VTl, *VTc; bf16* O; const float* rpb; };
constexpr int ATT_KS = 144, ATT_VS = 80, ATT_TILE = 32 * ATT_KS + 64 * ATT_VS;
struct AttG { v4u k[4], v[4]; };
__device__ __forceinline__ void att_gload(AttG& G, const bf16* kblk, const bf16* vblk, int vstride, int lane) {
#pragma unroll
    for (int i = 0; i < 4; ++i) { G.k[i] = *(const v4u*)(kblk + (size_t)(8 * i + (lane >> 3)) * 1024 + (lane & 7) * 8);
                                  G.v[i] = *(const v4u*)(vblk + (size_t)(16 * i + (lane >> 2)) * vstride + (lane & 3) * 8); }
}
__device__ __forceinline__ void att_lwrite(const AttG& G, LAS unsigned char* tile, int lane) {
#pragma unroll
    for (int i = 0; i < 4; ++i) { *(LAS v4u*)(tile + (8 * i + (lane >> 3)) * ATT_KS + (lane & 7) * 16) = G.k[i];
        LAS unsigned char* vp = tile + 32 * ATT_KS + (16 * i + (lane >> 2)) * ATT_VS + 32 * ((lane & 3) >> 1) + 8 * (lane & 1); v2u lo = {G.v[i].x, G.v[i].y}, hi = {G.v[i].z, G.v[i].w}; *(LAS v2u*)vp = lo; *(LAS v2u*)(vp + 16) = hi; }
}
struct AttF { bf16x8 k[4]; v2u v[8]; };
__device__ __forceinline__ void att_fread(AttF& F, const LAS unsigned char* tile, int lane) {
    const int q = lane & 31, hh = lane >> 5;
#pragma unroll
    for (int ss = 0; ss < 4; ++ss) F.k[ss] = *(const LAS bf16x8*)(tile + q * ATT_KS + (16 * ss + 8 * hh) * 2);
#pragma unroll
    for (int f = 0; f < 2; ++f)
#pragma unroll
        for (int s2 = 0; s2 < 2; ++s2) { const v4u w = *(const LAS v4u*)(tile + 32 * ATT_KS + (32 * f + q) * ATT_VS + 32 * s2 + 16 * hh); F.v[(f * 2 + s2) * 2] = (v2u){w.x, w.y}; F.v[(f * 2 + s2) * 2 + 1] = (v2u){w.z, w.w}; }
}
__device__ __forceinline__ void att_compute(const AttF& B, const bf16x8 (&qf)[4], f32x16& o0, f32x16& o1, float& mrun, float& lrun, bool local, const unsigned (&colb)[4], unsigned rowb) {
    f32x16 s = {0.f, 0.f, 0.f, 0.f, 0.f, 0.f, 0.f, 0.f, 0.f, 0.f, 0.f, 0.f, 0.f, 0.f, 0.f, 0.f};
#pragma unroll
    for (int ss = 0; ss < 4; ++ss) s = MFMA32(B.k[ss], qf[ss], s);
    if (local) {
        float bs[16];
#pragma unroll
        for (int r = 0; r < 16; ++r) bs[r] = *(const LAS float*)(size_t)(((colb[r >> 2] >> (8 * (r & 3))) & 0xffu) + rowb);
#pragma unroll
        for (int r = 0; r < 16; ++r) s[r] += bs[r];
    }
    float bm = s[0];
#pragma unroll
    for (int r = 1; r < 16; ++r) bm = fmaxf(bm, s[r]);
    bm = fmaxf(bm, __shfl_xor(bm, 32));
    if (__any(bm > mrun)) {
        const float mn = fmaxf(mrun, bm), alpha = __builtin_amdgcn_exp2f(mrun - mn); mrun = mn;
        lrun = lrun * alpha; o0 = o0 * alpha; o1 = o1 * alpha;
    }
    float p[16]; float ps = 0.f;
#pragma unroll
    for (int r = 0; r < 16; ++r) { p[r] = __builtin_amdgcn_exp2f(s[r] - mrun); ps += p[r]; }
    lrun += ps;
#pragma unroll
    for (int s2 = 0; s2 < 2; ++s2) { v4u w; w.x = pg8::cvt_pk_bf16(p[8 * s2], p[8 * s2 + 1]); w.y = pg8::cvt_pk_bf16(p[8 * s2 + 2], p[8 * s2 + 3]);
        w.z = pg8::cvt_pk_bf16(p[8 * s2 + 4], p[8 * s2 + 5]); w.w = pg8::cvt_pk_bf16(p[8 * s2 + 6], p[8 * s2 + 7]); const bf16x8 pf = __builtin_bit_cast(bf16x8, w);
        { v4u a = {B.v[s2 * 2].x, B.v[s2 * 2].y, B.v[s2 * 2 + 1].x, B.v[s2 * 2 + 1].y}; o0 = MFMA32(__builtin_bit_cast(bf16x8, a), pf, o0); }
        { v4u a = {B.v[(2 + s2) * 2].x, B.v[(2 + s2) * 2].y, B.v[(2 + s2) * 2 + 1].x, B.v[(2 + s2) * 2 + 1].y}; o1 = MFMA32(__builtin_bit_cast(bf16x8, a), pf, o1); } }
}
__device__ __forceinline__ void att_item(int item, int layer, const AttPtrs P, LAS unsigned char* tile, LAS float* btab, int& tab_head, int lane) {
    const int q = lane & 31, hh = lane >> 5;
    const bool local = item < 4096;
    int b, h, r = 0, half = 0, qrow;
    if (local) { half = item & 1; r = (item >> 1) & 31; h = (item >> 6) & 15; b = item >> 10; qrow = b * SEQ + r * 64 + half * 32 + q; }
    else { const int it = item - 4096; const int qb = it & 7; h = (it >> 3) & 15; b = it >> 7; qrow = RL + b * CTX + qb * 32 + q; }
    if (local && tab_head != h) {
        LDS_WAIT(); asm volatile("" ::: "memory");
        const float* src = P.rpb + ((size_t)layer * NHEAD + h) * 465;
        for (int i = lane; i < 480; i += 64) { const int ro = i >> 5, j = i & 31; btab[i] = j < 31 ? src[ro * 31 + j] * LOG2E : -1e30f; }
        LDS_WAIT(); asm volatile("" ::: "memory");
        tab_head = h;
    }
    bf16x8 qf[4];
#pragma unroll
    for (int s = 0; s < 4; ++s) qf[s] = *(const bf16x8*)(P.Q + (size_t)qrow * 1024 + h * 64 + 16 * s + 8 * hh);
    f32x16 o0 = {0.f, 0.f, 0.f, 0.f, 0.f, 0.f, 0.f, 0.f, 0.f, 0.f, 0.f, 0.f, 0.f, 0.f, 0.f, 0.f}, o1 = o0; float mrun = -1e30f, lrun = 0.f;
    const bf16* vtc = P.VTc + (size_t)(b * 16 + h) * 64 * CTX;
    const bf16* kc = P.K + (size_t)(RL + b * CTX) * 1024 + h * 64;
    int r0 = r - 4; r0 = r0 < 0 ? 0 : (r0 > 24 ? 24 : r0);
    const int c = half * 32 + q; int c0 = c - 8; c0 = c0 < 0 ? 0 : (c0 > 48 ? 48 : c0);
    const bf16* vtl = P.VTl + (size_t)(b * 16 + h) * 64 * SEQ;
    const bf16* kl = P.K + (size_t)(b * SEQ) * 1024 + h * 64;
    unsigned colb0[4] = {0u, 0u, 0u, 0u}, colb1[4] = {0u, 0u, 0u, 0u}; const unsigned tb = (unsigned)(size_t)btab;
#pragma unroll
    for (int rr = 0; rr < 16; ++rr) { const int k0 = (rr & 3) + 8 * (rr >> 2) + 4 * hh, k1 = 32 + k0;
        colb0[rr >> 2] |= (4u * (unsigned)(((unsigned)(k0 - c0) < 16u) ? k0 - c + 15 : 31)) << (8 * (rr & 3)); colb1[rr >> 2] |= (4u * (unsigned)(((unsigned)(k1 - c0) < 16u) ? k1 - c + 15 : 31)) << (8 * (rr & 3)); }
    const int npair = local ? 12 : 4;
    auto gl = [&](AttG& G, int i) { if (i < 8) att_gload(G, kc + (size_t)(32 * i) * 1024, vtc + 32 * i, CTX, lane);
                                    else { const int j = i - 8, t0 = (r0 + (j >> 1)) * 64 + 32 * (j & 1); att_gload(G, kl + (size_t)t0 * 1024, vtl + t0, SEQ, lane); } };
    const int nblk = 2 * npair;
    AttG G; gl(G, 0);
    att_lwrite(G, tile, lane);
    gl(G, 1);
    for (int p = 0; p < npair; ++p) {
        const bool loc = p >= 4; const unsigned rowb = tb + (loc ? (unsigned)((r0 + (p - 4) - r + 7) * 128) : 0u);
        { AttF F; LDS_WAIT(); asm volatile("" ::: "memory"); att_fread(F, tile, lane); LDS_WAIT(); asm volatile("" ::: "memory");
          att_lwrite(G, tile, lane); gl(G, 2 * p + 2 < nblk ? 2 * p + 2 : nblk - 1);
          att_compute(F, qf, o0, o1, mrun, lrun, loc, colb0, rowb); }
        { AttF F; LDS_WAIT(); asm volatile("" ::: "memory"); att_fread(F, tile, lane); LDS_WAIT(); asm volatile("" ::: "memory");
          att_lwrite(G, tile, lane); gl(G, 2 * p + 3 < nblk ? 2 * p + 3 : nblk - 1);
          att_compute(F, qf, o0, o1, mrun, lrun, loc, colb1, rowb); }
    }
    const float inv = 1.0f / (lrun + __shfl_xor(lrun, 32));
    bf16* op = P.O + (size_t)qrow * 1024 + h * 64 + 4 * hh;
#pragma unroll
    for (int g4 = 0; g4 < 4; ++g4) {
        v2u w0, w1; w0.x = pg8::cvt_pk_bf16(o0[4 * g4] * inv, o0[4 * g4 + 1] * inv); w0.y = pg8::cvt_pk_bf16(o0[4 * g4 + 2] * inv, o0[4 * g4 + 3] * inv);
        w1.x = pg8::cvt_pk_bf16(o1[4 * g4] * inv, o1[4 * g4 + 1] * inv); w1.y = pg8::cvt_pk_bf16(o1[4 * g4 + 2] * inv, o1[4 * g4 + 3] * inv);
        *(v2u*)(op + 8 * g4) = w0; *(v2u*)(op + 32 + 8 * g4) = w1; }
}

#ifndef REPEAT_MASK
#define REPEAT_MASK 0
#endif
#ifndef PROBE_SCAN_REP
#define PROBE_SCAN_REP 1
#endif
#ifndef PROBE_ATT_REP
#define PROBE_ATT_REP 1
#endif
#ifndef PHASE_MASK
#define PHASE_MASK 2047
#endif
constexpr int NPH = 2 + 9 * DEPTH;
struct Args { const float* in[26]; float* out; unsigned char* ws; int ph_lo, ph_hi, use_bar, pad; };
typedef const __attribute__((address_space(4))) Args* KArgs;
#define KARGS(ka) KArgs ka = (KArgs)__builtin_amdgcn_kernarg_segment_ptr(); asm volatile("" : "+s"(ka))

constexpr int I_IN = (DM / 64) * (PW / 32), I_VG = (SSMW / 64) * (DM / 32), I_NA = (NAW / 64) * (DM / 32), I_OUT = (DM / 64) * (DM / 32), I_F1 = (DM / 64) * (DFF / 32), I_F2 = (DFF / 64) * (DM / 32);
constexpr int I_MIX = I_IN + 2 * I_VG + I_NA + I_OUT, I_LAYER = I_MIX + I_F1 + I_F2;
__device__ __forceinline__ void conv_item(KArgs ka, unsigned char* ws, int l, int r, LAS float* scr, int lane) {
    unsigned char* wb = ws + WS_W + (size_t)l * W_LAYER;
    const float* src; int K, N, mode; size_t wo;
    if (r < I_IN) { src = ka->in[10] + (size_t)l * DM * PW; K = DM; N = PW; mode = 0; wo = WO_IN; }
    else if ((r -= I_IN) < I_VG) { src = ka->in[19] + (size_t)l * SSMW * DM; K = SSMW; N = DM; mode = 1; wo = WO_VG; }
    else if ((r -= I_VG) < I_VG) { src = ka->in[20] + (size_t)l * SSMW * DM; K = SSMW; N = DM; mode = 2; wo = WO_VG; }
    else if ((r -= I_VG) < I_NA) { src = ka->in[22] + (size_t)l * NAW * DM; K = NAW; N = DM; mode = 0; wo = WO_NA; }
    else if ((r -= I_NA) < I_OUT) { src = ka->in[23] + (size_t)l * DM * DM; K = DM; N = DM; mode = 0; wo = WO_OUT; }
    else if ((r -= I_OUT) < I_F1) { src = ka->in[24] + (size_t)l * DM * DFF; K = DM; N = DFF; mode = 0; wo = WO_FC1; }
    else { r -= I_F1; src = ka->in[25] + (size_t)l * DFF * DM; K = DFF; N = DM; mode = 0; wo = WO_FC2; }
    p0_transpose_item(src, K, N, (bf16*)(wb + wo), mode, scr, r, lane);
}

__device__ __forceinline__ void mod_gemv_items(KArgs ka, unsigned char* ws, LAS unsigned char* lds, int tid, int lane, int wave, int it0, int it1, int step) {
        {
            const float* c_in = ka->in[1]; const float* cctx_in = ka->in[3]; const float* w_mod = ka->in[4]; const float* b_mod = ka->in[5]; float* MOD = (float*)(ws + WS_MOD);
            LAS float* SIL = (LAS float*)(lds + 71680); LAS float* PART = (LAS float*)(lds + 112640);
            for (int i = tid; i < 5 * DM; i += NWAVES * 64) { const int r = i >> 11, k = i & 2047; const float v = r < 4 ? c_in[r * DM + k] : cctx_in[k]; SIL[i] = v / (1.0f + expf(-v)); }
            __syncthreads();
            for (int it = it0; it < it1; it += step) {
                const int l = it / 192, jn = it % 192, col = jn * 64 + lane, k0 = wave * 256;
                const float* W = w_mod + (size_t)l * DM * (NMOD * DM) + (size_t)k0 * (NMOD * DM) + col;
                float a0 = 0.f, a1 = 0.f, a2 = 0.f, a3 = 0.f, a4 = 0.f;
#pragma unroll 4
                for (int kk = 0; kk < 256; kk += 4) {
                    const float w0 = __builtin_nontemporal_load(W + (size_t)(kk + 0) * (NMOD * DM)), w1 = __builtin_nontemporal_load(W + (size_t)(kk + 1) * (NMOD * DM)), w2 = __builtin_nontemporal_load(W + (size_t)(kk + 2) * (NMOD * DM)), w3 = __builtin_nontemporal_load(W + (size_t)(kk + 3) * (NMOD * DM));
                    const f32x4 s0 = *(const LAS f32x4*)(SIL + 0 * DM + k0 + kk), s1 = *(const LAS f32x4*)(SIL + 1 * DM + k0 + kk), s2 = *(const LAS f32x4*)(SIL + 2 * DM + k0 + kk),
                                s3 = *(const LAS f32x4*)(SIL + 3 * DM + k0 + kk), s4 = *(const LAS f32x4*)(SIL + 4 * DM + k0 + kk);
                    a0 += s0.x * w0 + s0.y * w1 + s0.z * w2 + s0.w * w3; a1 += s1.x * w0 + s1.y * w1 + s1.z * w2 + s1.w * w3; a2 += s2.x * w0 + s2.y * w1 + s2.z * w2 + s2.w * w3;
                    a3 += s3.x * w0 + s3.y * w1 + s3.z * w2 + s3.w * w3; a4 += s4.x * w0 + s4.y * w1 + s4.z * w2 + s4.w * w3;
                }
                PART[(wave * 5 + 0) * 64 + lane] = a0; PART[(wave * 5 + 1) * 64 + lane] = a1; PART[(wave * 5 + 2) * 64 + lane] = a2; PART[(wave * 5 + 3) * 64 + lane] = a3; PART[(wave * 5 + 4) * 64 + lane] = a4;
                __syncthreads();
                if (wave < 5) { float s = b_mod[l * (NMOD * DM) + col];
#pragma unroll
                    for (int w = 0; w < 8; ++w) s += PART[(w * 5 + wave) * 64 + lane];
                    const int kidx = jn >> 5, c = col & (DM - 1);
                    if (kidx == 1) s = ka->in[6][l * DM + c] * (1.0f + s); else if (kidx == 2) s *= ka->in[7][l * DM + c];
                    else if (kidx == 4) s = ka->in[8][l * DM + c] * (1.0f + s); else if (kidx == 5) s *= ka->in[9][l * DM + c];
                    MOD[(size_t)(l * 5 + wave) * (NMOD * DM) + col] = s; }
                __syncthreads();
            }
        }
}
#define IDLE_COPY(nun, cl, lo_, hi_) do { const int first_ = (nun) % G; if (first_ != 0 && bx >= first_) { const int nid_ = G - first_, j_ = bx - first_, per_ = ((hi_) - (lo_) + nid_ - 1) / nid_; \
        const int a_ = (lo_) + j_ * per_, b_ = (a_ + per_ < (hi_)) ? a_ + per_ : (hi_); LAS float* scr_ = (LAS float*)(lds + wave * 8704); \
        for (int it_ = a_ + wave; it_ < b_; it_ += NWAVES) conv_item(ka, ws, cl, it_, scr_, lane); } } while (0)
__global__ void __launch_bounds__(NWAVES * 64, 2) mega_fwd(Args args_unused) {
    extern __shared__ __attribute__((aligned(16))) unsigned char lds_raw[];
    LAS unsigned char* lds = (LAS unsigned char*)lds_raw;
    const int tid0 = threadIdx.x, wave = __builtin_amdgcn_readfirstlane(tid0 >> 6);
    const int G = gridDim.x, bx = blockIdx.x;
    const int vcu = (G % 8 == 0) ? (bx % 8) * (G / 8) + bx / 8 : bx;
    const int gw = vcu * NWAVES + wave, NGW = G * NWAVES;
    for (int u = tid0; u < (LDS_BYTES - RING_BYTES) / 4; u += NWAVES * 64) ((LAS unsigned*)(lds + RING_BYTES))[u] = 0u;
    __syncthreads();
    int lo, hi, use_bar;
    { KARGS(ka); lo = ka->ph_lo; hi = ka->ph_hi; use_bar = ka->use_bar;
      if (use_bar) (void)xcd_barrier_post((unsigned*)(ka->ws + WS_CTL) + CW_BAR, (volatile LAS unsigned*)(lds + MISC_OFF) + 8); }
    for (int ph = lo; ph < hi; ++ph) {
    const int l = ph >= 2 ? (ph - 2) / 9 : 0, pk = ph >= 2 ? (ph - 2) % 9 : -1; const bool last = (l == DEPTH - 1);
    const int Mrows = last ? RL : RT;
    const int pbit = ph == 0 ? 512 : (ph == 1 ? 1024 : (1 << pk)); const int nrep = (REPEAT_MASK & pbit) ? 2 : 1;
    for (int rep = 0; rep < nrep; ++rep) {
    int tid = threadIdx.x; asm volatile("" : "+v"(tid)); const int lane = tid & 63;
    if (ph == 0 && (PHASE_MASK & 512)) {
        KARGS(ka); unsigned char* ws = ka->ws;
        {
            mod_gemv_items(ka, ws, lds, tid, lane, wave, bx, 192, G);
            float* ROPE = (float*)(ws + WS_ROPE);
            if (bx == G - 1) for (int i = tid; i < 64 * 16; i += NWAVES * 64) { const int pos = i >> 4, f = i & 15; const float inv = powf(10000.0f, -(float)f / 16.0f); const float ang = (float)pos * inv;
                float sn, cs; sincosf(ang, &sn, &cs); ROPE[2 * i] = cs; ROPE[2 * i + 1] = sn; }
        }
        LAS float* scr = (LAS float*)(lds + wave * 8704);
        for (int it = gw; it < I_MIX; it += NGW) conv_item(ka, ws, 0, it, scr, lane);
    }
    else if (ph == 1 && (PHASE_MASK & 1024)) {
        KARGS(ka); unsigned char* ws = ka->ws; const float* x_in = ka->in[0]; const float* ctx_in = ka->in[2];
        const float* MOD = (const float*)(ws + WS_MOD); bf16* H = (bf16*)(ws + WS_H);
        rowpass_pipe<false, 0, true>(lane, gw, NGW, RL, x_in, false, nullptr, nullptr, H, nullptr, MOD, 1, 0, -1);
        rowpass_pipe<false, 0, true>(lane, (gw & 1) ? RC : (gw >> 1), NGW / 2, RC, ctx_in, false, nullptr, nullptr, H + (size_t)RL * DM, nullptr, MOD, 1, 0, 4);
    }
    else {
        if (pk == 0 && (PHASE_MASK & 1)) {
            KARGS(ka); unsigned char* ws = ka->ws; unsigned char* wb = ws + WS_W + (size_t)l * W_LAYER; unsigned char* pj = ws + WS_PROJ;
            pg8::Gemm g{(const bf16*)(ws + WS_H), (const bf16*)(wb + WO_IN), RT, PW, DM};
            pg8::EpiIn E{(bf16*)(pj + PO_U), (bf16*)(pj + PO_Q), (bf16*)(pj + PO_K), (bf16*)(pj + PO_VTL), (bf16*)(pj + PO_VTC), (bf16*)(pj + PO_GS), (bf16*)(pj + PO_GN), (const float*)(ws + WS_ROPE)};
            if (!last) { pg8::StaticOrder S; S.init(RT, PW, G, bx); pg8::gemm_phase<pg8::EpiIn, pg8::StaticOrder, true, true>(lds, g, S, E); IDLE_COPY((RT / 256) * (PW / 256), 0, I_MIX, I_LAYER); }
            else { pg8::OrderL1In S; S.init(RL, PW, G, bx); pg8::gemm_phase<pg8::EpiIn, pg8::OrderL1In, true, true>(lds, g, S, E); IDLE_COPY((RL / 256) * (PW / 256) + 48, 1, I_MIX, I_LAYER); }
        }
        else if (pk == 1 && (PHASE_MASK & 2)) {
            KARGS(ka); unsigned char* ws = ka->ws; unsigned char* pj = ws + WS_PROJ;
            const ScanPtrs SPp{ka->in[11], ka->in[12], ka->in[13], ka->in[14], ka->in[15], ka->in[16], ka->in[17], ka->in[18], (const bf16*)(pj + PO_U), (float*)(ws + WS_OUT), (bf16*)(ws + WS_ACT)};
            LAS unsigned* flagb = (LAS unsigned*)(lds + MISC_OFF) + 16;
            if (tid < 320) flagb[tid] = 0u;
            if (tid == 0) ((LAS unsigned*)(lds + MISC_OFF))[12] = 0u;
            LDS_WAIT(); __syncthreads();
            LAS unsigned* cctr = (LAS unsigned*)(lds + MISC_OFF) + 12;
            if (wave < 2) {
                __builtin_amdgcn_s_setprio(3);
                LAS unsigned char* sl = lds + wave * SCAN_LDS; int iter = 0;
                for (int rp = 0; rp < PROBE_SCAN_REP; ++rp)
                for (int pair = bx; pair < NB * SG; pair += G, ++iter) {
                    LAS unsigned* flags = flagb + (iter & 7) * 40;
                    if (wave == 0) scan_chain<false>(sl, flags, l, pair >> 6, pair & 63, SPp, lane, !last);
                    else scan_chain<true>(sl, flags, l, pair >> 6, pair & 63, SPp, lane, !last);
                }
                __builtin_amdgcn_s_setprio(0);
            } else {
                LAS unsigned char* tile = lds + 2 * SCAN_LDS + (wave - 2) * ATT_TILE;
                {
                    const AttPtrs AP{(const bf16*)(pj + PO_Q), (const bf16*)(pj + PO_K), (const bf16*)(pj + PO_VTL), (const bf16*)(pj + PO_VTC), (bf16*)(ws + WS_ATT), ka->in[21]};
                    LAS float* btab = (LAS float*)(lds + 2 * SCAN_LDS + 6 * ATT_TILE + (wave - 2) * 2048); int tab_head = -1;
                    const int ipp = last ? 64 : 72, nq = 8 * ipp, xg = bx & 7, slot = (bx >> 3) * 6 + (wave - 2), nslot = (G >> 3) * 6;
                    const int ncl = last ? 4 : 8; int cpair = bx, citer = 0, cli = wave - 2;
                    for (int q = slot; ; q += nslot) {
                        const bool have = q < nq;
                        if (have) { const int pid = xg * 8 + q / ipp, w = q % ipp;
                            att_item(w < 64 ? pid * 64 + w : 4096 + pid * 8 + (w - 64), l, AP, tile, btab, tab_head, lane); }
                        while (cpair < NB * SG) {
                            if (cli >= ncl) { cli = wave - 2; cpair += G; ++citer; continue; }
                            const int cfc = last ? 18 + cli : (cli < 4 ? cli : 14 + cli);
                            volatile LAS unsigned* flags = (volatile LAS unsigned*)(flagb + (citer & 7) * 40);
                            if (flags[cfc] < 2u) { if (have) break;
                                unsigned spins = 0; while (flags[cfc] < 2u && ++spins < (1u << 24)) __builtin_amdgcn_s_sleep(8); }
                            asm volatile("" ::: "memory");
                            scan_combine(SPp, l, cpair >> 6, cpair & 63, cfc, lane);
                            cli += 6;
                        }
                        if (!have) break;
                    }
                }
            }
            __syncthreads();
        }
        else if (pk == 2 && (PHASE_MASK & 4)) {
            KARGS(ka); unsigned char* ws = ka->ws; unsigned char* wb = ws + WS_W + (size_t)l * W_LAYER;
            pg8::Gemm g{(const bf16*)(ws + WS_ACT), (const bf16*)(wb + WO_VG), Mrows, 2 * DM, SSMW}; pg8::StaticOrder S; S.init(Mrows, 2 * DM, G, bx);
            pg8::EpiD1 E{(const bf16*)(ws + WS_PROJ + PO_GS), (bf16*)(ws + WS_TM)};
            pg8::gemm_phase<pg8::EpiD1, pg8::StaticOrder, true, true>(lds, g, S, E);
            if (!last) { const int first = ((Mrows / 256) * (2 * DM / 256)) % G; if (first != 0 && bx >= first) mod_gemv_items(ka, ws, lds, tid, lane, wave, 192 + bx - first, 2 * 192, G - first); else if (first == 0) mod_gemv_items(ka, ws, lds, tid, lane, wave, 192 + bx, 2 * 192, G); }
        }
        else if (pk == 3 && (PHASE_MASK & 8)) {
            KARGS(ka); unsigned char* ws = ka->ws; unsigned char* wb = ws + WS_W + (size_t)l * W_LAYER;
            pg8::Gemm g{(const bf16*)(ws + WS_ATT), (const bf16*)(wb + WO_NA), Mrows, DM, NAW}; pg8::StaticOrder S; S.init(Mrows, DM, G, bx);
            pg8::EpiD2 E{(const bf16*)(ws + WS_PROJ + PO_GN), (bf16*)(ws + WS_TM)};
            pg8::gemm_phase<pg8::EpiD2, pg8::StaticOrder, true, true>(lds, g, S, E);
        }
        else if (pk == 4 && (PHASE_MASK & 16)) {
            KARGS(ka); unsigned char* ws = ka->ws; unsigned char* wb = ws + WS_W + (size_t)l * W_LAYER;
            pg8::Gemm g{(const bf16*)(ws + WS_TM), (const bf16*)(wb + WO_OUT), Mrows, DM, DM}; pg8::OrderSplitCtx S; S.init(RL, DM, G, bx); S.ksl = DM / 64 / 8; S.nctx = last ? 0 : 256;
            pg8::EpiF32S E{(bf16*)(ws + WS_OUT), (bf16*)(ws + WS_SLAB)};
            pg8::gemm_phase<pg8::EpiF32S, pg8::OrderSplitCtx, true, true>(lds, g, S, E);
        }
        else if ((pk == 5 && (PHASE_MASK & 32)) || (pk == 8 && (PHASE_MASK & 256))) {
            KARGS(ka); unsigned char* ws = ka->ws; const bool r2 = pk == 8;
            const float* mdl = (const float*)(ws + WS_MOD) + (size_t)(l * 5) * (NMOD * DM); const float* modg = mdl + (r2 ? 5 : 2) * DM;
            const float* modh = r2 ? mdl + (size_t)5 * (NMOD * DM) : mdl; const int kss = r2 ? 1 : 4, ksh = r2 ? 0 : 3;
            bf16* H = (bf16*)(ws + WS_H); bf16* XA = (bf16*)(ws + WS_XA); const bool xf = !r2 && l == 0;
            if (!last) rowpass_ctx8((LAS float*)(lds + MISC_OFF + 4096), lane, wave, vcu, G, xf ? (const void*)ka->in[2] : (const void*)(XA + (size_t)RL * DM), !xf, (const bf16*)(ws + WS_SLAB), XA + (size_t)RL * DM, H + (size_t)RL * DM,
                                    modg + (size_t)4 * (NMOD * DM), modh + (size_t)4 * (NMOD * DM) + kss * DM, modh + (size_t)4 * (NMOD * DM) + ksh * DM);
            if (!(r2 && last)) rowpass_pipe<true, 2, true>(lane, gw, NGW, RL, xf ? (const void*)ka->in[0] : (const void*)XA, !xf, (const bf16*)(ws + WS_OUT), XA, H, modg, modh, kss, ksh, -1);
            else rowpass_pipe<true, 1, false>(lane, gw, NGW, RL, XA, true, (const bf16*)(ws + WS_OUT), ka->out, nullptr, modg, nullptr, 0, 0, -1);
        }
        else if (pk == 6 && (PHASE_MASK & 64)) {
            KARGS(ka); unsigned char* ws = ka->ws; unsigned char* wb = ws + WS_W + (size_t)l * W_LAYER;
            pg8::Gemm g{(const bf16*)(ws + WS_H), (const bf16*)(wb + WO_FC1), Mrows, DFF, DM}; pg8::StaticOrder S; S.init(Mrows, DFF, G, bx);
            pg8::EpiRelu2 E{(bf16*)(ws + WS_PROJ), DFF};
            pg8::gemm_phase<pg8::EpiRelu2, pg8::StaticOrder, true, true>(lds, g, S, E);
            if (!last) IDLE_COPY((RT / 256) * (DFF / 256), 1, 0, I_MIX);
        }
        else if (pk == 7 && (PHASE_MASK & 128)) {
            KARGS(ka); unsigned char* ws = ka->ws; unsigned char* wb = ws + WS_W + (size_t)l * W_LAYER;
            pg8::Gemm g{(const bf16*)(ws + WS_PROJ), (const bf16*)(wb + WO_FC2), Mrows, DM, DFF}; pg8::OrderSplitCtx S; S.init(RL, DM, G, bx); S.ksl = DFF / 64 / 8; S.nctx = last ? 0 : 256;
            pg8::EpiF32S E{(bf16*)(ws + WS_OUT), (bf16*)(ws + WS_SLAB)};
            pg8::gemm_phase<pg8::EpiF32S, pg8::OrderSplitCtx, true, true>(lds, g, S, E);
        }
    }
    }
    if (ph + 1 < hi && use_bar) {
        KARGS(kb); XcdBarrier b2; b2.bar = (unsigned*)(kb->ws + WS_CTL) + CW_BAR; b2.x = xb_xcc_id(); b2.st = (volatile LAS unsigned*)(lds + MISC_OFF) + 8;
        xcd_barrier(b2);
    }
    }
}

extern "C" void kernel_launch(void* const* d_in, const int* in_sizes, int n_in, void* d_out, int out_size, void* d_ws, size_t ws_size, hipStream_t stream) {
    static int grid = 0;
    if (grid == 0) {
        if (n_in != 26 || in_sizes[0] != RL * DM || out_size != RL * DM || ws_size < WS_END) { fprintf(stderr, "kernel_launch: unexpected shapes / workspace (n_in %d, in0 %d, out %d, ws %zu < %zu); nothing launched\n", n_in, n_in > 0 ? in_sizes[0] : -1, out_size, ws_size, (size_t)WS_END); grid = -1; return; }
        int dev = 0, cus = 0, per_cu = 0;
        if (hipGetDevice(&dev) != hipSuccess || hipDeviceGetAttribute(&cus, hipDeviceAttributeMultiprocessorCount, dev) != hipSuccess) { grid = -1; return; }
        if (hipFuncSetAttribute((const void*)mega_fwd, hipFuncAttributeMaxDynamicSharedMemorySize, LDS_BYTES) != hipSuccess) { fprintf(stderr, "kernel_launch: hipFuncSetAttribute failed\n"); grid = -1; return; }
        if (hipOccupancyMaxActiveBlocksPerMultiprocessor(&per_cu, (const void*)mega_fwd, NWAVES * 64, LDS_BYTES) != hipSuccess || per_cu < 1) { fprintf(stderr, "kernel_launch: occupancy query says %d blocks per CU; nothing launched\n", per_cu); (void)hipGetLastError(); grid = -1; return; }
        grid = cus;
    }
    if (grid < 0) return;
    (void)hipMemsetAsync((char*)d_ws + WS_CTL, 0, CTL_ZERO_BYTES, stream);
    Args a{};
    for (int i = 0; i < 26; ++i) a.in[i] = (const float*)d_in[i];
    a.out = (float*)d_out; a.ws = (unsigned char*)d_ws;
#if MK_PER_PHASE
    for (int p = 0; p < NPH; ++p) { a.ph_lo = p; a.ph_hi = p + 1; a.use_bar = 0; a.pad = 0; hipLaunchKernelGGL(mega_fwd, dim3(grid), dim3(NWAVES * 64), LDS_BYTES, stream, a); }
#else
    a.ph_lo = 0; a.ph_hi = NPH; a.use_bar = 1; a.pad = 0;
    hipLaunchKernelGGL(mega_fwd, dim3(grid), dim3(NWAVES * 64), LDS_BYTES, stream, a);
#endif
}
```

```cpp
#include <hip/hip_runtime.h>
#include <cstdio>
#include <cstdint>
#ifndef MK_PER_PHASE
#define MK_PER_PHASE 0
#endif
namespace pg8 {
#define PG8_LAS __attribute__((address_space(3)))
typedef unsigned short bf16_t;
typedef short bf16x8 __attribute__((ext_vector_type(8)));
typedef float f32x4 __attribute__((ext_vector_type(4)));
typedef unsigned u32x4 __attribute__((ext_vector_type(4)));
constexpr int BM = 256, BK = 64, HALF = 128, HTB = HALF * BK * 2  , STAGE_BYTES = 8 * HTB, NXCD = 8, WGM = 8;

__host__ __device__ __forceinline__ int lds_byte(int r, int c) { const int st = (r >> 4) * 2 + (c >> 5), rr = r & 15, cc = c & 31, ob = rr * 64 + cc * 2; return st * 1024 + (ob ^ (((ob >> 9) & 1) << 5)); }
__host__ __device__ __forceinline__ void stage_rc(int b, int& R, int& C) { const int st = b / 1024, sb = b % 1024, swz = sb ^ (((sb >> 9) & 1) << 5); R = (st >> 1) * 16 + swz / 64; C = (st & 1) * 32 + (swz % 64) / 2; }
__host__ __device__ __forceinline__ int perm32(int rho) { const int n = rho >> 4, i = rho & 15; return 8 * (i >> 2) + 4 * n + (i & 3); }

struct Unit { int pm, pn, nt, ks; };
struct Gemm { const bf16_t* A; const bf16_t* Bt; int M, N, K; };

struct StaticOrder {
    int nM, nN, nwg, G, c;
    __host__ __device__ void init(int M, int N, int G_, int c_) { nM = M / BM; nN = N / BM; nwg = nM * nN; G = G_; c = c_; }
    __host__ __device__ __forceinline__ bool next(int i, Unit& u, int ntdef) const {
        u.nt = ntdef; u.ks = 0; u.pm = 0; u.pn = 0;
        const long L = (long)i * G + c; if (L >= nwg) return false;
        int wgid = (int)L; { const int q = nwg / NXCD, r = nwg % NXCD, xcd = wgid % NXCD, off = wgid / NXCD; wgid = (xcd < r ? xcd * (q + 1) : r * (q + 1) + (xcd - r) * q) + off; }
        const int nig = WGM * nN, gid = wgid / nig, fm = gid * WGM, gsz = (nM - fm) < WGM ? (nM - fm) : WGM;
        u.pm = fm + ((wgid % nig) % gsz); u.pn = (wgid % nig) / gsz; return true;
    }
    __device__ __forceinline__ void a_ready(const Unit&) const {}
    __device__ __forceinline__ void done(const Unit&) const {}
};


__device__ __forceinline__ unsigned cvt_pk_bf16(float lo, float hi) { unsigned r; asm volatile("v_cvt_pk_bf16_f32 %0, %1, %2" : "=v"(r) : "v"(lo), "v"(hi)); return r; }
typedef unsigned u32x2 __attribute__((ext_vector_type(2)));
__device__ __forceinline__ float sigm(float x) { return __builtin_amdgcn_rcpf(1.0f + __builtin_amdgcn_exp2f(-1.4426950408889634f * x)); }
__device__ __forceinline__ float bflo(unsigned w) { return __uint_as_float(w << 16); }
__device__ __forceinline__ float bfhi(unsigned w) { return __uint_as_float(w & 0xffff0000u); }
__device__ __forceinline__ u32x2 pack4(f32x4 v) { u32x2 w; w.x = cvt_pk_bf16(v[0], v[1]); w.y = cvt_pk_bf16(v[2], v[3]); return w; }

constexpr float QSCALE = 0.125f * 1.4426950408889634f;

struct EpiIn {
    static constexpr bool PERM = false, AFTER_DRAIN = false;
    bf16_t *U, *Q, *Kb, *VTl, *VTc, *GS, *GN; const float* rope;
    __device__ __forceinline__ void operator()(const f32x4 (&acc)[2][2][4][2], const Unit& u, int wr, int wc, int fr, int fq) const {
        const int pn = u.pn; const bool lat = u.pm < 32;
        const int row0 = u.pm * BM + wr * 64 + fr;
        if (pn < 4 || pn >= 16) {
            bf16_t* base; int ld, colt; bool sg;
            if (pn < 4) { base = U; ld = 1024; colt = pn * 256; sg = false; }
            else if (pn < 24) { base = GS; ld = 2048; colt = (pn - 16) * 256; sg = true; }
            else { base = GN; ld = 2048; colt = (pn - 24) * 256; sg = true; }
            const int col0 = colt + wc * 32 + 4 * fq;
#pragma unroll
            for (int ai = 0; ai < 2; ++ai)
#pragma unroll
                for (int m = 0; m < 4; ++m) { bf16_t* rowp = base + (size_t)(row0 + ai * HALF + m * 16) * ld + col0;
#pragma unroll
                    for (int bj = 0; bj < 2; ++bj)
#pragma unroll
                        for (int n = 0; n < 2; ++n) { f32x4 v = acc[ai][bj][m][n];
                            if (sg) { v[0] = sigm(v[0]); v[1] = sigm(v[1]); v[2] = sigm(v[2]); v[3] = sigm(v[3]); }
                            *(u32x2*)(rowp + bj * HALF + n * 16) = pack4(v); } }
        } else if (pn < 12) {
            const bool isq = pn < 8; bf16_t* base = isq ? Q : Kb; const int colt = (pn - (isq ? 4 : 8)) * 256;
            const float sc = isq ? QSCALE : 1.0f; const int col0 = colt + wc * 32 + 4 * fq; const int colsel = wc & 1;
#pragma unroll
            for (int ai = 0; ai < 2; ++ai)
#pragma unroll
                for (int m = 0; m < 4; ++m) { const int row = row0 + ai * HALF + m * 16; bf16_t* rowp = base + (size_t)row * 1024 + col0;
                    f32x4 cA = (f32x4){1.f, 0.f, 1.f, 0.f}, cB = cA;
                    if (lat) { const int t = row & 2047, pos = colsel ? (t & 63) : (t >> 6); const f32x4* rp = (const f32x4*)(rope + (pos * 16 + 4 * fq) * 2); cA = rp[0]; cB = rp[1]; }
#pragma unroll
                    for (int bj = 0; bj < 2; ++bj) { const f32x4 x1 = acc[ai][bj][m][0], x2 = acc[ai][bj][m][1]; f32x4 o1, o2;
                        o1[0] = x1[0] * cA[0] - x2[0] * cA[1]; o2[0] = x1[0] * cA[1] + x2[0] * cA[0];
                        o1[1] = x1[1] * cA[2] - x2[1] * cA[3]; o2[1] = x1[1] * cA[3] + x2[1] * cA[2];
                        o1[2] = x1[2] * cB[0] - x2[2] * cB[1]; o2[2] = x1[2] * cB[1] + x2[2] * cB[0];
                        o1[3] = x1[3] * cB[2] - x2[3] * cB[3]; o2[3] = x1[3] * cB[3] + x2[3] * cB[2];
                        o1 = o1 * sc; o2 = o2 * sc;
                        *(u32x2*)(rowp + bj * HALF) = pack4(o1); *(u32x2*)(rowp + bj * HALF + 16) = pack4(o2); } }
        } else {
            const int colt = (pn - 12) * 256;
#pragma unroll
            for (int ai = 0; ai < 2; ++ai)
#pragma unroll
                for (int m = 0; m < 4; ++m) { const int row = row0 + ai * HALF + m * 16;
                    bf16_t* bp; int tstride;
                    if (lat) { const int b = row >> 11, t = row & 2047; bp = VTl + (size_t)b * (16 * 64 * 2048) + t; tstride = 2048; }
                    else { const int rr = row - 8192, b = rr >> 8, l = rr & 255; bp = VTc + (size_t)b * (16 * 64 * 256) + l; tstride = 256; }
#pragma unroll
                    for (int bj = 0; bj < 2; ++bj)
#pragma unroll
                        for (int n = 0; n < 2; ++n) { const int c = colt + bj * HALF + wc * 32 + n * 16 + 4 * fq; const f32x4 v = acc[ai][bj][m][n];
                            const u32x2 w = pack4(v);
                            bp[(size_t)(c + 0) * tstride] = (bf16_t)(w.x & 0xffffu); bp[(size_t)(c + 1) * tstride] = (bf16_t)(w.x >> 16);
                            bp[(size_t)(c + 2) * tstride] = (bf16_t)(w.y & 0xffffu); bp[(size_t)(c + 3) * tstride] = (bf16_t)(w.y >> 16); } }
        }
    }
};
struct EpiD1 {
    static constexpr bool PERM = false, AFTER_DRAIN = false;
    const bf16_t* GS; bf16_t* T1;
    __device__ __forceinline__ void operator()(const f32x4 (&acc)[2][2][4][2], const Unit& u, int wr, int wc, int fr, int fq) const {
        const int row0 = u.pm * BM + wr * 64 + fr, L0 = u.pn * 128 + wc * 16 + 4 * fq;
#pragma unroll
        for (int ai = 0; ai < 2; ++ai)
#pragma unroll
            for (int m = 0; m < 4; ++m) { const size_t off = (size_t)(row0 + ai * HALF + m * 16) * 2048 + L0;
#pragma unroll
                for (int bj = 0; bj < 2; ++bj) { const f32x4 val = acc[ai][bj][m][0], glu = acc[ai][bj][m][1]; const u32x2 g = *(const u32x2*)(GS + off + bj * 64); f32x4 t;
                    t[0] = bflo(g.x) * val[0] * sigm(glu[0]); t[1] = bfhi(g.x) * val[1] * sigm(glu[1]); t[2] = bflo(g.y) * val[2] * sigm(glu[2]); t[3] = bfhi(g.y) * val[3] * sigm(glu[3]);
                    *(u32x2*)(T1 + off + bj * 64) = pack4(t); } }
    }
};
struct EpiD2 {
    static constexpr bool PERM = true, AFTER_DRAIN = false;
    const bf16_t* GN; bf16_t* TM;
    __device__ __forceinline__ void operator()(const f32x4 (&acc)[2][2][4][2], const Unit& u, int wr, int wc, int fr, int fq) const {
        const int row0 = u.pm * BM + wr * 64 + fr, col0 = u.pn * BM + wc * 32 + 8 * fq;
#pragma unroll
        for (int ai = 0; ai < 2; ++ai)
#pragma unroll
            for (int m = 0; m < 4; ++m) { const size_t off = (size_t)(row0 + ai * HALF + m * 16) * 2048 + col0;
#pragma unroll
                for (int bj = 0; bj < 2; ++bj) { const f32x4 v0 = acc[ai][bj][m][0], v1 = acc[ai][bj][m][1];
                    const u32x4 t = *(const u32x4*)(TM + off + bj * HALF), g = *(const u32x4*)(GN + off + bj * HALF); u32x4 w;
                    w.x = cvt_pk_bf16(bflo(t.x) + bflo(g.x) * v0[0], bfhi(t.x) + bfhi(g.x) * v0[1]); w.y = cvt_pk_bf16(bflo(t.y) + bflo(g.y) * v0[2], bfhi(t.y) + bfhi(g.y) * v0[3]);
                    w.z = cvt_pk_bf16(bflo(t.z) + bflo(g.z) * v1[0], bfhi(t.z) + bfhi(g.z) * v1[1]); w.w = cvt_pk_bf16(bflo(t.w) + bflo(g.w) * v1[2], bfhi(t.w) + bfhi(g.w) * v1[3]);
                    *(u32x4*)(TM + off + bj * HALF) = w; } }
    }
};
struct EpiF32 {
    static constexpr bool PERM = false, AFTER_DRAIN = false;
    float* O; int ldc;
    __device__ __forceinline__ void operator()(const f32x4 (&acc)[2][2][4][2], const Unit& u, int wr, int wc, int fr, int fq) const {
        const int row0 = u.pm * BM + wr * 64 + fr, col0 = u.pn * BM + wc * 32 + 4 * fq;
#pragma unroll
        for (int ai = 0; ai < 2; ++ai)
#pragma unroll
            for (int m = 0; m < 4; ++m) { float* rowp = O + (size_t)(row0 + ai * HALF + m * 16) * ldc + col0;
#pragma unroll
                for (int bj = 0; bj < 2; ++bj)
#pragma unroll
                    for (int n = 0; n < 2; ++n) *(f32x4*)(rowp + bj * HALF + n * 16) = acc[ai][bj][m][n]; }
    }
};
struct EpiF32S {
    static constexpr bool PERM = true, AFTER_DRAIN = false;
    bf16_t* O; bf16_t* SL;
    __device__ __forceinline__ void operator()(const f32x4 (&acc)[2][2][4][2], const Unit& u, int wr, int wc, int fr, int fq) const {
        const int row0 = u.pm * BM + wr * 64 + fr, col0 = u.pn * BM + wc * 32 + 8 * fq;
        if (u.pm < 32) {
#pragma unroll
            for (int ai = 0; ai < 2; ++ai)
#pragma unroll
                for (int m = 0; m < 4; ++m) { bf16_t* rowp = O + (size_t)(row0 + ai * HALF + m * 16) * 2048 + col0;
#pragma unroll
                    for (int bj = 0; bj < 2; ++bj) { const f32x4 v0 = acc[ai][bj][m][0], v1 = acc[ai][bj][m][1];
                        u32x4 w; w.x = cvt_pk_bf16(v0[0], v0[1]); w.y = cvt_pk_bf16(v0[2], v0[3]); w.z = cvt_pk_bf16(v1[0], v1[1]); w.w = cvt_pk_bf16(v1[2], v1[3]);
                        *(u32x4*)(rowp + bj * HALF) = w; } }
        } else {
            bf16_t* base = SL + ((size_t)u.ks * 1024 + (row0 - 8192)) * 2048;
#pragma unroll
            for (int ai = 0; ai < 2; ++ai)
#pragma unroll
                for (int m = 0; m < 4; ++m) { bf16_t* rowp = base + (size_t)(ai * HALF + m * 16) * 2048 + col0;
#pragma unroll
                    for (int bj = 0; bj < 2; ++bj) { const f32x4 v0 = acc[ai][bj][m][0], v1 = acc[ai][bj][m][1];
                        u32x4 w; w.x = cvt_pk_bf16(v0[0], v0[1]); w.y = cvt_pk_bf16(v0[2], v0[3]); w.z = cvt_pk_bf16(v1[0], v1[1]); w.w = cvt_pk_bf16(v1[2], v1[3]);
                        *(u32x4*)(rowp + bj * HALF) = w; } }
        }
    }
};
struct OrderSplitCtx : StaticOrder {
    int ksl, nctx;
    __device__ __forceinline__ bool next(int i, Unit& u, int ntdef) const {
        if (StaticOrder::next(i, u, ntdef)) return true;
        const long L = (long)i * G + c - nwg; if (L >= nctx) return false;
        const int unit = (int)L >> 3; u.pm = 32 + (unit & 3); u.pn = unit >> 2; u.ks = (int)L & 7; u.nt = ksl; return true;
    }
};
struct EpiRelu2 {
    static constexpr bool PERM = true, AFTER_DRAIN = false;
    bf16_t* O; int ldc;
    __device__ __forceinline__ void operator()(const f32x4 (&acc)[2][2][4][2], const Unit& u, int wr, int wc, int fr, int fq) const {
        const int row0 = u.pm * BM + wr * 64 + fr, col0 = u.pn * BM + wc * 32 + 8 * fq;
#pragma unroll
        for (int ai = 0; ai < 2; ++ai)
#pragma unroll
            for (int m = 0; m < 4; ++m) { bf16_t* rowp = O + (size_t)(row0 + ai * HALF + m * 16) * ldc + col0;
#pragma unroll
                for (int bj = 0; bj < 2; ++bj) { f32x4 v0 = acc[ai][bj][m][0], v1 = acc[ai][bj][m][1];
                    v0 = __builtin_elementwise_max(v0, (f32x4){0.f, 0.f, 0.f, 0.f}); v1 = __builtin_elementwise_max(v1, (f32x4){0.f, 0.f, 0.f, 0.f}); v0 = v0 * v0; v1 = v1 * v1;
                    u32x4 w; w.x = cvt_pk_bf16(v0[0], v0[1]); w.y = cvt_pk_bf16(v0[2], v0[3]); w.z = cvt_pk_bf16(v1[0], v1[1]); w.w = cvt_pk_bf16(v1[2], v1[3]);
                    *(u32x4*)(rowp + bj * HALF) = w; } }
    }
};
struct OrderL1In : StaticOrder {
    __device__ __forceinline__ bool next(int i, Unit& u, int ntdef) const {
        if (StaticOrder::next(i, u, ntdef)) return true;
        const long L = (long)i * G + c - nwg; if (L >= 48) return false;
        const int k = (int)L >> 2; u.pm = 32 + ((int)L & 3); u.pn = k < 4 ? k : k + 4; return true;
    }
};

template <class Epi, class Sched, bool ALIGN_EPI = false, bool SP2 = false>
__device__ __forceinline__ void gemm_phase(PG8_LAS unsigned char* lds, const Gemm g, const Sched& S, const Epi& E) {
    int tid_o = threadIdx.x; asm volatile("" : "+v"(tid_o));
    const int tid = tid_o, wid = __builtin_amdgcn_readfirstlane(tid >> 6), lane = tid & 63, wr = wid >> 2, wc = wid & 3, fr = lane & 15, fq = lane >> 4;
    const int K = g.K, nt = K / BK;
    unsigned voffA[2], voffB[2];
#pragma unroll
    for (int i = 0; i < 2; ++i) { int R, C; stage_rc(tid * 16 + i * 8192, R, C); const int Rb = Epi::PERM ? ((R & ~31) + perm32(R & 31)) : R;
        voffA[i] = (unsigned)(R * K + C) * 2u; voffB[i] = (unsigned)(Rb * K + C) * 2u; }
    const size_t kstep = (size_t)(BK * 2);
    const size_t hstep = (size_t)HALF * K * 2;
    const size_t tstep = 2 * hstep;
    const unsigned ldsw = (unsigned)wid * 1024u;
    const int aoff = lds_byte(wr * 64 + fr, fq * 8), boff = lds_byte(wc * 32 + fr, fq * 8);
#define PG8_SA(b, h) (((b) * 2 + (h)) * HTB)
#define PG8_SB(b, h) ((4 + (b) * 2 + (h)) * HTB)
#define PG8_STAGE(bufoff, gbase, voff) do { _Pragma("unroll") for (int _i = 0; _i < 2; ++_i) \
        __builtin_amdgcn_global_load_lds((const unsigned*)((const char*)(gbase) + (voff)[_i]), (PG8_LAS unsigned*)(lds + (bufoff) + ldsw + _i * 8192), 16, 0, 0); } while (0)
#define PG8_LDA(dst, b, h) do { _Pragma("unroll") for (int m = 0; m < 4; ++m) _Pragma("unroll") for (int k = 0; k < 2; ++k) dst[m][k] = *(const PG8_LAS bf16x8*)(lds + PG8_SA(b, h) + aoff + m * 2048 + k * 1024); } while (0)
#define PG8_LDB(dst, b, h) do { _Pragma("unroll") for (int n = 0; n < 2; ++n) _Pragma("unroll") for (int k = 0; k < 2; ++k) dst[n][k] = *(const PG8_LAS bf16x8*)(lds + PG8_SB(b, h) + boff + n * 2048 + k * 1024); } while (0)
#define PG8_MMA(ai, bj, At, Bt) do { __builtin_amdgcn_s_setprio(1); _Pragma("unroll") for (int m = 0; m < 4; ++m) _Pragma("unroll") for (int n = 0; n < 2; ++n) _Pragma("unroll") for (int k = 0; k < 2; ++k) \
        acc[ai][bj][m][n] = __builtin_amdgcn_mfma_f32_16x16x32_bf16(Bt[n][k], At[m][k], acc[ai][bj][m][n], 0, 0, 0); __builtin_amdgcn_s_setprio(0); } while (0)
#define PG8_WAIT_V(n) asm volatile("s_waitcnt vmcnt(" #n ")" ::: "memory")
#define PG8_WAIT_L(n) asm volatile("s_waitcnt lgkmcnt(" #n ")" ::: "memory")
#define PG8_BAR __builtin_amdgcn_s_barrier()
#define PG8_SCHED __builtin_amdgcn_sched_barrier(0)
    Unit cur, nxt; int ui = 0;
    if (!S.next(0, cur, nt)) return;
    f32x4 acc[2][2][4][2];
#pragma unroll
    for (int a = 0; a < 2; ++a)
#pragma unroll
        for (int b = 0; b < 2; ++b)
#pragma unroll
            for (int m = 0; m < 4; ++m)
#pragma unroll
                for (int n = 0; n < 2; ++n) acc[a][b][m][n] = (f32x4){0.f, 0.f, 0.f, 0.f};
    bf16x8 At[4][2], B0[2][2], B1[2][2];
    const char* cA = (const char*)g.A + (size_t)cur.pm * tstep + (size_t)(cur.ks * cur.nt) * (BK * 2); const char* cB = (const char*)g.Bt + (size_t)cur.pn * tstep + (size_t)(cur.ks * cur.nt) * (BK * 2);
    S.a_ready(cur);
    if constexpr (SP2) {
        PG8_STAGE(PG8_SB(0, 0), cB, voffB); PG8_STAGE(PG8_SB(0, 1), cB + hstep, voffB); PG8_STAGE(PG8_SA(0, 0), cA, voffA); PG8_STAGE(PG8_SA(0, 1), cA + hstep, voffA);
        if (wr == 1) PG8_BAR;
        PG8_WAIT_V(2); PG8_BAR;
        PG8_STAGE(PG8_SB(1, 0), cB + kstep, voffB); PG8_STAGE(PG8_SA(1, 0), cA + kstep, voffA); PG8_STAGE(PG8_SB(1, 1), cB + hstep + kstep, voffB);
        PG8_WAIT_V(6); PG8_BAR;
    } else {
        PG8_STAGE(PG8_SB(0, 0), cB, voffB); PG8_STAGE(PG8_SA(0, 0), cA, voffA); PG8_STAGE(PG8_SB(0, 1), cB + hstep, voffB); PG8_STAGE(PG8_SA(0, 1), cA + hstep, voffA);
        if (wr == 1) PG8_BAR;
        PG8_WAIT_V(4); PG8_BAR;
        PG8_STAGE(PG8_SB(1, 0), cB + kstep, voffB); PG8_STAGE(PG8_SA(1, 0), cA + kstep, voffA); PG8_STAGE(PG8_SB(1, 1), cB + hstep + kstep, voffB);
        PG8_WAIT_V(6); PG8_BAR;
    }
    for (;;) {
        const bool has_next = S.next(ui + 1, nxt, nt);
        const int ntu = cur.nt;
        const char* nA = has_next ? (const char*)g.A + (size_t)nxt.pm * tstep + (size_t)(nxt.ks * nxt.nt) * (BK * 2) : cA; const char* nB = has_next ? (const char*)g.Bt + (size_t)nxt.pn * tstep + (size_t)(nxt.ks * nxt.nt) * (BK * 2) : cB;
        for (int t = 0; t < ntu; t += 2) {
            const bool last = (t == ntu - 2);
            const char* a1 = cA + (size_t)(t + 1) * kstep;
            const char* a2 = last ? nA : cA + (size_t)(t + 2) * kstep; const char* b2 = last ? nB : cB + (size_t)(t + 2) * kstep;
            const char* a3 = a2 + kstep; const char* b3 = b2 + kstep;
            if (last && has_next) S.a_ready(nxt);
            if constexpr (SP2) {
            PG8_LDB(B0, 0, 0); PG8_LDB(B1, 0, 1); PG8_SCHED; PG8_LDA(At, 0, 0); PG8_STAGE(PG8_SA(1, 1), a1 + hstep, voffA);
            PG8_WAIT_V(8); PG8_WAIT_L(0); PG8_BAR; PG8_MMA(0, 0, At, B0); PG8_MMA(0, 1, At, B1); PG8_BAR; PG8_SCHED;
            PG8_LDA(At, 0, 1); PG8_STAGE(PG8_SB(0, 0), b2, voffB); PG8_STAGE(PG8_SB(0, 1), b2 + hstep, voffB); PG8_STAGE(PG8_SA(0, 0), a2, voffA);
            PG8_WAIT_V(8); PG8_WAIT_L(0); PG8_BAR; PG8_MMA(1, 0, At, B0); PG8_MMA(1, 1, At, B1); PG8_BAR; PG8_SCHED;
            PG8_LDB(B0, 1, 0); PG8_LDB(B1, 1, 1); PG8_SCHED; PG8_LDA(At, 1, 0); PG8_STAGE(PG8_SA(0, 1), a2 + hstep, voffA);
            PG8_WAIT_V(8); PG8_WAIT_L(0); PG8_BAR; PG8_MMA(0, 0, At, B0); PG8_MMA(0, 1, At, B1); PG8_BAR; PG8_SCHED;
            PG8_LDA(At, 1, 1); PG8_STAGE(PG8_SB(1, 0), b3, voffB); PG8_STAGE(PG8_SB(1, 1), b3 + hstep, voffB); PG8_STAGE(PG8_SA(1, 0), a3, voffA);
            PG8_WAIT_V(8); PG8_WAIT_L(0); PG8_BAR; PG8_MMA(1, 0, At, B0); PG8_MMA(1, 1, At, B1); PG8_BAR; PG8_SCHED;
            } else {
            PG8_LDB(B0, 0, 0); PG8_SCHED; PG8_LDA(At, 0, 0); PG8_STAGE(PG8_SA(1, 1), a1 + hstep, voffA);
            PG8_WAIT_L(8); PG8_BAR; PG8_WAIT_L(0); PG8_MMA(0, 0, At, B0); PG8_BAR; PG8_SCHED;
            PG8_LDB(B1, 0, 1); PG8_STAGE(PG8_SB(0, 0), b2, voffB);
            PG8_BAR; PG8_WAIT_L(0); PG8_MMA(0, 1, At, B1); PG8_BAR;
            PG8_LDA(At, 0, 1); PG8_STAGE(PG8_SA(0, 0), a2, voffA);
            PG8_BAR; PG8_WAIT_L(0); PG8_MMA(1, 0, At, B0); PG8_BAR; PG8_SCHED;
            PG8_STAGE(PG8_SB(0, 1), b2 + hstep, voffB);
            PG8_WAIT_V(6); PG8_BAR; PG8_MMA(1, 1, At, B1); PG8_BAR;
            PG8_LDB(B0, 1, 0); PG8_SCHED; PG8_LDA(At, 1, 0); PG8_STAGE(PG8_SA(0, 1), a2 + hstep, voffA);
            PG8_WAIT_L(8); PG8_BAR; PG8_WAIT_L(0); PG8_MMA(0, 0, At, B0); PG8_BAR; PG8_SCHED;
            PG8_LDB(B1, 1, 1); PG8_STAGE(PG8_SB(1, 0), b3, voffB);
            PG8_BAR; PG8_WAIT_L(0); PG8_MMA(0, 1, At, B1); PG8_BAR;
            PG8_LDA(At, 1, 1); PG8_STAGE(PG8_SA(1, 0), a3, voffA);
            PG8_BAR; PG8_WAIT_L(0); PG8_MMA(1, 0, At, B0); PG8_BAR; PG8_SCHED;
            PG8_STAGE(PG8_SB(1, 1), b3 + hstep, voffB);
            PG8_WAIT_V(6); PG8_BAR; PG8_MMA(1, 1, At, B1); PG8_BAR;
            }
        }
        if constexpr (ALIGN_EPI) { if (wr == 0) PG8_BAR; }
        if constexpr (!Epi::AFTER_DRAIN) { E(acc, cur, wr, wc, fr, fq); S.done(cur); }
        if (!has_next) break;
#pragma unroll
        for (int a = 0; a < 2; ++a)
#pragma unroll
            for (int b = 0; b < 2; ++b)
#pragma unroll
                for (int m = 0; m < 4; ++m)
#pragma unroll
                    for (int n = 0; n < 2; ++n) acc[a][b][m][n] = (f32x4){0.f, 0.f, 0.f, 0.f};
        cur = nxt; cA = nA; cB = nB; ++ui;
        if constexpr (ALIGN_EPI) { if (wr == 1) PG8_BAR; }
    }
    PG8_WAIT_V(0);
    if constexpr (!ALIGN_EPI) { if (wr == 0) PG8_BAR; }
    PG8_BAR;
    if constexpr (Epi::AFTER_DRAIN) { E.fused(acc, cur, wr, wc, fr, fq, lds, wid, lane); S.done(cur); }
#undef PG8_SA
#undef PG8_SB
#undef PG8_STAGE
#undef PG8_LDA
#undef PG8_LDB
#undef PG8_MMA
#undef PG8_WAIT_V
#undef PG8_WAIT_L
#undef PG8_BAR
#undef PG8_SCHED
}
}

constexpr int NWAVES = 8;
constexpr int DM = 2048, NB = 4, SEQ = 2048, CTX = 256, DEPTH = 2, NHEAD = 16, HD = 64, GRIDW = 64, NMOD = 6;
constexpr int RL = NB * SEQ, RC = NB * CTX, RT = RL + RC;
constexpr int SSMW = 1024, NAW = 1024, PW = 8192, DFF = 8192, SG = 64, SP = 64, SC = 16;
constexpr float NORM_EPS = 1e-6f;
constexpr float LOG2E = 1.4426950408889634f;

constexpr size_t MiB = 1u << 20;
constexpr size_t WS_CTL = 0, CTL_ZERO_BYTES = 1 * MiB;
constexpr size_t WS_MOD = 1 * MiB;
constexpr size_t WS_ROPE = 1 * MiB + 512 * 1024;
constexpr size_t WS_W = 2 * MiB, W_LAYER = 116 * MiB;
constexpr size_t WO_IN = 0, WO_VG = 32 * MiB, WO_NA = 40 * MiB, WO_OUT = 44 * MiB, WO_FC1 = 52 * MiB, WO_FC2 = 84 * MiB;
constexpr size_t WS_XA = 234 * MiB;
constexpr size_t WS_H = 306 * MiB;
constexpr size_t WS_PROJ = 342 * MiB;
constexpr size_t PO_U = 0, PO_Q = 18 * MiB, PO_K = 36 * MiB, PO_VTL = 54 * MiB, PO_VTC = 70 * MiB, PO_GS = 72 * MiB, PO_GN = 108 * MiB;
constexpr size_t WS_ACT = 486 * MiB;
constexpr size_t WS_ATT = 504 * MiB;
constexpr size_t WS_TM = 522 * MiB;
constexpr size_t WS_OUT = 558 * MiB;
constexpr size_t WS_SLAB = 630 * MiB;
constexpr size_t WS_END = 694 * MiB;
constexpr int CW_BAR = 4096;

constexpr int RING_BYTES = 131072, MISC_OFF = RING_BYTES + 320, LDS_BYTES = 147456;
constexpr int SCAN_LDS = 17408;
#define GAS __attribute__((address_space(1)))
#define LAS __attribute__((address_space(3)))
typedef unsigned short bf16;
typedef unsigned v4u __attribute__((ext_vector_type(4)));
typedef unsigned v2u __attribute__((ext_vector_type(2)));
typedef float f32x4 __attribute__((ext_vector_type(4)));
typedef float f32x16 __attribute__((ext_vector_type(16)));
typedef short bf16x8 __attribute__((ext_vector_type(8)));
typedef GAS unsigned gu32;
#define RLX_AGENT __ATOMIC_RELAXED, __HIP_MEMORY_SCOPE_AGENT
#define LDS_WAIT() asm volatile("s_waitcnt lgkmcnt(0)" ::: "memory")
#define VM_WAIT() asm volatile("s_waitcnt vmcnt(0)" ::: "memory")
__device__ __forceinline__ unsigned f2bf(float f) { unsigned u = __builtin_bit_cast(unsigned, f); return (u + 0x7fffu + ((u >> 16) & 1u)) >> 16; }
__device__ __forceinline__ unsigned pk2(float lo, float hi) { return f2bf(lo) | (f2bf(hi) << 16); }
__device__ __forceinline__ float bf2f(bf16 v) { return __uint_as_float((unsigned)v << 16); }
__device__ __forceinline__ float wave_sum(float v) {
#pragma unroll
    for (int o = 1; o < 64; o <<= 1) v += __shfl_xor(v, o);
    return v;
}
#define XB_TMO      128
#define XB_XCNT(j)  (256  + 64 * (j))
#define XB_XSUB(j)  (1280 + 64 * (j))
#define XB_XGEN(j)  (2304 + 64 * (j))
#define XB_TOP      3328
#define XB_TOPGEN   3392
#define XCD_BAR_WORDS 3456
#define XB_SPIN_CAP (1u << 18)

__device__ __forceinline__ unsigned xb_ld(unsigned* p)              { return __hip_atomic_load(p, __ATOMIC_RELAXED, __HIP_MEMORY_SCOPE_AGENT); }
__device__ __forceinline__ unsigned xb_add(unsigned* p, unsigned v) { return __hip_atomic_fetch_add(p, v, __ATOMIC_RELAXED, __HIP_MEMORY_SCOPE_AGENT); }
__device__ __forceinline__ unsigned xb_xcc_id() { return (unsigned)__builtin_amdgcn_s_getreg((3 << 11) | 20) & 0xFu; }
#define XB_SPIN(cond, bar) do { unsigned _sp = 0; while (cond) { __builtin_amdgcn_s_sleep(1); \
    if ((++_sp & 255u) == 0u) { if (xb_ld(&(bar)[XB_TMO])) break; if (_sp > XB_SPIN_CAP) { atomicAdd(&(bar)[XB_TMO], 1u); break; } } } } while (0)

struct XcdBarrier {
    unsigned* bar; unsigned x;
    volatile LAS unsigned* st;
};

__device__ __forceinline__ XcdBarrier xcd_barrier_post(unsigned* bar, volatile LAS unsigned* st) {
    XcdBarrier b; b.bar = bar; b.x = xb_xcc_id(); b.st = st;
    if (threadIdx.x == 0) (void)xb_add(&bar[XB_XCNT(b.x)], 1u);
    return b;
}
__device__ __forceinline__ void xcd_barrier_complete(unsigned* bar, unsigned x, unsigned& nloc, unsigned& nx) {
    const unsigned G = gridDim.x * gridDim.y * gridDim.z;
    unsigned sum, cnt, mine, sp = 0u;
    for (;;) {
        sum = 0u; cnt = 0u; mine = 0u;
#pragma unroll
        for (unsigned j = 0; j < 16; ++j) { const unsigned c = xb_ld(&bar[XB_XCNT(j)]); sum += c; cnt += (c > 0u) ? 1u : 0u; mine = (j == x) ? c : mine; }
        if (sum == G) break;
        __builtin_amdgcn_s_sleep(1);
        if ((++sp & 255u) == 0u) { if (xb_ld(&bar[XB_TMO])) break; if (sp > XB_SPIN_CAP) { atomicAdd(&bar[XB_TMO], 1u); break; } }
    }
    nloc = mine > 0u ? mine : 1u; nx = cnt > 0u ? cnt : 1u;
}

__device__ __forceinline__ void xcd_barrier(const XcdBarrier& b) {
    asm volatile("s_waitcnt vmcnt(0)" ::: "memory");
    __syncthreads();
    if (threadIdx.x == 0) {
        unsigned* bar = b.bar;
        __builtin_amdgcn_s_waitcnt(0);
        unsigned nloc = b.st[0], nx = b.st[1];
        if (nloc == 0u) { xcd_barrier_complete(bar, b.x, nloc, nx); b.st[0] = nloc; b.st[1] = nx; }
        const unsigned old = xb_add(&bar[XB_XSUB(b.x)], 1u);
        const unsigned gen = old / nloc;
        if (old + 1u == (gen + 1u) * nloc) {
            __builtin_amdgcn_fence(__ATOMIC_RELEASE, "agent");
            asm volatile("s_waitcnt vmcnt(0)" ::: "memory");
            const unsigned og = xb_add(&bar[XB_TOP], 1u);
            const unsigned tg = og / nx;
            if (og + 1u == (tg + 1u) * nx) xb_add(&bar[XB_TOPGEN], 1u);
            else XB_SPIN(xb_ld(&bar[XB_TOPGEN]) == tg, bar);
            __builtin_amdgcn_fence(__ATOMIC_ACQUIRE, "agent");
            xb_add(&bar[XB_XGEN(b.x)], 1u);
            asm volatile("s_waitcnt vmcnt(0)" ::: "memory");
        } else {
            XB_SPIN(xb_ld(&bar[XB_XGEN(b.x)]) == gen, bar);
            __builtin_amdgcn_fence(__ATOMIC_ACQUIRE, "agent");
            asm volatile("s_waitcnt vmcnt(0)" ::: "memory");
        }
    }
    __syncthreads();
}

__device__ __forceinline__ void p0_transpose_item(const float* W, int K, int N, bf16* WT, int mode, LAS float* scr, int item, int lane) {
    const int nblk = N / 32, kb = item / nblk, nb = item % nblk, k0 = 64 * kb, n0 = 32 * nb;
    float wv[32];
    const float* wp = W + (size_t)(k0 + (lane >> 5)) * N + n0 + (lane & 31);
#pragma unroll
    for (int i = 0; i < 32; ++i) wv[i] = __builtin_nontemporal_load(wp + (size_t)(2 * i) * N);
#pragma unroll
    for (int i = 0; i < 32; ++i) scr[(2 * i + (lane >> 5)) * 33 + (lane & 31)] = wv[i];
    LDS_WAIT(); asm volatile("" ::: "memory");
    const int c = lane & 7;
#pragma unroll
    for (int j = 0; j < 4; ++j) { const int n = (lane >> 3) + 8 * j; const LAS float* s = scr + (8 * c) * 33 + n;
        v4u o; o.x = pk2(s[0 * 33], s[1 * 33]); o.y = pk2(s[2 * 33], s[3 * 33]); o.z = pk2(s[4 * 33], s[5 * 33]); o.w = pk2(s[6 * 33], s[7 * 33]);
        const int ng = n0 + n; const int drow = mode == 0 ? ng : (32 * (ng >> 4) + (ng & 15) + (mode == 2 ? 16 : 0));
        __builtin_nontemporal_store(o, (GAS v4u*)(WT + (size_t)drow * K + k0 + 8 * c)); }
    LDS_WAIT(); asm volatile("" ::: "memory");
}

template <bool HASY, int XOUT, bool HOUT>
__device__ __forceinline__ void rowpass_pipe(int lane, int first, int step, int M, const void* xin, bool xbf, const bf16* yin, void* xout, bf16* hout,
                                             const float* modg, const float* modh, int kss, int ksh, int mr_fixed) {
    int m = first; if (m >= M) return;
    f32x4 xr_[8]; v2u yc[8];
#pragma unroll
    for (int j = 0; j < 8; ++j) { xr_[j] = (f32x4){0.f, 0.f, 0.f, 0.f}; yc[j] = (v2u){0u, 0u}; }
    if (xbf) { const GAS v2u* xb = (const GAS v2u*)((const bf16*)xin + (size_t)m * DM) + lane;
#pragma unroll
        for (int j = 0; j < 8; ++j) { const v2u t = __builtin_nontemporal_load(xb + 64 * j); xr_[j].x = __uint_as_float(t.x); xr_[j].y = __uint_as_float(t.y); } }
    else { const GAS f32x4* xr = (const GAS f32x4*)((const float*)xin + (size_t)m * DM) + lane;
#pragma unroll
        for (int j = 0; j < 8; ++j) xr_[j] = __builtin_nontemporal_load(xr + 64 * j); }
    if (HASY) { const GAS v2u* yb = (const GAS v2u*)(yin + (size_t)m * DM) + lane;
#pragma unroll
        for (int j = 0; j < 8; ++j) yc[j] = __builtin_nontemporal_load(yb + 64 * j); }
    for (;;) {
        const int mn = m + step; const bool hn = mn < M;
        const int mr = mr_fixed >= 0 ? mr_fixed : (m >> 11);
        f32x4 gg[8], sv[8], hv[8];
        if (HASY) { const GAS f32x4* p = (const GAS f32x4*)(modg + (size_t)mr * (NMOD * DM)) + lane;
#pragma unroll
            for (int j = 0; j < 8; ++j) gg[j] = p[64 * j]; }
        f32x4 xn[8]; v2u yn[8];
#pragma unroll
        for (int j = 0; j < 8; ++j) { xn[j] = xr_[j]; yn[j] = yc[j]; }
        if (hn) {
            if (xbf) { const GAS v2u* xb = (const GAS v2u*)((const bf16*)xin + (size_t)mn * DM) + lane;
#pragma unroll
                for (int j = 0; j < 8; ++j) { const v2u t = __builtin_nontemporal_load(xb + 64 * j); xn[j].x = __uint_as_float(t.x); xn[j].y = __uint_as_float(t.y); } }
            else { const GAS f32x4* xr = (const GAS f32x4*)((const float*)xin + (size_t)mn * DM) + lane;
#pragma unroll
                for (int j = 0; j < 8; ++j) xn[j] = __builtin_nontemporal_load(xr + 64 * j); }
            if (HASY) { const GAS v2u* yb = (const GAS v2u*)(yin + (size_t)mn * DM) + lane;
#pragma unroll
                for (int j = 0; j < 8; ++j) yn[j] = __builtin_nontemporal_load(yb + 64 * j); } }
        f32x4 xc[8];
#pragma unroll
        for (int j = 0; j < 8; ++j) { const unsigned w0 = __float_as_uint(xr_[j].x), w1 = __float_as_uint(xr_[j].y);
            xc[j] = xbf ? (f32x4){pg8::bflo(w0), pg8::bfhi(w0), pg8::bflo(w1), pg8::bfhi(w1)} : xr_[j]; }
        if (HASY) { f32x4 yv[8]; float ss = 0.f;
#pragma unroll
            for (int j = 0; j < 8; ++j) { yv[j] = (f32x4){pg8::bflo(yc[j].x), pg8::bfhi(yc[j].x), pg8::bflo(yc[j].y), pg8::bfhi(yc[j].y)};
                ss += (yv[j].x * yv[j].x + yv[j].y * yv[j].y) + (yv[j].z * yv[j].z + yv[j].w * yv[j].w); }
            const float r = 1.0f / sqrtf(wave_sum(ss) * (1.0f / DM) + NORM_EPS);
#pragma unroll
            for (int j = 0; j < 8; ++j) xc[j] = xc[j] + gg[j] * (yv[j] * r); }
        if (XOUT == 1) { GAS f32x4* xo = (GAS f32x4*)((float*)xout + (size_t)m * DM) + lane;
#pragma unroll
            for (int j = 0; j < 8; ++j) __builtin_nontemporal_store(xc[j], xo + 64 * j); }
        if (XOUT == 2) { GAS v2u* xo = (GAS v2u*)((bf16*)xout + (size_t)m * DM) + lane;
#pragma unroll
            for (int j = 0; j < 8; ++j) { v2u w; w.x = pg8::cvt_pk_bf16(xc[j].x, xc[j].y); w.y = pg8::cvt_pk_bf16(xc[j].z, xc[j].w); __builtin_nontemporal_store(w, xo + 64 * j); } }
        if (HOUT) { float ss = 0.f;
            if (HASY) __builtin_amdgcn_sched_barrier(0);
            { const GAS f32x4* p = (const GAS f32x4*)(modh + (size_t)mr * (NMOD * DM) + kss * DM) + lane; const GAS f32x4* q = (const GAS f32x4*)(modh + (size_t)mr * (NMOD * DM) + ksh * DM) + lane;
#pragma unroll
              for (int j = 0; j < 8; ++j) { sv[j] = p[64 * j]; hv[j] = q[64 * j]; } }
#pragma unroll
            for (int j = 0; j < 8; ++j) ss += (xc[j].x * xc[j].x + xc[j].y * xc[j].y) + (xc[j].z * xc[j].z + xc[j].w * xc[j].w);
            const float r = 1.0f / sqrtf(wave_sum(ss) * (1.0f / DM) + NORM_EPS);
            GAS v2u* ho = (GAS v2u*)(hout + (size_t)m * DM) + lane;
#pragma unroll
            for (int j = 0; j < 8; ++j) { const f32x4 h = (xc[j] * r) * sv[j] + hv[j];
                v2u w; w.x = pg8::cvt_pk_bf16(h.x, h.y); w.y = pg8::cvt_pk_bf16(h.z, h.w); __builtin_nontemporal_store(w, ho + 64 * j); } }
        if (!hn) break;
#pragma unroll
        for (int j = 0; j < 8; ++j) { xr_[j] = xn[j]; yc[j] = yn[j]; }
        m = mn;
    }
}
__device__ __forceinline__ void rowpass_ctx8(LAS float* red, int lane, int wave, int vcu, int G, const void* xin, bool xbf, const bf16* slab, bf16* xout, bf16* hout,
                                             const float* gg, const float* sv, const float* hv) {
    for (int base = vcu * 4; base < RC; base += G * 4) {
        const int row = base + (wave >> 1); const size_t off = (size_t)row * DM + (wave & 1) * 1024; const int co = (wave & 1) * 1024;
        f32x4 xv[4], yv[4];
        v2u yb[8][4];
#pragma unroll
        for (int sl = 0; sl < 8; ++sl) { const GAS v2u* ys = (const GAS v2u*)(slab + (size_t)sl * RC * DM + off) + lane;
#pragma unroll
            for (int j = 0; j < 4; ++j) yb[sl][j] = __builtin_nontemporal_load(ys + 64 * j); }
        if (xbf) { const GAS v2u* xb = (const GAS v2u*)((const bf16*)xin + off) + lane;
#pragma unroll
            for (int j = 0; j < 4; ++j) { const v2u t = __builtin_nontemporal_load(xb + 64 * j); xv[j] = (f32x4){pg8::bflo(t.x), pg8::bfhi(t.x), pg8::bflo(t.y), pg8::bfhi(t.y)}; } }
        else { const GAS f32x4* xr = (const GAS f32x4*)((const float*)xin + off) + lane;
#pragma unroll
            for (int j = 0; j < 4; ++j) xv[j] = __builtin_nontemporal_load(xr + 64 * j); }
#pragma unroll
        for (int j = 0; j < 4; ++j) { yv[j] = (f32x4){0.f, 0.f, 0.f, 0.f};
#pragma unroll
            for (int sl = 0; sl < 8; ++sl) yv[j] = yv[j] + (f32x4){pg8::bflo(yb[sl][j].x), pg8::bfhi(yb[sl][j].x), pg8::bflo(yb[sl][j].y), pg8::bfhi(yb[sl][j].y)}; }
        float ss = 0.f;
#pragma unroll
        for (int j = 0; j < 4; ++j) ss += (yv[j].x * yv[j].x + yv[j].y * yv[j].y) + (yv[j].z * yv[j].z + yv[j].w * yv[j].w);
        ss = wave_sum(ss); if (lane == 0) red[wave] = ss;
        LDS_WAIT(); __syncthreads();
        float r = 1.0f / sqrtf((red[wave] + red[wave ^ 1]) * (1.0f / DM) + NORM_EPS);
        const GAS f32x4* gp = (const GAS f32x4*)(gg + co) + lane;
#pragma unroll
        for (int j = 0; j < 4; ++j) xv[j] = xv[j] + gp[64 * j] * (yv[j] * r);
        GAS v2u* xo = (GAS v2u*)(xout + off) + lane;
#pragma unroll
        for (int j = 0; j < 4; ++j) { v2u w; w.x = pg8::cvt_pk_bf16(xv[j].x, xv[j].y); w.y = pg8::cvt_pk_bf16(xv[j].z, xv[j].w); __builtin_nontemporal_store(w, xo + 64 * j); }
        ss = 0.f;
#pragma unroll
        for (int j = 0; j < 4; ++j) ss += (xv[j].x * xv[j].x + xv[j].y * xv[j].y) + (xv[j].z * xv[j].z + xv[j].w * xv[j].w);
        ss = wave_sum(ss); if (lane == 0) red[8 + wave] = ss;
        LDS_WAIT(); __syncthreads();
        r = 1.0f / sqrtf((red[8 + wave] + red[8 + (wave ^ 1)]) * (1.0f / DM) + NORM_EPS);
        const GAS f32x4* sp = (const GAS f32x4*)(sv + co) + lane; const GAS f32x4* hp = (const GAS f32x4*)(hv + co) + lane; GAS v2u* ho = (GAS v2u*)(hout + off) + lane;
#pragma unroll
        for (int j = 0; j < 4; ++j) { const f32x4 h = (xv[j] * r) * sp[64 * j] + hp[64 * j];
            v2u w; w.x = pg8::cvt_pk_bf16(h.x, h.y); w.y = pg8::cvt_pk_bf16(h.z, h.w); __builtin_nontemporal_store(w, ho + 64 * j); }
        LDS_WAIT();
    }
}

#define MFMA32(a, b, c) __builtin_amdgcn_mfma_f32_32x32x16_bf16(a, b, c, 0, 0, 0)
#define MFMA16(a, b, c) __builtin_amdgcn_mfma_f32_16x16x32_bf16(a, b, c, 0, 0, 0)
struct ScanPtrs { const float *lam_re, *lam_im, *log_dt, *b_re, *b_im, *c_re, *c_im, *dsk; const bf16* U; float* YP; bf16* ACT; };

__device__ __forceinline__ void s5_disc(const float* lam_re, const float* lam_im, int ldg, int pp, float dt, float& lbr, float& lbi, float& cr, float& ci) {
    const float lr = lam_re[ldg * 64 + pp], li = lam_im[ldg * 64 + pp];
    const float a = lr * dt, th = li * dt; float sn, cs; sincosf(th, &sn, &cs);
    const float em1 = expm1f(a), mag = em1 + 1.0f; float sh_, ch_; sincosf(0.5f * th, &sh_, &ch_);
    lbr = mag * cs; lbi = mag * sn;
    const float nr = em1 * cs - 2.0f * sh_ * sh_, ni = lbi;
    const float den = 1.0f / (lr * lr + li * li);
    cr = (nr * lr + ni * li) * den; ci = (ni * lr - nr * li) * den;
}
__device__ __forceinline__ float gelu_tanh(float y) { const float z = 0.7978845608028654f * (y + 0.044715f * y * y * y); return y * pg8::sigm(2.0f * z); }

constexpr int SELF_CI = 22;
template <bool REV>
__device__ __forceinline__ void scan_chain(LAS unsigned char* sl, LAS unsigned* flags, int layer, int b, int g, const ScanPtrs P, int lane, bool ctx_out) {
    const int d = REV ? 1 : 0, ldg = (layer * 2 + d) * 64 + g, hh = lane >> 5, l31 = lane & 31;
    const float dt = expf(P.log_dt[ldg]);
    float lb0r, lb0i, c0r, c0i, lb1r, lb1i, c1r, c1i;
    s5_disc(P.lam_re, P.lam_im, ldg, l31, dt, lb0r, lb0i, c0r, c0i);
    s5_disc(P.lam_re, P.lam_im, ldg, 32 + l31, dt, lb1r, lb1i, c1r, c1i);
    const float lr = hh ? lb1r : lb0r, li = hh ? lb1i : lb0i;
    bf16x8 bfr[4];
#pragma unroll
    for (int j = 0; j < 4; ++j) { const int pp = l31 + 32 * (j & 1); const float cr = (j & 1) ? c1r : c0r, ci = (j & 1) ? c1i : c0i;
        const float* br = P.b_re + ((size_t)ldg * 64 + pp) * 16 + 8 * hh; const float* bi = P.b_im + ((size_t)ldg * 64 + pp) * 16 + 8 * hh;
        const f32x4 r0 = *(const f32x4*)br, r1 = *(const f32x4*)(br + 4), i0 = *(const f32x4*)bi, i1 = *(const f32x4*)(bi + 4);
        f32x4 v0, v1; if (j < 2) { v0 = r0 * cr - i0 * ci; v1 = r1 * cr - i1 * ci; } else { v0 = i0 * cr + r0 * ci; v1 = i1 * cr + r1 * ci; }
        v4u w; w.x = pk2(v0.x, v0.y); w.y = pk2(v0.z, v0.w); w.z = pk2(v1.x, v1.y); w.w = pk2(v1.z, v1.w); bfr[j] = __builtin_bit_cast(bf16x8, w); }
    const int cc = lane & 15, kq = lane >> 4;
    bf16x8 cfr[4];
#pragma unroll
    for (int s = 0; s < 4; ++s) { const size_t o = ((size_t)ldg * 16 + cc) * 64 + 16 * s + 4 * kq; const f32x4 re = *(const f32x4*)(P.c_re + o), im = *(const f32x4*)(P.c_im + o);
        v4u w; w.x = pk2(re.x, -im.x); w.y = pk2(re.y, -im.y); w.z = pk2(re.z, -im.z); w.w = pk2(re.w, -im.w); cfr[s] = __builtin_bit_cast(bf16x8, w); }
    LAS unsigned char* SB = sl;
    float sr = 0.f, si = 0.f; int pend0 = -1, pend1 = -1;
    auto rowbase_of = [&](int ci) -> int { if (ci < 4) { const int c4 = REV ? 3 - ci : ci; return RL + b * CTX + c4 * 64; } const int lc = ci - 4, c32 = REV ? 31 - lc : lc; return b * SEQ + c32 * 64; };
    bf16x8 ufr[2], un1[2], un2[2];
    { const int rb = rowbase_of(0), r1 = rowbase_of(1);
#pragma unroll
      for (int i = 0; i < 2; ++i) { ufr[i] = *(const bf16x8*)(P.U + (size_t)(rb + 32 * i + l31) * 1024 + g * 16 + 8 * hh); un1[i] = *(const bf16x8*)(P.U + (size_t)(r1 + 32 * i + l31) * 1024 + g * 16 + 8 * hh); } }
    un2[0] = un1[0]; un2[1] = un1[1];
    const f32x4 dk4 = *(const f32x4*)(P.dsk + layer * 1024 + g * 16 + 4 * kq);
    for (int ci = 0; ci < 36; ++ci) {
        const int rb = rowbase_of(ci);
        const int fidx = ci < 4 ? (REV ? 3 - ci : ci) : 4 + (REV ? 35 - ci : ci - 4);
        const bool selfc = ci >= SELF_CI;
        unsigned long long op[8]; v2u uu[4];
#pragma unroll
        for (int e = 0; e < 4; ++e) { op[2 * e] = 0ull; op[2 * e + 1] = 0ull; uu[e] = (v2u){0u, 0u}; }
        if (selfc) {
            while (__hip_atomic_load(flags + fidx, __ATOMIC_RELAXED, __HIP_MEMORY_SCOPE_WORKGROUP) < 1u) __builtin_amdgcn_s_sleep(2);
            asm volatile("" ::: "memory");
            const size_t eo = (size_t)(rb + cc) * 1024 + g * 16 + 4 * kq;
            const unsigned long long* opp = (const unsigned long long*)(P.YP + (size_t)(1 - d) * RT * 1024 + eo); const bf16* upp = P.U + eo;
#pragma unroll
            for (int f = 0; f < 4; ++f) { op[2 * f] = __hip_atomic_load(opp + (size_t)f * 8192, RLX_AGENT); op[2 * f + 1] = __hip_atomic_load(opp + (size_t)f * 8192 + 1, RLX_AGENT); uu[f] = *(const v2u*)(upp + (size_t)f * 16384); }
        }
        if (ci + 2 < 36) { const int rn = rowbase_of(ci + 2);
#pragma unroll
            for (int i = 0; i < 2; ++i) un2[i] = *(const bf16x8*)(P.U + (size_t)(rn + 32 * i + l31) * 1024 + g * 16 + 8 * hh); }
#pragma unroll
        for (int ib = 0; ib < 2; ++ib) { const int i = REV ? 1 - ib : ib;
            const f32x16 z = {0.f, 0.f, 0.f, 0.f, 0.f, 0.f, 0.f, 0.f, 0.f, 0.f, 0.f, 0.f, 0.f, 0.f, 0.f, 0.f};
            f32x16 x0 = MFMA32(ufr[i], bfr[0], z), x1 = MFMA32(ufr[i], bfr[1], z), x2 = MFMA32(ufr[i], bfr[2], z), x3 = MFMA32(ufr[i], bfr[3], z);
#pragma unroll
            for (int r = 0; r < 16; ++r) {
                auto pa = __builtin_amdgcn_permlane32_swap(__float_as_uint(x0[r]), __float_as_uint(x1[r]), false, false); x0[r] = __uint_as_float(pa[0]); x1[r] = __uint_as_float(pa[1]);
                auto pc = __builtin_amdgcn_permlane32_swap(__float_as_uint(x2[r]), __float_as_uint(x3[r]), false, false); x2[r] = __uint_as_float(pc[0]); x3[r] = __uint_as_float(pc[1]);
            }
#pragma unroll
            for (int k = 0; k < 32; ++k) { const int t = REV ? 31 - k : k; const int tg = (t >> 2) & 1, rg = (t & 3) + 4 * (t >> 3);
                const float xr = tg ? x1[rg] : x0[rg], xi = tg ? x3[rg] : x2[rg];
                const float nr = fmaf(-li, si, fmaf(lr, sr, xr)), ni = fmaf(li, sr, fmaf(lr, si, xi)); sr = nr; si = ni;
                *(LAS unsigned*)(SB + (32 * i + t) * 272 + lane * 4) = pg8::cvt_pk_bf16(sr, si); }
        }
        LDS_WAIT(); asm volatile("" ::: "memory");
        if (ci >= 4 || ctx_out) {
            f32x4 ya[4];
#pragma unroll
            for (int f = 0; f < 4; ++f) { f32x4 a = {0.f, 0.f, 0.f, 0.f};
#pragma unroll
                for (int s = 0; s < 4; ++s) { const bf16x8 af = *(const LAS bf16x8*)(SB + (16 * f + cc) * 272 + (32 * s + 8 * kq) * 2); a = MFMA16(cfr[s], af, a); }
                ya[f] = a; }
            if (!selfc) {
            asm volatile("s_waitcnt vmcnt(6)" ::: "memory");
            if (pend1 >= 0 && lane == 0) (void)__hip_atomic_fetch_add(flags + pend1, 1u, __ATOMIC_RELAXED, __HIP_MEMORY_SCOPE_WORKGROUP);
            pend1 = pend0; pend0 = fidx;
            float* myp = P.YP + ((size_t)d * RT + rb + cc) * 1024 + g * 16 + 4 * kq;
#pragma unroll
            for (int f = 0; f < 4; ++f) *(f32x4*)(myp + (size_t)f * 16384) = ya[f];
            } else {
                VM_WAIT();
                if (lane == 0) { if (pend1 >= 0) (void)__hip_atomic_fetch_add(flags + pend1, 1u, __ATOMIC_RELAXED, __HIP_MEMORY_SCOPE_WORKGROUP);
                                 if (pend0 >= 0) (void)__hip_atomic_fetch_add(flags + pend0, 1u, __ATOMIC_RELAXED, __HIP_MEMORY_SCOPE_WORKGROUP); }
                pend1 = -1; pend0 = -1;
                bf16* ap = P.ACT + (size_t)(rb + cc) * 1024 + g * 16 + 4 * kq;
#pragma unroll
                for (int f = 0; f < 4; ++f) {
                    const float y0 = ya[f][0] + __uint_as_float((unsigned)op[2 * f]) + dk4[0] * pg8::bflo(uu[f].x), y1 = ya[f][1] + __uint_as_float((unsigned)(op[2 * f] >> 32)) + dk4[1] * pg8::bfhi(uu[f].x);
                    const float y2 = ya[f][2] + __uint_as_float((unsigned)op[2 * f + 1]) + dk4[2] * pg8::bflo(uu[f].y), y3 = ya[f][3] + __uint_as_float((unsigned)(op[2 * f + 1] >> 32)) + dk4[3] * pg8::bfhi(uu[f].y);
                    v2u w; w.x = pg8::cvt_pk_bf16(gelu_tanh(y0), gelu_tanh(y1)); w.y = pg8::cvt_pk_bf16(gelu_tanh(y2), gelu_tanh(y3)); *(v2u*)(ap + (size_t)f * 16384) = w; }
            }
        }
        ufr[0] = un1[0]; ufr[1] = un1[1]; un1[0] = un2[0]; un1[1] = un2[1];
    }
    VM_WAIT();
    if (lane == 0) { if (pend1 >= 0) (void)__hip_atomic_fetch_add(flags + pend1, 1u, __ATOMIC_RELAXED, __HIP_MEMORY_SCOPE_WORKGROUP);
                     if (pend0 >= 0) (void)__hip_atomic_fetch_add(flags + pend0, 1u, __ATOMIC_RELAXED, __HIP_MEMORY_SCOPE_WORKGROUP); }
}


__device__ __forceinline__ void scan_combine(const ScanPtrs P, int layer, int b, int g, int fidx, int lane) {
    const int rb = fidx < 4 ? RL + b * CTX + fidx * 64 : b * SEQ + (fidx - 4) * 64;
    const size_t ro = (size_t)(rb + lane) * 1024 + g * 16;
    const unsigned long long* p0 = (const unsigned long long*)(P.YP + ro); const unsigned long long* p1 = (const unsigned long long*)(P.YP + (size_t)RT * 1024 + ro);
    unsigned long long a[8], c[8];
#pragma unroll
    for (int i = 0; i < 8; ++i) { a[i] = __hip_atomic_load(p0 + i, RLX_AGENT); c[i] = __hip_atomic_load(p1 + i, RLX_AGENT); }
    const v4u u0 = *(const v4u*)(P.U + ro), u1 = *(const v4u*)(P.U + ro + 8);
    const unsigned uw[8] = {u0.x, u0.y, u0.z, u0.w, u1.x, u1.y, u1.z, u1.w};
    const float* dk = P.dsk + layer * 1024 + g * 16;
    unsigned ow[8];
#pragma unroll
    for (int i = 0; i < 8; ++i) {
        const float y0 = __uint_as_float((unsigned)a[i]) + __uint_as_float((unsigned)c[i]) + dk[2 * i] * pg8::bflo(uw[i]);
        const float y1 = __uint_as_float((unsigned)(a[i] >> 32)) + __uint_as_float((unsigned)(c[i] >> 32)) + dk[2 * i + 1] * pg8::bfhi(uw[i]);
        ow[i] = pg8::cvt_pk_bf16(gelu_tanh(y0), gelu_tanh(y1)); }
    v4u o0 = {ow[0], ow[1], ow[2], ow[3]}, o1 = {ow[4], ow[5], ow[6], ow[7]};
    *(v4u*)(P.ACT + ro) = o0; *(v4u*)(P.ACT + ro + 8) = o1;
}
struct AttPtrs { const bf16 *Q, *K, *VTl, *VTc; bf16* O; const float* rpb; };
constexpr int ATT_KS = 144, ATT_VS = 80, ATT_TILE = 32 * ATT_KS + 64 * ATT_VS;
struct AttG { v4u k[4], v[4]; };
__device__ __forceinline__ void att_gload(AttG& G, const bf16* kblk, const bf16* vblk, int vstride, int lane) {
#pragma unroll
    for (int i = 0; i < 4; ++i) { G.k[i] = *(const v4u*)(kblk + (size_t)(8 * i + (lane >> 3)) * 1024 + (lane & 7) * 8);
                                  G.v[i] = *(const v4u*)(vblk + (size_t)(16 * i + (lane >> 2)) * vstride + (lane & 3) * 8); }
}
__device__ __forceinline__ void att_lwrite(const AttG& G, LAS unsigned char* tile, int lane) {
#pragma unroll
    for (int i = 0; i < 4; ++i) { *(LAS v4u*)(tile + (8 * i + (lane >> 3)) * ATT_KS + (lane & 7) * 16) = G.k[i];
        LAS unsigned char* vp = tile + 32 * ATT_KS + (16 * i + (lane >> 2)) * ATT_VS + 32 * ((lane & 3) >> 1) + 8 * (lane & 1); v2u lo = {G.v[i].x, G.v[i].y}, hi = {G.v[i].z, G.v[i].w}; *(LAS v2u*)vp = lo; *(LAS v2u*)(vp + 16) = hi; }
}
struct AttF { bf16x8 k[4]; v2u v[8]; };
__device__ __forceinline__ void att_fread(AttF& F, const LAS unsigned char* tile, int lane) {
    const int q = lane & 31, hh = lane >> 5;
#pragma unroll
    for (int ss = 0; ss < 4; ++ss) F.k[ss] = *(const LAS bf16x8*)(tile + q * ATT_KS + (16 * ss + 8 * hh) * 2);
#pragma unroll
    for (int f = 0; f < 2; ++f)
#pragma unroll
        for (int s2 = 0; s2 < 2; ++s2) { const v4u w = *(const LAS v4u*)(tile + 32 * ATT_KS + (32 * f + q) * ATT_VS + 32 * s2 + 16 * hh); F.v[(f * 2 + s2) * 2] = (v2u){w.x, w.y}; F.v[(f * 2 + s2) * 2 + 1] = (v2u){w.z, w.w}; }
}
__device__ __forceinline__ void att_compute(const AttF& B, const bf16x8 (&qf)[4], f32x16& o0, f32x16& o1, float& mrun, float& lrun, bool local, const unsigned (&colb)[4], unsigned rowb) {
    f32x16 s = {0.f, 0.f, 0.f, 0.f, 0.f, 0.f, 0.f, 0.f, 0.f, 0.f, 0.f, 0.f, 0.f, 0.f, 0.f, 0.f};
#pragma unroll
    for (int ss = 0; ss < 4; ++ss) s = MFMA32(B.k[ss], qf[ss], s);
    if (local) {
        float bs[16];
#pragma unroll
        for (int r = 0; r < 16; ++r) bs[r] = *(const LAS float*)(size_t)(((colb[r >> 2] >> (8 * (r & 3))) & 0xffu) + rowb);
#pragma unroll
        for (int r = 0; r < 16; ++r) s[r] += bs[r];
    }
    float bm = s[0];
#pragma unroll
    for (int r = 1; r < 16; ++r) bm = fmaxf(bm, s[r]);
    bm = fmaxf(bm, __shfl_xor(bm, 32));
    if (__any(bm > mrun)) {
        const float mn = fmaxf(mrun, bm), alpha = __builtin_amdgcn_exp2f(mrun - mn); mrun = mn;
        lrun = lrun * alpha; o0 = o0 * alpha; o1 = o1 * alpha;
    }
    float p[16]; float ps = 0.f;
#pragma unroll
    for (int r = 0; r < 16; ++r) { p[r] = __builtin_amdgcn_exp2f(s[r] - mrun); ps += p[r]; }
    lrun += ps;
#pragma unroll
    for (int s2 = 0; s2 < 2; ++s2) { v4u w; w.x = pg8::cvt_pk_bf16(p[8 * s2], p[8 * s2 + 1]); w.y = pg8::cvt_pk_bf16(p[8 * s2 + 2], p[8 * s2 + 3]);
        w.z = pg8::cvt_pk_bf16(p[8 * s2 + 4], p[8 * s2 + 5]); w.w = pg8::cvt_pk_bf16(p[8 * s2 + 6], p[8 * s2 + 7]); const bf16x8 pf = __builtin_bit_cast(bf16x8, w);
        { v4u a = {B.v[s2 * 2].x, B.v[s2 * 2].y, B.v[s2 * 2 + 1].x, B.v[s2 * 2 + 1].y}; o0 = MFMA32(__builtin_bit_cast(bf16x8, a), pf, o0); }
        { v4u a = {B.v[(2 + s2) * 2].x, B.v[(2 + s2) * 2].y, B.v[(2 + s2) * 2 + 1].x, B.v[(2 + s2) * 2 + 1].y}; o1 = MFMA32(__builtin_bit_cast(bf16x8, a), pf, o1); } }
}
__device__ __forceinline__ void att_item(int item, int layer, const AttPtrs P, LAS unsigned char* tile, LAS float* btab, int& tab_head, int lane) {
    const int q = lane & 31, hh = lane >> 5;
    const bool local = item < 4096;
    int b, h, r = 0, half = 0, qrow;
    if (local) { half = item & 1; r = (item >> 1) & 31; h = (item >> 6) & 15; b = item >> 10; qrow = b * SEQ + r * 64 + half * 32 + q; }
    else { const int it = item - 4096; const int qb = it & 7; h = (it >> 3) & 15; b = it >> 7; qrow = RL + b * CTX + qb * 32 + q; }
    if (local && tab_head != h) {
        LDS_WAIT(); asm volatile("" ::: "memory");
        const float* src = P.rpb + ((size_t)layer * NHEAD + h) * 465;
        for (int i = lane; i < 480; i += 64) { const int ro = i >> 5, j = i & 31; btab[i] = j < 31 ? src[ro * 31 + j] * LOG2E : -1e30f; }
        LDS_WAIT(); asm volatile("" ::: "memory");
        tab_head = h;
    }
    bf16x8 qf[4];
#pragma unroll
    for (int s = 0; s < 4; ++s) qf[s] = *(const bf16x8*)(P.Q + (size_t)qrow * 1024 + h * 64 + 16 * s + 8 * hh);
    f32x16 o0 = {0.f, 0.f, 0.f, 0.f, 0.f, 0.f, 0.f, 0.f, 0.f, 0.f, 0.f, 0.f, 0.f, 0.f, 0.f, 0.f}, o1 = o0; float mrun = -1e30f, lrun = 0.f;
    const bf16* vtc = P.VTc + (size_t)(b * 16 + h) * 64 * CTX;
    const bf16* kc = P.K + (size_t)(RL + b * CTX) * 1024 + h * 64;
    int r0 = r - 4; r0 = r0 < 0 ? 0 : (r0 > 24 ? 24 : r0);
    const int c = half * 32 + q; int c0 = c - 8; c0 = c0 < 0 ? 0 : (c0 > 48 ? 48 : c0);
    const bf16* vtl = P.VTl + (size_t)(b * 16 + h) * 64 * SEQ;
    const bf16* kl = P.K + (size_t)(b * SEQ) * 1024 + h * 64;
    unsigned colb0[4] = {0u, 0u, 0u, 0u}, colb1[4] = {0u, 0u, 0u, 0u}; const unsigned tb = (unsigned)(size_t)btab;
#pragma unroll
    for (int rr = 0; rr < 16; ++rr) { const int k0 = (rr & 3) + 8 * (rr >> 2) + 4 * hh, k1 = 32 + k0;
        colb0[rr >> 2] |= (4u * (unsigned)(((unsigned)(k0 - c0) < 16u) ? k0 - c + 15 : 31)) << (8 * (rr & 3)); colb1[rr >> 2] |= (4u * (unsigned)(((unsigned)(k1 - c0) < 16u) ? k1 - c + 15 : 31)) << (8 * (rr & 3)); }
    const int npair = local ? 12 : 4;
    auto gl = [&](AttG& G, int i) { if (i < 8) att_gload(G, kc + (size_t)(32 * i) * 1024, vtc + 32 * i, CTX, lane);
                                    else { const int j = i - 8, t0 = (r0 + (j >> 1)) * 64 + 32 * (j & 1); att_gload(G, kl + (size_t)t0 * 1024, vtl + t0, SEQ, lane); } };
    const int nblk = 2 * npair;
    AttG G; gl(G, 0);
    att_lwrite(G, tile, lane);
    gl(G, 1);
    for (int p = 0; p < npair; ++p) {
        const bool loc = p >= 4; const unsigned rowb = tb + (loc ? (unsigned)((r0 + (p - 4) - r + 7) * 128) : 0u);
        { AttF F; LDS_WAIT(); asm volatile("" ::: "memory"); att_fread(F, tile, lane); LDS_WAIT(); asm volatile("" ::: "memory");
          att_lwrite(G, tile, lane); gl(G, 2 * p + 2 < nblk ? 2 * p + 2 : nblk - 1);
          att_compute(F, qf, o0, o1, mrun, lrun, loc, colb0, rowb); }
        { AttF F; LDS_WAIT(); asm volatile("" ::: "memory"); att_fread(F, tile, lane); LDS_WAIT(); asm volatile("" ::: "memory");
          att_lwrite(G, tile, lane); gl(G, 2 * p + 3 < nblk ? 2 * p + 3 : nblk - 1);
          att_compute(F, qf, o0, o1, mrun, lrun, loc, colb1, rowb); }
    }
    const float inv = 1.0f / (lrun + __shfl_xor(lrun, 32));
    bf16* op = P.O + (size_t)qrow * 1024 + h * 64 + 4 * hh;
#pragma unroll
    for (int g4 = 0; g4 < 4; ++g4) {
        v2u w0, w1; w0.x = pg8::cvt_pk_bf16(o0[4 * g4] * inv, o0[4 * g4 + 1] * inv); w0.y = pg8::cvt_pk_bf16(o0[4 * g4 + 2] * inv, o0[4 * g4 + 3] * inv);
        w1.x = pg8::cvt_pk_bf16(o1[4 * g4] * inv, o1[4 * g4 + 1] * inv); w1.y = pg8::cvt_pk_bf16(o1[4 * g4 + 2] * inv, o1[4 * g4 + 3] * inv);
        *(v2u*)(op + 8 * g4) = w0; *(v2u*)(op + 32 + 8 * g4) = w1; }
}

#ifndef REPEAT_MASK
#define REPEAT_MASK 0
#endif
#ifndef PROBE_SCAN_REP
#define PROBE_SCAN_REP 1
#endif
#ifndef PROBE_ATT_REP
#define PROBE_ATT_REP 1
#endif
#ifndef PHASE_MASK
#define PHASE_MASK 2047
#endif
constexpr int NPH = 2 + 9 * DEPTH;
struct Args { const float* in[26]; float* out; unsigned char* ws; int ph_lo, ph_hi, use_bar, pad; };
typedef const __attribute__((address_space(4))) Args* KArgs;
#define KARGS(ka) KArgs ka = (KArgs)__builtin_amdgcn_kernarg_segment_ptr(); asm volatile("" : "+s"(ka))

constexpr int I_IN = (DM / 64) * (PW / 32), I_VG = (SSMW / 64) * (DM / 32), I_NA = (NAW / 64) * (DM / 32), I_OUT = (DM / 64) * (DM / 32), I_F1 = (DM / 64) * (DFF / 32), I_F2 = (DFF / 64) * (DM / 32);
constexpr int I_MIX = I_IN + 2 * I_VG + I_NA + I_OUT, I_LAYER = I_MIX + I_F1 + I_F2;
__device__ __forceinline__ void conv_item(KArgs ka, unsigned char* ws, int l, int r, LAS float* scr, int lane) {
    unsigned char* wb = ws + WS_W + (size_t)l * W_LAYER;
    const float* src; int K, N, mode; size_t wo;
    if (r < I_IN) { src = ka->in[10] + (size_t)l * DM * PW; K = DM; N = PW; mode = 0; wo = WO_IN; }
    else if ((r -= I_IN) < I_VG) { src = ka->in[19] + (size_t)l * SSMW * DM; K = SSMW; N = DM; mode = 1; wo = WO_VG; }
    else if ((r -= I_VG) < I_VG) { src = ka->in[20] + (size_t)l * SSMW * DM; K = SSMW; N = DM; mode = 2; wo = WO_VG; }
    else if ((r -= I_VG) < I_NA) { src = ka->in[22] + (size_t)l * NAW * DM; K = NAW; N = DM; mode = 0; wo = WO_NA; }
    else if ((r -= I_NA) < I_OUT) { src = ka->in[23] + (size_t)l * DM * DM; K = DM; N = DM; mode = 0; wo = WO_OUT; }
    else if ((r -= I_OUT) < I_F1) { src = ka->in[24] + (size_t)l * DM * DFF; K = DM; N = DFF; mode = 0; wo = WO_FC1; }
    else { r -= I_F1; src = ka->in[25] + (size_t)l * DFF * DM; K = DFF; N = DM; mode = 0; wo = WO_FC2; }
    p0_transpose_item(src, K, N, (bf16*)(wb + wo), mode, scr, r, lane);
}

__device__ __forceinline__ void mod_gemv_items(KArgs ka, unsigned char* ws, LAS unsigned char* lds, int tid, int lane, int wave, int it0, int it1, int step) {
        {
            const float* c_in = ka->in[1]; const float* cctx_in = ka->in[3]; const float* w_mod = ka->in[4]; const float* b_mod = ka->in[5]; float* MOD = (float*)(ws + WS_MOD);
            LAS float* SIL = (LAS float*)(lds + 71680); LAS float* PART = (LAS float*)(lds + 112640);
            for (int i = tid; i < 5 * DM; i += NWAVES * 64) { const int r = i >> 11, k = i & 2047; const float v = r < 4 ? c_in[r * DM + k] : cctx_in[k]; SIL[i] = v / (1.0f + expf(-v)); }
            __syncthreads();
            for (int it = it0; it < it1; it += step) {
                const int l = it / 192, jn = it % 192, col = jn * 64 + lane, k0 = wave * 256;
                const float* W = w_mod + (size_t)l * DM * (NMOD * DM) + (size_t)k0 * (NMOD * DM) + col;
                float a0 = 0.f, a1 = 0.f, a2 = 0.f, a3 = 0.f, a4 = 0.f;
#pragma unroll 4
                for (int kk = 0; kk < 256; kk += 4) {
                    const float w0 = __builtin_nontemporal_load(W + (size_t)(kk + 0) * (NMOD * DM)), w1 = __builtin_nontemporal_load(W + (size_t)(kk + 1) * (NMOD * DM)), w2 = __builtin_nontemporal_load(W + (size_t)(kk + 2) * (NMOD * DM)), w3 = __builtin_nontemporal_load(W + (size_t)(kk + 3) * (NMOD * DM));
                    const f32x4 s0 = *(const LAS f32x4*)(SIL + 0 * DM + k0 + kk), s1 = *(const LAS f32x4*)(SIL + 1 * DM + k0 + kk), s2 = *(const LAS f32x4*)(SIL + 2 * DM + k0 + kk),
                                s3 = *(const LAS f32x4*)(SIL + 3 * DM + k0 + kk), s4 = *(const LAS f32x4*)(SIL + 4 * DM + k0 + kk);
                    a0 += s0.x * w0 + s0.y * w1 + s0.z * w2 + s0.w * w3; a1 += s1.x * w0 + s1.y * w1 + s1.z * w2 + s1.w * w3; a2 += s2.x * w0 + s2.y * w1 + s2.z * w2 + s2.w * w3;
                    a3 += s3.x * w0 + s3.y * w1 + s3.z * w2 + s3.w * w3; a4 += s4.x * w0 + s4.y * w1 + s4.z * w2 + s4.w * w3;
                }
                PART[(wave * 5 + 0) * 64 + lane] = a0; PART[(wave * 5 + 1) * 64 + lane] = a1; PART[(wave * 5 + 2) * 64 + lane] = a2; PART[(wave * 5 + 3) * 64 + lane] = a3; PART[(wave * 5 + 4) * 64 + lane] = a4;
                __syncthreads();
                if (wave < 5) { float s = b_mod[l * (NMOD * DM) + col];
#pragma unroll
                    for (int w = 0; w < 8; ++w) s += PART[(w * 5 + wave) * 64 + lane];
                    const int kidx = jn >> 5, c = col & (DM - 1);
                    if (kidx == 1) s = ka->in[6][l * DM + c] * (1.0f + s); else if (kidx == 2) s *= ka->in[7][l * DM + c];
                    else if (kidx == 4) s = ka->in[8][l * DM + c] * (1.0f + s); else if (kidx == 5) s *= ka->in[9][l * DM + c];
                    MOD[(size_t)(l * 5 + wave) * (NMOD * DM) + col] = s; }
                __syncthreads();
            }
        }
}
#define IDLE_COPY(nun, cl, lo_, hi_) do { const int first_ = (nun) % G; if (first_ != 0 && bx >= first_) { const int nid_ = G - first_, j_ = bx - first_, per_ = ((hi_) - (lo_) + nid_ - 1) / nid_; \
        const int a_ = (lo_) + j_ * per_, b_ = (a_ + per_ < (hi_)) ? a_ + per_ : (hi_); LAS float* scr_ = (LAS float*)(lds + wave * 8704); \
        for (int it_ = a_ + wave; it_ < b_; it_ += NWAVES) conv_item(ka, ws, cl, it_, scr_, lane); } } while (0)
__global__ void __launch_bounds__(NWAVES * 64, 2) mega_fwd(Args args_unused) {
    extern __shared__ __attribute__((aligned(16))) unsigned char lds_raw[];
    LAS unsigned char* lds = (LAS unsigned char*)lds_raw;
    const int tid0 = threadIdx.x, wave = __builtin_amdgcn_readfirstlane(tid0 >> 6);
    const int G = gridDim.x, bx = blockIdx.x;
    const int vcu = (G % 8 == 0) ? (bx % 8) * (G / 8) + bx / 8 : bx;
    const int gw = vcu * NWAVES + wave, NGW = G * NWAVES;
    for (int u = tid0; u < (LDS_BYTES - RING_BYTES) / 4; u += NWAVES * 64) ((LAS unsigned*)(lds + RING_BYTES))[u] = 0u;
    __syncthreads();
    int lo, hi, use_bar;
    { KARGS(ka); lo = ka->ph_lo; hi = ka->ph_hi; use_bar = ka->use_bar;
      if (use_bar) (void)xcd_barrier_post((unsigned*)(ka->ws + WS_CTL) + CW_BAR, (volatile LAS unsigned*)(lds + MISC_OFF) + 8); }
    for (int ph = lo; ph < hi; ++ph) {
    const int l = ph >= 2 ? (ph - 2) / 9 : 0, pk = ph >= 2 ? (ph - 2) % 9 : -1; const bool last = (l == DEPTH - 1);
    const int Mrows = last ? RL : RT;
    const int pbit = ph == 0 ? 512 : (ph == 1 ? 1024 : (1 << pk)); const int nrep = (REPEAT_MASK & pbit) ? 2 : 1;
    for (int rep = 0; rep < nrep; ++rep) {
    int tid = threadIdx.x; asm volatile("" : "+v"(tid)); const int lane = tid & 63;
    if (ph == 0 && (PHASE_MASK & 512)) {
        KARGS(ka); unsigned char* ws = ka->ws;
        {
            mod_gemv_items(ka, ws, lds, tid, lane, wave, bx, 192, G);
            float* ROPE = (float*)(ws + WS_ROPE);
            if (bx == G - 1) for (int i = tid; i < 64 * 16; i += NWAVES * 64) { const int pos = i >> 4, f = i & 15; const float inv = powf(10000.0f, -(float)f / 16.0f); const float ang = (float)pos * inv;
                float sn, cs; sincosf(ang, &sn, &cs); ROPE[2 * i] = cs; ROPE[2 * i + 1] = sn; }
        }
        LAS float* scr = (LAS float*)(lds + wave * 8704);
        for (int it = gw; it < I_MIX; it += NGW) conv_item(ka, ws, 0, it, scr, lane);
    }
    else if (ph == 1 && (PHASE_MASK & 1024)) {
        KARGS(ka); unsigned char* ws = ka->ws; const float* x_in = ka->in[0]; const float* ctx_in = ka->in[2];
        const float* MOD = (const float*)(ws + WS_MOD); bf16* H = (bf16*)(ws + WS_H);
        rowpass_pipe<false, 0, true>(lane, gw, NGW, RL, x_in, false, nullptr, nullptr, H, nullptr, MOD, 1, 0, -1);
        rowpass_pipe<false, 0, true>(lane, (gw & 1) ? RC : (gw >> 1), NGW / 2, RC, ctx_in, false, nullptr, nullptr, H + (size_t)RL * DM, nullptr, MOD, 1, 0, 4);
    }
    else {
        if (pk == 0 && (PHASE_MASK & 1)) {
            KARGS(ka); unsigned char* ws = ka->ws; unsigned char* wb = ws + WS_W + (size_t)l * W_LAYER; unsigned char* pj = ws + WS_PROJ;
            pg8::Gemm g{(const bf16*)(ws + WS_H), (const bf16*)(wb + WO_IN), RT, PW, DM};
            pg8::EpiIn E{(bf16*)(pj + PO_U), (bf16*)(pj + PO_Q), (bf16*)(pj + PO_K), (bf16*)(pj + PO_VTL), (bf16*)(pj + PO_VTC), (bf16*)(pj + PO_GS), (bf16*)(pj + PO_GN), (const float*)(ws + WS_ROPE)};
            if (!last) { pg8::StaticOrder S; S.init(RT, PW, G, bx); pg8::gemm_phase<pg8::EpiIn, pg8::StaticOrder, true, true>(lds, g, S, E); IDLE_COPY((RT / 256) * (PW / 256), 0, I_MIX, I_LAYER); }
            else { pg8::OrderL1In S; S.init(RL, PW, G, bx); pg8::gemm_phase<pg8::EpiIn, pg8::OrderL1In, true, true>(lds, g, S, E); IDLE_COPY((RL / 256) * (PW / 256) + 48, 1, I_MIX, I_LAYER); }
        }
        else if (pk == 1 && (PHASE_MASK & 2)) {
            KARGS(ka); unsigned char* ws = ka->ws; unsigned char* pj = ws + WS_PROJ;
            const ScanPtrs SPp{ka->in[11], ka->in[12], ka->in[13], ka->in[14], ka->in[15], ka->in[16], ka->in[17], ka->in[18], (const bf16*)(pj + PO_U), (float*)(ws + WS_OUT), (bf16*)(ws + WS_ACT)};
            LAS unsigned* flagb = (LAS unsigned*)(lds + MISC_OFF) + 16;
            if (tid < 320) flagb[tid] = 0u;
            if (tid == 0) ((LAS unsigned*)(lds + MISC_OFF))[12] = 0u;
            LDS_WAIT(); __syncthreads();
            LAS unsigned* cctr = (LAS unsigned*)(lds + MISC_OFF) + 12;
            if (wave < 2) {
                __builtin_amdgcn_s_setprio(3);
                LAS unsigned char* sl = lds + wave * SCAN_LDS; int iter = 0;
                for (int rp = 0; rp < PROBE_SCAN_REP; ++rp)
                for (int pair = bx; pair < NB * SG; pair += G, ++iter) {
                    LAS unsigned* flags = flagb + (iter & 7) * 40;
                    if (wave == 0) scan_chain<false>(sl, flags, l, pair >> 6, pair & 63, SPp, lane, !last);
                    else scan_chain<true>(sl, flags, l, pair >> 6, pair & 63, SPp, lane, !last);
                }
                __builtin_amdgcn_s_setprio(0);
            } else {
                LAS unsigned char* tile = lds + 2 * SCAN_LDS + (wave - 2) * ATT_TILE;
                {
                    const AttPtrs AP{(const bf16*)(pj + PO_Q), (const bf16*)(pj + PO_K), (const bf16*)(pj + PO_VTL), (const bf16*)(pj + PO_VTC), (bf16*)(ws + WS_ATT), ka->in[21]};
                    LAS float* btab = (LAS float*)(lds + 2 * SCAN_LDS + 6 * ATT_TILE + (wave - 2) * 2048); int tab_head = -1;
                    const int ipp = last ? 64 : 72, nq = 8 * ipp, xg = bx & 7, slot = (bx >> 3) * 6 + (wave - 2), nslot = (G >> 3) * 6;
                    const int ncl = last ? 4 : 8; int cpair = bx, citer = 0, cli = wave - 2;
                    for (int q = slot; ; q += nslot) {
                        const bool have = q < nq;
                        if (have) { const int pid = xg * 8 + q / ipp, w = q % ipp;
                            att_item(w < 64 ? pid * 64 + w : 4096 + pid * 8 + (w - 64), l, AP, tile, btab, tab_head, lane); }
                        while (cpair < NB * SG) {
                            if (cli >= ncl) { cli = wave - 2; cpair += G; ++citer; continue; }
                            const int cfc = last ? 18 + cli : (cli < 4 ? cli : 14 + cli);
                            volatile LAS unsigned* flags = (volatile LAS unsigned*)(flagb + (citer & 7) * 40);
                            if (flags[cfc] < 2u) { if (have) break;
                                unsigned spins = 0; while (flags[cfc] < 2u && ++spins < (1u << 24)) __builtin_amdgcn_s_sleep(8); }
                            asm volatile("" ::: "memory");
                            scan_combine(SPp, l, cpair >> 6, cpair & 63, cfc, lane);
                            cli += 6;
                        }
                        if (!have) break;
                    }
                }
            }
            __syncthreads();
        }
        else if (pk == 2 && (PHASE_MASK & 4)) {
            KARGS(ka); unsigned char* ws = ka->ws; unsigned char* wb = ws + WS_W + (size_t)l * W_LAYER;
            pg8::Gemm g{(const bf16*)(ws + WS_ACT), (const bf16*)(wb + WO_VG), Mrows, 2 * DM, SSMW}; pg8::StaticOrder S; S.init(Mrows, 2 * DM, G, bx);
            pg8::EpiD1 E{(const bf16*)(ws + WS_PROJ + PO_GS), (bf16*)(ws + WS_TM)};
            pg8::gemm_phase<pg8::EpiD1, pg8::StaticOrder, true, true>(lds, g, S, E);
            if (!last) { const int first = ((Mrows / 256) * (2 * DM / 256)) % G; if (first != 0 && bx >= first) mod_gemv_items(ka, ws, lds, tid, lane, wave, 192 + bx - first, 2 * 192, G - first); else if (first == 0) mod_gemv_items(ka, ws, lds, tid, lane, wave, 192 + bx, 2 * 192, G); }
        }
        else if (pk == 3 && (PHASE_MASK & 8)) {
            KARGS(ka); unsigned char* ws = ka->ws; unsigned char* wb = ws + WS_W + (size_t)l * W_LAYER;
            pg8::Gemm g{(const bf16*)(ws + WS_ATT), (const bf16*)(wb + WO_NA), Mrows, DM, NAW}; pg8::StaticOrder S; S.init(Mrows, DM, G, bx);
            pg8::EpiD2 E{(const bf16*)(ws + WS_PROJ + PO_GN), (bf16*)(ws + WS_TM)};
            pg8::gemm_phase<pg8::EpiD2, pg8::StaticOrder, true, true>(lds, g, S, E);
        }
        else if (pk == 4 && (PHASE_MASK & 16)) {
            KARGS(ka); unsigned char* ws = ka->ws; unsigned char* wb = ws + WS_W + (size_t)l * W_LAYER;
            pg8::Gemm g{(const bf16*)(ws + WS_TM), (const bf16*)(wb + WO_OUT), Mrows, DM, DM}; pg8::OrderSplitCtx S; S.init(RL, DM, G, bx); S.ksl = DM / 64 / 8; S.nctx = last ? 0 : 256;
            pg8::EpiF32S E{(bf16*)(ws + WS_OUT), (bf16*)(ws + WS_SLAB)};
            pg8::gemm_phase<pg8::EpiF32S, pg8::OrderSplitCtx, true, true>(lds, g, S, E);
        }
        else if ((pk == 5 && (PHASE_MASK & 32)) || (pk == 8 && (PHASE_MASK & 256))) {
            KARGS(ka); unsigned char* ws = ka->ws; const bool r2 = pk == 8;
            const float* mdl = (const float*)(ws + WS_MOD) + (size_t)(l * 5) * (NMOD * DM); const float* modg = mdl + (r2 ? 5 : 2) * DM;
            const float* modh = r2 ? mdl + (size_t)5 * (NMOD * DM) : mdl; const int kss = r2 ? 1 : 4, ksh = r2 ? 0 : 3;
            bf16* H = (bf16*)(ws + WS_H); bf16* XA = (bf16*)(ws + WS_XA); const bool xf = !r2 && l == 0;
            if (!last) rowpass_ctx8((LAS float*)(lds + MISC_OFF + 4096), lane, wave, vcu, G, xf ? (const void*)ka->in[2] : (const void*)(XA + (size_t)RL * DM), !xf, (const bf16*)(ws + WS_SLAB), XA + (size_t)RL * DM, H + (size_t)RL * DM,
                                    modg + (size_t)4 * (NMOD * DM), modh + (size_t)4 * (NMOD * DM) + kss * DM, modh + (size_t)4 * (NMOD * DM) + ksh * DM);
            if (!(r2 && last)) rowpass_pipe<true, 2, true>(lane, gw, NGW, RL, xf ? (const void*)ka->in[0] : (const void*)XA, !xf, (const bf16*)(ws + WS_OUT), XA, H, modg, modh, kss, ksh, -1);
            else rowpass_pipe<true, 1, false>(lane, gw, NGW, RL, XA, true, (const bf16*)(ws + WS_OUT), ka->out, nullptr, modg, nullptr, 0, 0, -1);
        }
        else if (pk == 6 && (PHASE_MASK & 64)) {
            KARGS(ka); unsigned char* ws = ka->ws; unsigned char* wb = ws + WS_W + (size_t)l * W_LAYER;
            pg8::Gemm g{(const bf16*)(ws + WS_H), (const bf16*)(wb + WO_FC1), Mrows, DFF, DM}; pg8::StaticOrder S; S.init(Mrows, DFF, G, bx);
            pg8::EpiRelu2 E{(bf16*)(ws + WS_PROJ), DFF};
            pg8::gemm_phase<pg8::EpiRelu2, pg8::StaticOrder, true, true>(lds, g, S, E);
            if (!last) IDLE_COPY((RT / 256) * (DFF / 256), 1, 0, I_MIX);
        }
        else if (pk == 7 && (PHASE_MASK & 128)) {
            KARGS(ka); unsigned char* ws = ka->ws; unsigned char* wb = ws + WS_W + (size_t)l * W_LAYER;
            pg8::Gemm g{(const bf16*)(ws + WS_PROJ), (const bf16*)(wb + WO_FC2), Mrows, DM, DFF}; pg8::OrderSplitCtx S; S.init(RL, DM, G, bx); S.ksl = DFF / 64 / 8; S.nctx = last ? 0 : 256;
            pg8::EpiF32S E{(bf16*)(ws + WS_OUT), (bf16*)(ws + WS_SLAB)};
            pg8::gemm_phase<pg8::EpiF32S, pg8::OrderSplitCtx, true, true>(lds, g, S, E);
        }
    }
    }
    if (ph + 1 < hi && use_bar) {
        KARGS(kb); XcdBarrier b2; b2.bar = (unsigned*)(kb->ws + WS_CTL) + CW_BAR; b2.x = xb_xcc_id(); b2.st = (volatile LAS unsigned*)(lds + MISC_OFF) + 8;
        xcd_barrier(b2);
    }
    }
}

extern "C" void kernel_launch(void* const* d_in, const int* in_sizes, int n_in, void* d_out, int out_size, void* d_ws, size_t ws_size, hipStream_t stream) {
    static int grid = 0;
    if (grid == 0) {
        if (n_in != 26 || in_sizes[0] != RL * DM || out_size != RL * DM || ws_size < WS_END) { fprintf(stderr, "kernel_launch: unexpected shapes / workspace (n_in %d, in0 %d, out %d, ws %zu < %zu); nothing launched\n", n_in, n_in > 0 ? in_sizes[0] : -1, out_size, ws_size, (size_t)WS_END); grid = -1; return; }
        int dev = 0, cus = 0, per_cu = 0;
        if (hipGetDevice(&dev) != hipSuccess || hipDeviceGetAttribute(&cus, hipDeviceAttributeMultiprocessorCount, dev) != hipSuccess) { grid = -1; return; }
        if (hipFuncSetAttribute((const void*)mega_fwd, hipFuncAttributeMaxDynamicSharedMemorySize, LDS_BYTES) != hipSuccess) { fprintf(stderr, "kernel_launch: hipFuncSetAttribute failed\n"); grid = -1; return; }
        if (hipOccupancyMaxActiveBlocksPerMultiprocessor(&per_cu, (const void*)mega_fwd, NWAVES * 64, LDS_BYTES) != hipSuccess || per_cu < 1) { fprintf(stderr, "kernel_launch: occupancy query says %d blocks per CU; nothing launched\n", per_cu); (void)hipGetLastError(); grid = -1; return; }
        grid = cus;
    }
    if (grid < 0) return;
    (void)hipMemsetAsync((char*)d_ws + WS_CTL, 0, CTL_ZERO_BYTES, stream);
    Args a{};
    for (int i = 0; i < 26; ++i) a.in[i] = (const float*)d_in[i];
    a.out = (float*)d_out; a.ws = (unsigned char*)d_ws;
#if MK_PER_PHASE
    for (int p = 0; p < NPH; ++p) { a.ph_lo = p; a.ph_hi = p + 1; a.use_bar = 0; a.pad = 0; hipLaunchKernelGGL(mega_fwd, dim3(grid), dim3(NWAVES * 64), LDS_BYTES, stream, a); }
#else
    a.ph_lo = 0; a.ph_hi = NPH; a.use_bar = 1; a.pad = 0;
    hipLaunchKernelGGL(mega_fwd, dim3(grid), dim3(NWAVES * 64), LDS_BYTES, stream, a);
#endif
}
```

```cpp
#include <hip/hip_runtime.h>
#include <cstdio>
#include <cstdint>
#ifndef MK_PER_PHASE
#define MK_PER_PHASE 0
#endif
namespace pg8 {
#define PG8_LAS __attribute__((address_space(3)))
typedef unsigned short bf16_t;
typedef short bf16x8 __attribute__((ext_vector_type(8)));
typedef float f32x4 __attribute__((ext_vector_type(4)));
typedef unsigned u32x4 __attribute__((ext_vector_type(4)));
constexpr int BM = 256, BK = 64, HALF = 128, HTB = HALF * BK * 2  , STAGE_BYTES = 8 * HTB, NXCD = 8, WGM = 8;

__host__ __device__ __forceinline__ int lds_byte(int r, int c) { const int st = (r >> 4) * 2 + (c >> 5), rr = r & 15, cc = c & 31, ob = rr * 64 + cc * 2; return st * 1024 + (ob ^ (((ob >> 9) & 1) << 5)); }
__host__ __device__ __forceinline__ void stage_rc(int b, int& R, int& C) { const int st = b / 1024, sb = b % 1024, swz = sb ^ (((sb >> 9) & 1) << 5); R = (st >> 1) * 16 + swz / 64; C = (st & 1) * 32 + (swz % 64) / 2; }
__host__ __device__ __forceinline__ int perm32(int rho) { const int n = rho >> 4, i = rho & 15; return 8 * (i >> 2) + 4 * n + (i & 3); }

struct Unit { int pm, pn, nt, ks; };
struct Gemm { const bf16_t* A; const bf16_t* Bt; int M, N, K; };

struct StaticOrder {
    int nM, nN, nwg, G, c;
    __host__ __device__ void init(int M, int N, int G_, int c_) { nM = M / BM; nN = N / BM; nwg = nM * nN; G = G_; c = c_; }
    __host__ __device__ __forceinline__ bool next(int i, Unit& u, int ntdef) const {
        u.nt = ntdef; u.ks = 0; u.pm = 0; u.pn = 0;
        const long L = (long)i * G + c; if (L >= nwg) return false;
        int wgid = (int)L; { const int q = nwg / NXCD, r = nwg % NXCD, xcd = wgid % NXCD, off = wgid / NXCD; wgid = (xcd < r ? xcd * (q + 1) : r * (q + 1) + (xcd - r) * q) + off; }
        const int nig = WGM * nN, gid = wgid / nig, fm = gid * WGM, gsz = (nM - fm) < WGM ? (nM - fm) : WGM;
        u.pm = fm + ((wgid % nig) % gsz); u.pn = (wgid % nig) / gsz; return true;
    }
    __device__ __forceinline__ void a_ready(const Unit&) const {}
    __device__ __forceinline__ void done(const Unit&) const {}
};


__device__ __forceinline__ unsigned cvt_pk_bf16(float lo, float hi) { unsigned r; asm volatile("v_cvt_pk_bf16_f32 %0, %1, %2" : "=v"(r) : "v"(lo), "v"(hi)); return r; }
typedef unsigned u32x2 __attribute__((ext_vector_type(2)));
__device__ __forceinline__ float sigm(float x) { return __builtin_amdgcn_rcpf(1.0f + __builtin_amdgcn_exp2f(-1.4426950408889634f * x)); }
__device__ __forceinline__ float bflo(unsigned w) { return __uint_as_float(w << 16); }
__device__ __forceinline__ float bfhi(unsigned w) { return __uint_as_float(w & 0xffff0000u); }
__device__ __forceinline__ u32x2 pack4(f32x4 v) { u32x2 w; w.x = cvt_pk_bf16(v[0], v[1]); w.y = cvt_pk_bf16(v[2], v[3]); return w; }

constexpr float QSCALE = 0.125f * 1.4426950408889634f;

struct EpiIn {
    static constexpr bool PERM = false, AFTER_DRAIN = false;
    bf16_t *U, *Q, *Kb, *VTl, *VTc, *GS, *GN; const float* rope;
    __device__ __forceinline__ void operator()(const f32x4 (&acc)[2][2][4][2], const Unit& u, int wr, int wc, int fr, int fq) const {
        const int pn = u.pn; const bool lat = u.pm < 32;
        const int row0 = u.pm * BM + wr * 64 + fr;
        if (pn < 4 || pn >= 16) {
            bf16_t* base; int ld, colt; bool sg;
            if (pn < 4) { base = U; ld = 1024; colt = pn * 256; sg = false; }
            else if (pn < 24) { base = GS; ld = 2048; colt = (pn - 16) * 256; sg = true; }
            else { base = GN; ld = 2048; colt = (pn - 24) * 256; sg = true; }
            const int col0 = colt + wc * 32 + 4 * fq;
#pragma unroll
            for (int ai = 0; ai < 2; ++ai)
#pragma unroll
                for (int m = 0; m < 4; ++m) { bf16_t* rowp = base + (size_t)(row0 + ai * HALF + m * 16) * ld + col0;
#pragma unroll
                    for (int bj = 0; bj < 2; ++bj)
#pragma unroll
                        for (int n = 0; n < 2; ++n) { f32x4 v = acc[ai][bj][m][n];
                            if (sg) { v[0] = sigm(v[0]); v[1] = sigm(v[1]); v[2] = sigm(v[2]); v[3] = sigm(v[3]); }
                            *(u32x2*)(rowp + bj * HALF + n * 16) = pack4(v); } }
        } else if (pn < 12) {
            const bool isq = pn < 8; bf16_t* base = isq ? Q : Kb; const int colt = (pn - (isq ? 4 : 8)) * 256;
            const float sc = isq ? QSCALE : 1.0f; const int col0 = colt + wc * 32 + 4 * fq; const int colsel = wc & 1;
#pragma unroll
            for (int ai = 0; ai < 2; ++ai)
#pragma unroll
                for (int m = 0; m < 4; ++m) { const int row = row0 + ai * HALF + m * 16; bf16_t* rowp = base + (size_t)row * 1024 + col0;
                    f32x4 cA = (f32x4){1.f, 0.f, 1.f, 0.f}, cB = cA;
                    if (lat) { const int t = row & 2047, pos = colsel ? (t & 63) : (t >> 6); const f32x4* rp = (const f32x4*)(rope + (pos * 16 + 4 * fq) * 2); cA = rp[0]; cB = rp[1]; }
#pragma unroll
                    for (int bj = 0; bj < 2; ++bj) { const f32x4 x1 = acc[ai][bj][m][0], x2 = acc[ai][bj][m][1]; f32x4 o1, o2;
                        o1[0] = x1[0] * cA[0] - x2[0] * cA[1]; o2[0] = x1[0] * cA[1] + x2[0] * cA[0];
                        o1[1] = x1[1] * cA[2] - x2[1] * cA[3]; o2[1] = x1[1] * cA[3] + x2[1] * cA[2];
                        o1[2] = x1[2] * cB[0] - x2[2] * cB[1]; o2[2] = x1[2] * cB[1] + x2[2] * cB[0];
                        o1[3] = x1[3] * cB[2] - x2[3] * cB[3]; o2[3] = x1[3] * cB[3] + x2[3] * cB[2];
                        o1 = o1 * sc; o2 = o2 * sc;
                        *(u32x2*)(rowp + bj * HALF) = pack4(o1); *(u32x2*)(rowp + bj * HALF + 16) = pack4(o2); } }
        } else {
            const int colt = (pn - 12) * 256;
#pragma unroll
            for (int ai = 0; ai < 2; ++ai)
#pragma unroll
                for (int m = 0; m < 4; ++m) { const int row = row0 + ai * HALF + m * 16;
                    bf16_t* bp; int tstride;
                    if (lat) { const int b = row >> 11, t = row & 2047; bp = VTl + (size_t)b * (16 * 64 * 2048) + t; tstride = 2048; }
                    else { const int rr = row - 8192, b = rr >> 8, l = rr & 255; bp = VTc + (size_t)b * (16 * 64 * 256) + l; tstride = 256; }
#pragma unroll
                    for (int bj = 0; bj < 2; ++bj)
#pragma unroll
                        for (int n = 0; n < 2; ++n) { const int c = colt + bj * HALF + wc * 32 + n * 16 + 4 * fq; const f32x4 v = acc[ai][bj][m][n];
                            const u32x2 w = pack4(v);
                            bp[(size_t)(c + 0) * tstride] = (bf16_t)(w.x & 0xffffu); bp[(size_t)(c + 1) * tstride] = (bf16_t)(w.x >> 16);
                            bp[(size_t)(c + 2) * tstride] = (bf16_t)(w.y & 0xffffu); bp[(size_t)(c + 3) * tstride] = (bf16_t)(w.y >> 16); } }
        }
    }
};
struct EpiD1 {
    static constexpr bool PERM = false, AFTER_DRAIN = false;
    const bf16_t* GS; bf16_t* T1;
    __device__ __forceinline__ void operator()(const f32x4 (&acc)[2][2][4][2], const Unit& u, int wr, int wc, int fr, int fq) const {
        const int row0 = u.pm * BM + wr * 64 + fr, L0 = u.pn * 128 + wc * 16 + 4 * fq;
#pragma unroll
        for (int ai = 0; ai < 2; ++ai)
#pragma unroll
            for (int m = 0; m < 4; ++m) { const size_t off = (size_t)(row0 + ai * HALF + m * 16) * 2048 + L0;
#pragma unroll
                for (int bj = 0; bj < 2; ++bj) { const f32x4 val = acc[ai][bj][m][0], glu = acc[ai][bj][m][1]; const u32x2 g = *(const u32x2*)(GS + off + bj * 64); f32x4 t;
                    t[0] = bflo(g.x) * val[0] * sigm(glu[0]); t[1] = bfhi(g.x) * val[1] * sigm(glu[1]); t[2] = bflo(g.y) * val[2] * sigm(glu[2]); t[3] = bfhi(g.y) * val[3] * sigm(glu[3]);
                    *(u32x2*)(T1 + off + bj * 64) = pack4(t); } }
    }
};
struct EpiD2 {
    static constexpr bool PERM = true, AFTER_DRAIN = false;
    const bf16_t* GN; bf16_t* TM;
    __device__ __forceinline__ void operator()(const f32x4 (&acc)[2][2][4][2], const Unit& u, int wr, int wc, int fr, int fq) const {
        const int row0 = u.pm * BM + wr * 64 + fr, col0 = u.pn * BM + wc * 32 + 8 * fq;
#pragma unroll
        for (int ai = 0; ai < 2; ++ai)
#pragma unroll
            for (int m = 0; m < 4; ++m) { const size_t off = (size_t)(row0 + ai * HALF + m * 16) * 2048 + col0;
#pragma unroll
                for (int bj = 0; bj < 2; ++bj) { const f32x4 v0 = acc[ai][bj][m][0], v1 = acc[ai][bj][m][1];
                    const u32x4 t = *(const u32x4*)(TM + off + bj * HALF), g = *(const u32x4*)(GN + off + bj * HALF); u32x4 w;
                    w.x = cvt_pk_bf16(bflo(t.x) + bflo(g.x) * v0[0], bfhi(t.x) + bfhi(g.x) * v0[1]); w.y = cvt_pk_bf16(bflo(t.y) + bflo(g.y) * v0[2], bfhi(t.y) + bfhi(g.y) * v0[3]);
                    w.z = cvt_pk_bf16(bflo(t.z) + bflo(g.z) * v1[0], bfhi(t.z) + bfhi(g.z) * v1[1]); w.w = cvt_pk_bf16(bflo(t.w) + bflo(g.w) * v1[2], bfhi(t.w) + bfhi(g.w) * v1[3]);
                    *(u32x4*)(TM + off + bj * HALF) = w; } }
    }
};
struct EpiF32 {
    static constexpr bool PERM = false, AFTER_DRAIN = false;
    float* O; int ldc;
    __device__ __forceinline__ void operator()(const f32x4 (&acc)[2][2][4][2], const Unit& u, int wr, int wc, int fr, int fq) const {
        const int row0 = u.pm * BM + wr * 64 + fr, col0 = u.pn * BM + wc * 32 + 4 * fq;
#pragma unroll
        for (int ai = 0; ai < 2; ++ai)
#pragma unroll
            for (int m = 0; m < 4; ++m) { float* rowp = O + (size_t)(row0 + ai * HALF + m * 16) * ldc + col0;
#pragma unroll
                for (int bj = 0; bj < 2; ++bj)
#pragma unroll
                    for (int n = 0; n < 2; ++n) *(f32x4*)(rowp + bj * HALF + n * 16) = acc[ai][bj][m][n]; }
    }
};
struct EpiF32S {
    static constexpr bool PERM = true, AFTER_DRAIN = false;
    bf16_t* O; bf16_t* SL;
    __device__ __forceinline__ void operator()(const f32x4 (&acc)[2][2][4][2], const Unit& u, int wr, int wc, int fr, int fq) const {
        const int row0 = u.pm * BM + wr * 64 + fr, col0 = u.pn * BM + wc * 32 + 8 * fq;
        if (u.pm < 32) {
#pragma unroll
            for (int ai = 0; ai < 2; ++ai)
#pragma unroll
                for (int m = 0; m < 4; ++m) { bf16_t* rowp = O + (size_t)(row0 + ai * HALF + m * 16) * 2048 + col0;
#pragma unroll
                    for (int bj = 0; bj < 2; ++bj) { const f32x4 v0 = acc[ai][bj][m][0], v1 = acc[ai][bj][m][1];
                        u32x4 w; w.x = cvt_pk_bf16(v0[0], v0[1]); w.y = cvt_pk_bf16(v0[2], v0[3]); w.z = cvt_pk_bf16(v1[0], v1[1]); w.w = cvt_pk_bf16(v1[2], v1[3]);
                        *(u32x4*)(rowp + bj * HALF) = w; } }
        } else {
            bf16_t* base = SL + ((size_t)u.ks * 1024 + (row0 - 8192)) * 2048;
#pragma unroll
            for (int ai = 0; ai < 2; ++ai)
#pragma unroll
                for (int m = 0; m < 4; ++m) { bf16_t* rowp = base + (size_t)(ai * HALF + m * 16) * 2048 + col0;
#pragma unroll
                    for (int bj = 0; bj < 2; ++bj) { const f32x4 v0 = acc[ai][bj][m][0], v1 = acc[ai][bj][m][1];
                        u32x4 w; w.x = cvt_pk_bf16(v0[0], v0[1]); w.y = cvt_pk_bf16(v0[2], v0[3]); w.z = cvt_pk_bf16(v1[0], v1[1]); w.w = cvt_pk_bf16(v1[2], v1[3]);
                        *(u32x4*)(rowp + bj * HALF) = w; } }
        }
    }
};
struct OrderSplitCtx : StaticOrder {
    int ksl, nctx;
    __device__ __forceinline__ bool next(int i, Unit& u, int ntdef) const {
        if (StaticOrder::next(i, u, ntdef)) return true;
        const long L = (long)i * G + c - nwg; if (L >= nctx) return false;
        const int unit = (int)L >> 3; u.pm = 32 + (unit & 3); u.pn = unit >> 2; u.ks = (int)L & 7; u.nt = ksl; return true;
    }
};
struct EpiRelu2 {
    static constexpr bool PERM = true, AFTER_DRAIN = false;
    bf16_t* O; int ldc;
    __device__ __forceinline__ void operator()(const f32x4 (&acc)[2][2][4][2], const Unit& u, int wr, int wc, int fr, int fq) const {
        const int row0 = u.pm * BM + wr * 64 + fr, col0 = u.pn * BM + wc * 32 + 8 * fq;
#pragma unroll
        for (int ai = 0; ai < 2; ++ai)
#pragma unroll
            for (int m = 0; m < 4; ++m) { bf16_t* rowp = O + (size_t)(row0 + ai * HALF + m * 16) * ldc + col0;
#pragma unroll
                for (int bj = 0; bj < 2; ++bj) { f32x4 v0 = acc[ai][bj][m][0], v1 = acc[ai][bj][m][1];
                    v0 = __builtin_elementwise_max(v0, (f32x4){0.f, 0.f, 0.f, 0.f}); v1 = __builtin_elementwise_max(v1, (f32x4){0.f, 0.f, 0.f, 0.f}); v0 = v0 * v0; v1 = v1 * v1;
                    u32x4 w; w.x = cvt_pk_bf16(v0[0], v0[1]); w.y = cvt_pk_bf16(v0[2], v0[3]); w.z = cvt_pk_bf16(v1[0], v1[1]); w.w = cvt_pk_bf16(v1[2], v1[3]);
                    *(u32x4*)(rowp + bj * HALF) = w; } }
    }
};
struct OrderL1In : StaticOrder {
    __device__ __forceinline__ bool next(int i, Unit& u, int ntdef) const {
        if (StaticOrder::next(i, u, ntdef)) return true;
        const long L = (long)i * G + c - nwg; if (L >= 48) return false;
        const int k = (int)L >> 2; u.pm = 32 + ((int)L & 3); u.pn = k < 4 ? k : k + 4; return true;
    }
};

template <class Epi, class Sched, bool ALIGN_EPI = false, bool SP2 = false>
__device__ __forceinline__ void gemm_phase(PG8_LAS unsigned char* lds, const Gemm g, const Sched& S, const Epi& E) {
    int tid_o = threadIdx.x; asm volatile("" : "+v"(tid_o));
    const int tid = tid_o, wid = __builtin_amdgcn_readfirstlane(tid >> 6), lane = tid & 63, wr = wid >> 2, wc = wid & 3, fr = lane & 15, fq = lane >> 4;
    const int K = g.K, nt = K / BK;
    unsigned voffA[2], voffB[2];
#pragma unroll
    for (int i = 0; i < 2; ++i) { int R, C; stage_rc(tid * 16 + i * 8192, R, C); const int Rb = Epi::PERM ? ((R & ~31) + perm32(R & 31)) : R;
        voffA[i] = (unsigned)(R * K + C) * 2u; voffB[i] = (unsigned)(Rb * K + C) * 2u; }
    const size_t kstep = (size_t)(BK * 2);
    const size_t hstep = (size_t)HALF * K * 2;
    const size_t tstep = 2 * hstep;
    const unsigned ldsw = (unsigned)wid * 1024u;
    const int aoff = lds_byte(wr * 64 + fr, fq * 8), boff = lds_byte(wc * 32 + fr, fq * 8);
#define PG8_SA(b, h) (((b) * 2 + (h)) * HTB)
#define PG8_SB(b, h) ((4 + (b) * 2 + (h)) * HTB)
#define PG8_STAGE(bufoff, gbase, voff) do { _Pragma("unroll") for (int _i = 0; _i < 2; ++_i) \
        __builtin_amdgcn_global_load_lds((const unsigned*)((const char*)(gbase) + (voff)[_i]), (PG8_LAS unsigned*)(lds + (bufoff) + ldsw + _i * 8192), 16, 0, 0); } while (0)
#define PG8_LDA(dst, b, h) do { _Pragma("unroll") for (int m = 0; m < 4; ++m) _Pragma("unroll") for (int k = 0; k < 2; ++k) dst[m][k] = *(const PG8_LAS bf16x8*)(lds + PG8_SA(b, h) + aoff + m * 2048 + k * 1024); } while (0)
#define PG8_LDB(dst, b, h) do { _Pragma("unroll") for (int n = 0; n < 2; ++n) _Pragma("unroll") for (int k = 0; k < 2; ++k) dst[n][k] = *(const PG8_LAS bf16x8*)(lds + PG8_SB(b, h) + boff + n * 2048 + k * 1024); } while (0)
#define PG8_MMA(ai, bj, At, Bt) do { __builtin_amdgcn_s_setprio(1); _Pragma("unroll") for (int m = 0; m < 4; ++m) _Pragma("unroll") for (int n = 0; n < 2; ++n) _Pragma("unroll") for (int k = 0; k < 2; ++k) \
        acc[ai][bj][m][n] = __builtin_amdgcn_mfma_f32_16x16x32_bf16(Bt[n][k], At[m][k], acc[ai][bj][m][n], 0, 0, 0); __builtin_amdgcn_s_setprio(0); } while (0)
#define PG8_WAIT_V(n) asm volatile("s_waitcnt vmcnt(" #n ")" ::: "memory")
#define PG8_WAIT_L(n) asm volatile("s_waitcnt lgkmcnt(" #n ")" ::: "memory")
#define PG8_BAR __builtin_amdgcn_s_barrier()
#define PG8_SCHED __builtin_amdgcn_sched_barrier(0)
    Unit cur, nxt; int ui = 0;
    if (!S.next(0, cur, nt)) return;
    f32x4 acc[2][2][4][2];
#pragma unroll
    for (int a = 0; a < 2; ++a)
#pragma unroll
        for (int b = 0; b < 2; ++b)
#pragma unroll
            for (int m = 0; m < 4; ++m)
#pragma unroll
                for (int n = 0; n < 2; ++n) acc[a][b][m][n] = (f32x4){0.f, 0.f, 0.f, 0.f};
    bf16x8 At[4][2], B0[2][2], B1[2][2];
    const char* cA = (const char*)g.A + (size_t)cur.pm * tstep + (size_t)(cur.ks * cur.nt) * (BK * 2); const char* cB = (const char*)g.Bt + (size_t)cur.pn * tstep + (size_t)(cur.ks * cur.nt) * (BK * 2);
    S.a_ready(cur);
    if constexpr (SP2) {
        PG8_STAGE(PG8_SB(0, 0), cB, voffB); PG8_STAGE(PG8_SB(0, 1), cB + hstep, voffB); PG8_STAGE(PG8_SA(0, 0), cA, voffA); PG8_STAGE(PG8_SA(0, 1), cA + hstep, voffA);
        if (wr == 1) PG8_BAR;
        PG8_WAIT_V(2); PG8_BAR;
        PG8_STAGE(PG8_SB(1, 0), cB + kstep, voffB); PG8_STAGE(PG8_SA(1, 0), cA + kstep, voffA); PG8_STAGE(PG8_SB(1, 1), cB + hstep + kstep, voffB);
        PG8_WAIT_V(6); PG8_BAR;
    } else {
        PG8_STAGE(PG8_SB(0, 0), cB, voffB); PG8_STAGE(PG8_SA(0, 0), cA, voffA); PG8_STAGE(PG8_SB(0, 1), cB + hstep, voffB); PG8_STAGE(PG8_SA(0, 1), cA + hstep, voffA);
        if (wr == 1) PG8_BAR;
        PG8_WAIT_V(4); PG8_BAR;
        PG8_STAGE(PG8_SB(1, 0), cB + kstep, voffB); PG8_STAGE(PG8_SA(1, 0), cA + kstep, voffA); PG8_STAGE(PG8_SB(1, 1), cB + hstep + kstep, voffB);
        PG8_WAIT_V(6); PG8_BAR;
    }
    for (;;) {
        const bool has_next = S.next(ui + 1, nxt, nt);
        const int ntu = cur.nt;
        const char* nA = has_next ? (const char*)g.A + (size_t)nxt.pm * tstep + (size_t)(nxt.ks * nxt.nt) * (BK * 2) : cA; const char* nB = has_next ? (const char*)g.Bt + (size_t)nxt.pn * tstep + (size_t)(nxt.ks * nxt.nt) * (BK * 2) : cB;
        for (int t = 0; t < ntu; t += 2) {
            const bool last = (t == ntu - 2);
            const char* a1 = cA + (size_t)(t + 1) * kstep;
            const char* a2 = last ? nA : cA + (size_t)(t + 2) * kstep; const char* b2 = last ? nB : cB + (size_t)(t + 2) * kstep;
            const char* a3 = a2 + kstep; const char* b3 = b2 + kstep;
            if (last && has_next) S.a_ready(nxt);
            if constexpr (SP2) {
            PG8_LDB(B0, 0, 0); PG8_LDB(B1, 0, 1); PG8_SCHED; PG8_LDA(At, 0, 0); PG8_STAGE(PG8_SA(1, 1), a1 + hstep, voffA);
            PG8_WAIT_V(8); PG8_WAIT_L(0); PG8_BAR; PG8_MMA(0, 0, At, B0); PG8_MMA(0, 1, At, B1); PG8_BAR; PG8_SCHED;
            PG8_LDA(At, 0, 1); PG8_STAGE(PG8_SB(0, 0), b2, voffB); PG8_STAGE(PG8_SB(0, 1), b2 + hstep, voffB); PG8_STAGE(PG8_SA(0, 0), a2, voffA);
            PG8_WAIT_V(8); PG8_WAIT_L(0); PG8_BAR; PG8_MMA(1, 0, At, B0); PG8_MMA(1, 1, At, B1); PG8_BAR; PG8_SCHED;
            PG8_LDB(B0, 1, 0); PG8_LDB(B1, 1, 1); PG8_SCHED; PG8_LDA(At, 1, 0); PG8_STAGE(PG8_SA(0, 1), a2 + hstep, voffA);
            PG8_WAIT_V(8); PG8_WAIT_L(0); PG8_BAR; PG8_MMA(0, 0, At, B0); PG8_MMA(0, 1, At, B1); PG8_BAR; PG8_SCHED;
            PG8_LDA(At, 1, 1); PG8_STAGE(PG8_SB(1, 0), b3, voffB); PG8_STAGE(PG8_SB(1, 1), b3 + hstep, voffB); PG8_STAGE(PG8_SA(1, 0), a3, voffA);
            PG8_WAIT_V(8); PG8_WAIT_L(0); PG8_BAR; PG8_MMA(1, 0, At, B0); PG8_MMA(1, 1, At, B1); PG8_BAR; PG8_SCHED;
            } else {
            PG8_LDB(B0, 0, 0); PG8_SCHED; PG8_LDA(At, 0, 0); PG8_STAGE(PG8_SA(1, 1), a1 + hstep, voffA);
            PG8_WAIT_L(8); PG8_BAR; PG8_WAIT_L(0); PG8_MMA(0, 0, At, B0); PG8_BAR; PG8_SCHED;
            PG8_LDB(B1, 0, 1); PG8_STAGE(PG8_SB(0, 0), b2, voffB);
            PG8_BAR; PG8_WAIT_L(0); PG8_MMA(0, 1, At, B1); PG8_BAR;
            PG8_LDA(At, 0, 1); PG8_STAGE(PG8_SA(0, 0), a2, voffA);
            PG8_BAR; PG8_WAIT_L(0); PG8_MMA(1, 0, At, B0); PG8_BAR; PG8_SCHED;
            PG8_STAGE(PG8_SB(0, 1), b2 + hstep, voffB);
            PG8_WAIT_V(6); PG8_BAR; PG8_MMA(1, 1, At, B1); PG8_BAR;
            PG8_LDB(B0, 1, 0); PG8_SCHED; PG8_LDA(At, 1, 0); PG8_STAGE(PG8_SA(0, 1), a2 + hstep, voffA);
            PG8_WAIT_L(8); PG8_BAR; PG8_WAIT_L(0); PG8_MMA(0, 0, At, B0); PG8_BAR; PG8_SCHED;
            PG8_LDB(B1, 1, 1); PG8_STAGE(PG8_SB(1, 0), b3, voffB);
            PG8_BAR; PG8_WAIT_L(0); PG8_MMA(0, 1, At, B1); PG8_BAR;
            PG8_LDA(At, 1, 1); PG8_STAGE(PG8_SA(1, 0), a3, voffA);
            PG8_BAR; PG8_WAIT_L(0); PG8_MMA(1, 0, At, B0); PG8_BAR; PG8_SCHED;
            PG8_STAGE(PG8_SB(1, 1), b3 + hstep, voffB);
            PG8_WAIT_V(6); PG8_BAR; PG8_MMA(1, 1, At, B1); PG8_BAR;
            }
        }
        if constexpr (ALIGN_EPI) { if (wr == 0) PG8_BAR; }
        if constexpr (!Epi::AFTER_DRAIN) { E(acc, cur, wr, wc, fr, fq); S.done(cur); }
        if (!has_next) break;
#pragma unroll
        for (int a = 0; a < 2; ++a)
#pragma unroll
            for (int b = 0; b < 2; ++b)
#pragma unroll
                for (int m = 0; m < 4; ++m)
#pragma unroll
                    for (int n = 0; n < 2; ++n) acc[a][b][m][n] = (f32x4){0.f, 0.f, 0.f, 0.f};
        cur = nxt; cA = nA; cB = nB; ++ui;
        if constexpr (ALIGN_EPI) { if (wr == 1) PG8_BAR; }
    }
    PG8_WAIT_V(0);
    if constexpr (!ALIGN_EPI) { if (wr == 0) PG8_BAR; }
    PG8_BAR;
    if constexpr (Epi::AFTER_DRAIN) { E.fused(acc, cur, wr, wc, fr, fq, lds, wid, lane); S.done(cur); }
#undef PG8_SA
#undef PG8_SB
#undef PG8_STAGE
#undef PG8_LDA
#undef PG8_LDB
#undef PG8_MMA
#undef PG8_WAIT_V
#undef PG8_WAIT_L
#undef PG8_BAR
#undef PG8_SCHED
}
}

constexpr int NWAVES = 8;
constexpr int DM = 2048, NB = 4, SEQ = 2048, CTX = 256, DEPTH = 2, NHEAD = 16, HD = 64, GRIDW = 64, NMOD = 6;
constexpr int RL = NB * SEQ, RC = NB * CTX, RT = RL + RC;
constexpr int SSMW = 1024, NAW = 1024, PW = 8192, DFF = 8192, SG = 64, SP = 64, SC = 16;
constexpr float NORM_EPS = 1e-6f;
constexpr float LOG2E = 1.4426950408889634f;

constexpr size_t MiB = 1u << 20;
constexpr size_t WS_CTL = 0, CTL_ZERO_BYTES = 1 * MiB;
constexpr size_t WS_MOD = 1 * MiB;
constexpr size_t WS_ROPE = 1 * MiB + 512 * 1024;
constexpr size_t WS_W = 2 * MiB, W_LAYER = 116 * MiB;
constexpr size_t WO_IN = 0, WO_VG = 32 * MiB, WO_NA = 40 * MiB, WO_OUT = 44 * MiB, WO_FC1 = 52 * MiB, WO_FC2 = 84 * MiB;
constexpr size_t WS_XA = 234 * MiB;
constexpr size_t WS_H = 306 * MiB;
constexpr size_t WS_PROJ = 342 * MiB;
constexpr size_t PO_U = 0, PO_Q = 18 * MiB, PO_K = 36 * MiB, PO_VTL = 54 * MiB, PO_VTC = 70 * MiB, PO_GS = 72 * MiB, PO_GN = 108 * MiB;
constexpr size_t WS_ACT = 486 * MiB;
constexpr size_t WS_ATT = 504 * MiB;
constexpr size_t WS_TM = 522 * MiB;
constexpr size_t WS_OUT = 558 * MiB;
constexpr size_t WS_SLAB = 630 * MiB;
constexpr size_t WS_END = 694 * MiB;
constexpr int CW_BAR = 4096;

constexpr int RING_BYTES = 131072, MISC_OFF = RING_BYTES + 320, LDS_BYTES = 147456;
constexpr int SCAN_LDS = 17408;
#define GAS __attribute__((address_space(1)))
#define LAS __attribute__((address_space(3)))
typedef unsigned short bf16;
typedef unsigned v4u __attribute__((ext_vector_type(4)));
typedef unsigned v2u __attribute__((ext_vector_type(2)));
typedef float f32x4 __attribute__((ext_vector_type(4)));
typedef float f32x16 __attribute__((ext_vector_type(16)));
typedef short bf16x8 __attribute__((ext_vector_type(8)));
typedef GAS unsigned gu32;
#define RLX_AGENT __ATOMIC_RELAXED, __HIP_MEMORY_SCOPE_AGENT
#define LDS_WAIT() asm volatile("s_waitcnt lgkmcnt(0)" ::: "memory")
#define VM_WAIT() asm volatile("s_waitcnt vmcnt(0)" ::: "memory")
__device__ __forceinline__ unsigned f2bf(float f) { unsigned u = __builtin_bit_cast(unsigned, f); return (u + 0x7fffu + ((u >> 16) & 1u)) >> 16; }
__device__ __forceinline__ unsigned pk2(float lo, float hi) { return f2bf(lo) | (f2bf(hi) << 16); }
__device__ __forceinline__ float bf2f(bf16 v) { return __uint_as_float((unsigned)v << 16); }
__device__ __forceinline__ float wave_sum(float v) {
#pragma unroll
    for (int o = 1; o < 64; o <<= 1) v += __shfl_xor(v, o);
    return v;
}
#define XB_TMO      128
#define XB_XCNT(j)  (256  + 64 * (j))
#define XB_XSUB(j)  (1280 + 64 * (j))
#define XB_XGEN(j)  (2304 + 64 * (j))
#define XB_TOP      3328
#define XB_TOPGEN   3392
#define XCD_BAR_WORDS 3456
#define XB_SPIN_CAP (1u << 18)

__device__ __forceinline__ unsigned xb_ld(unsigned* p)              { return __hip_atomic_load(p, __ATOMIC_RELAXED, __HIP_MEMORY_SCOPE_AGENT); }
__device__ __forceinline__ unsigned xb_add(unsigned* p, unsigned v) { return __hip_atomic_fetch_add(p, v, __ATOMIC_RELAXED, __HIP_MEMORY_SCOPE_AGENT); }
__device__ __forceinline__ unsigned xb_xcc_id() { return (unsigned)__builtin_amdgcn_s_getreg((3 << 11) | 20) & 0xFu; }
#define XB_SPIN(cond, bar) do { unsigned _sp = 0; while (cond) { __builtin_amdgcn_s_sleep(1); \
    if ((++_sp & 255u) == 0u) { if (xb_ld(&(bar)[XB_TMO])) break; if (_sp > XB_SPIN_CAP) { atomicAdd(&(bar)[XB_TMO], 1u); break; } } } } while (0)

struct XcdBarrier {
    unsigned* bar; unsigned x;
    volatile LAS unsigned* st;
};

__device__ __forceinline__ XcdBarrier xcd_barrier_post(unsigned* bar, volatile LAS unsigned* st) {
    XcdBarrier b; b.bar = bar; b.x = xb_xcc_id(); b.st = st;
    if (threadIdx.x == 0) (void)xb_add(&bar[XB_XCNT(b.x)], 1u);
    return b;
}
__device__ __forceinline__ void xcd_barrier_complete(unsigned* bar, unsigned x, unsigned& nloc, unsigned& nx) {
    const unsigned G = gridDim.x * gridDim.y * gridDim.z;
    unsigned sum, cnt, mine, sp = 0u;
    for (;;) {
        sum = 0u; cnt = 0u; mine = 0u;
#pragma unroll
        for (unsigned j = 0; j < 16; ++j) { const unsigned c = xb_ld(&bar[XB_XCNT(j)]); sum += c; cnt += (c > 0u) ? 1u : 0u; mine = (j == x) ? c : mine; }
        if (sum == G) break;
        __builtin_amdgcn_s_sleep(1);
        if ((++sp & 255u) == 0u) { if (xb_ld(&bar[XB_TMO])) break; if (sp > XB_SPIN_CAP) { atomicAdd(&bar[XB_TMO], 1u); break; } }
    }
    nloc = mine > 0u ? mine : 1u; nx = cnt > 0u ? cnt : 1u;
}

__device__ __forceinline__ void xcd_barrier(const XcdBarrier& b) {
    asm volatile("s_waitcnt vmcnt(0)" ::: "memory");
    __syncthreads();
    if (threadIdx.x == 0) {
        unsigned* bar = b.bar;
        __builtin_amdgcn_s_waitcnt(0);
        unsigned nloc = b.st[0], nx = b.st[1];
        if (nloc == 0u) { xcd_barrier_complete(bar, b.x, nloc, nx); b.st[0] = nloc; b.st[1] = nx; }
        const unsigned old = xb_add(&bar[XB_XSUB(b.x)], 1u);
        const unsigned gen = old / nloc;
        if (old + 1u == (gen + 1u) * nloc) {
            __builtin_amdgcn_fence(__ATOMIC_RELEASE, "agent");
            asm volatile("s_waitcnt vmcnt(0)" ::: "memory");
            const unsigned og = xb_add(&bar[XB_TOP], 1u);
            const unsigned tg = og / nx;
            if (og + 1u == (tg + 1u) * nx) xb_add(&bar[XB_TOPGEN], 1u);
            else XB_SPIN(xb_ld(&bar[XB_TOPGEN]) == tg, bar);
            __builtin_amdgcn_fence(__ATOMIC_ACQUIRE, "agent");
            xb_add(&bar[XB_XGEN(b.x)], 1u);
            asm volatile("s_waitcnt vmcnt(0)" ::: "memory");
        } else {
            XB_SPIN(xb_ld(&bar[XB_XGEN(b.x)]) == gen, bar);
            __builtin_amdgcn_fence(__ATOMIC_ACQUIRE, "agent");
            asm volatile("s_waitcnt vmcnt(0)" ::: "memory");
        }
    }
    __syncthreads();
}

__device__ __forceinline__ void p0_transpose_item(const float* W, int K, int N, bf16* WT, int mode, LAS float* scr, int item, int lane) {
    const int nblk = N / 32, kb = item / nblk, nb = item % nblk, k0 = 64 * kb, n0 = 32 * nb;
    float wv[32];
    const float* wp = W + (size_t)(k0 + (lane >> 5)) * N + n0 + (lane & 31);
#pragma unroll
    for (int i = 0; i < 32; ++i) wv[i] = __builtin_nontemporal_load(wp + (size_t)(2 * i) * N);
#pragma unroll
    for (int i = 0; i < 32; ++i) scr[(2 * i + (lane >> 5)) * 33 + (lane & 31)] = wv[i];
    LDS_WAIT(); asm volatile("" ::: "memory");
    const int c = lane & 7;
#pragma unroll
    for (int j = 0; j < 4; ++j) { const int n = (lane >> 3) + 8 * j; const LAS float* s = scr + (8 * c) * 33 + n;
        v4u o; o.x = pk2(s[0 * 33], s[1 * 33]); o.y = pk2(s[2 * 33], s[3 * 33]); o.z = pk2(s[4 * 33], s[5 * 33]); o.w = pk2(s[6 * 33], s[7 * 33]);
        const int ng = n0 + n; const int drow = mode == 0 ? ng : (32 * (ng >> 4) + (ng & 15) + (mode == 2 ? 16 : 0));
        __builtin_nontemporal_store(o, (GAS v4u*)(WT + (size_t)drow * K + k0 + 8 * c)); }
    LDS_WAIT(); asm volatile("" ::: "memory");
}

template <bool HASY, int XOUT, bool HOUT>
__device__ __forceinline__ void rowpass_pipe(int lane, int first, int step, int M, const void* xin, bool xbf, const bf16* yin, void* xout, bf16* hout,
                                             const float* modg, const float* modh, int kss, int ksh, int mr_fixed) {
    int m = first; if (m >= M) return;
    f32x4 xr_[8]; v2u yc[8];
#pragma unroll
    for (int j = 0; j < 8; ++j) { xr_[j] = (f32x4){0.f, 0.f, 0.f, 0.f}; yc[j] = (v2u){0u, 0u}; }
    if (xbf) { const GAS v2u* xb = (const GAS v2u*)((const bf16*)xin + (size_t)m * DM) + lane;
#pragma unroll
        for (int j = 0; j < 8; ++j) { const v2u t = __builtin_nontemporal_load(xb + 64 * j); xr_[j].x = __uint_as_float(t.x); xr_[j].y = __uint_as_float(t.y); } }
    else { const GAS f32x4* xr = (const GAS f32x4*)((const float*)xin + (size_t)m * DM) + lane;
#pragma unroll
        for (int j = 0; j < 8; ++j) xr_[j] = __builtin_nontemporal_load(xr + 64 * j); }
    if (HASY) { const GAS v2u* yb = (const GAS v2u*)(yin + (size_t)m * DM) + lane;
#pragma unroll
        for (int j = 0; j < 8; ++j) yc[j] = __builtin_nontemporal_load(yb + 64 * j); }
    for (;;) {
        const int mn = m + step; const bool hn = mn < M;
        const int mr = mr_fixed >= 0 ? mr_fixed : (m >> 11);
        f32x4 gg[8], sv[8], hv[8];
        if (HASY) { const GAS f32x4* p = (const GAS f32x4*)(modg + (size_t)mr * (NMOD * DM)) + lane;
#pragma unroll
            for (int j = 0; j < 8; ++j) gg[j] = p[64 * j]; }
        f32x4 xn[8]; v2u yn[8];
#pragma unroll
        for (int j = 0; j < 8; ++j) { xn[j] = xr_[j]; yn[j] = yc[j]; }
        if (hn) {
            if (xbf) { const GAS v2u* xb = (const GAS v2u*)((const bf16*)xin + (size_t)mn * DM) + lane;
#pragma unroll
                for (int j = 0; j < 8; ++j) { const v2u t = __builtin_nontemporal_load(xb + 64 * j); xn[j].x = __uint_as_float(t.x); xn[j].y = __uint_as_float(t.y); } }
            else { const GAS f32x4* xr = (const GAS f32x4*)((const float*)xin + (size_t)mn * DM) + lane;
#pragma unroll
                for (int j = 0; j < 8; ++j) xn[j] = __builtin_nontemporal_load(xr + 64 * j); }
            if (HASY) { const GAS v2u* yb = (const GAS v2u*)(yin + (size_t)mn * DM) + lane;
#pragma unroll
                for (int j = 0; j < 8; ++j) yn[j] = __builtin_nontemporal_load(yb + 64 * j); } }
        f32x4 xc[8];
#pragma unroll
        for (int j = 0; j < 8; ++j) { const unsigned w0 = __float_as_uint(xr_[j].x), w1 = __float_as_uint(xr_[j].y);
            xc[j] = xbf ? (f32x4){pg8::bflo(w0), pg8::bfhi(w0), pg8::bflo(w1), pg8::bfhi(w1)} : xr_[j]; }
        if (HASY) { f32x4 yv[8]; float ss = 0.f;
#pragma unroll
            for (int j = 0; j < 8; ++j) { yv[j] = (f32x4){pg8::bflo(yc[j].x), pg8::bfhi(yc[j].x), pg8::bflo(yc[j].y), pg8::bfhi(yc[j].y)};
                ss += (yv[j].x * yv[j].x + yv[j].y * yv[j].y) + (yv[j].z * yv[j].z + yv[j].w * yv[j].w); }
            const float r = 1.0f / sqrtf(wave_sum(ss) * (1.0f / DM) + NORM_EPS);
#pragma unroll
            for (int j = 0; j < 8; ++j) xc[j] = xc[j] + gg[j] * (yv[j] * r); }
        if (XOUT == 1) { GAS f32x4* xo = (GAS f32x4*)((float*)xout + (size_t)m * DM) + lane;
#pragma unroll
            for (int j = 0; j < 8; ++j) __builtin_nontemporal_store(xc[j], xo + 64 * j); }
        if (XOUT == 2) { GAS v2u* xo = (GAS v2u*)((bf16*)xout + (size_t)m * DM) + lane;
#pragma unroll
            for (int j = 0; j < 8; ++j) { v2u w; w.x = pg8::cvt_pk_bf16(xc[j].x, xc[j].y); w.y = pg8::cvt_pk_bf16(xc[j].z, xc[j].w); __builtin_nontemporal_store(w, xo + 64 * j); } }
        if (HOUT) { float ss = 0.f;
            if (HASY) __builtin_amdgcn_sched_barrier(0);
            { const GAS f32x4* p = (const GAS f32x4*)(modh + (size_t)mr * (NMOD * DM) + kss * DM) + lane; const GAS f32x4* q = (const GAS f32x4*)(modh + (size_t)mr * (NMOD * DM) + ksh * DM) + lane;
#pragma unroll
              for (int j = 0; j < 8; ++j) { sv[j] = p[64 * j]; hv[j] = q[64 * j]; } }
#pragma unroll
            for (int j = 0; j < 8; ++j) ss += (xc[j].x * xc[j].x + xc[j].y * xc[j].y) + (xc[j].z * xc[j].z + xc[j].w * xc[j].w);
            const float r = 1.0f / sqrtf(wave_sum(ss) * (1.0f / DM) + NORM_EPS);
            GAS v2u* ho = (GAS v2u*)(hout + (size_t)m * DM) + lane;
#pragma unroll
            for (int j = 0; j < 8; ++j) { const f32x4 h = (xc[j] * r) * sv[j] + hv[j];
                v2u w; w.x = pg8::cvt_pk_bf16(h.x, h.y); w.y = pg8::cvt_pk_bf16(h.z, h.w); __builtin_nontemporal_store(w, ho + 64 * j); } }
        if (!hn) break;
#pragma unroll
        for (int j = 0; j < 8; ++j) { xr_[j] = xn[j]; yc[j] = yn[j]; }
        m = mn;
    }
}
__device__ __forceinline__ void rowpass_ctx8(LAS float* red, int lane, int wave, int vcu, int G, const void* xin, bool xbf, const bf16* slab, bf16* xout, bf16* hout,
                                             const float* gg, const float* sv, const float* hv) {
    for (int base = vcu * 4; base < RC; base += G * 4) {
        const int row = base + (wave >> 1); const size_t off = (size_t)row * DM + (wave & 1) * 1024; const int co = (wave & 1) * 1024;
        f32x4 xv[4], yv[4];
        v2u yb[8][4];
#pragma unroll
        for (int sl = 0; sl < 8; ++sl) { const GAS v2u* ys = (const GAS v2u*)(slab + (size_t)sl * RC * DM + off) + lane;
#pragma unroll
            for (int j = 0; j < 4; ++j) yb[sl][j] = __builtin_nontemporal_load(ys + 64 * j); }
        if (xbf) { const GAS v2u* xb = (const GAS v2u*)((const bf16*)xin + off) + lane;
#pragma unroll
            for (int j = 0; j < 4; ++j) { const v2u t = __builtin_nontemporal_load(xb + 64 * j); xv[j] = (f32x4){pg8::bflo(t.x), pg8::bfhi(t.x), pg8::bflo(t.y), pg8::bfhi(t.y)}; } }
        else { const GAS f32x4* xr = (const GAS f32x4*)((const float*)xin + off) + lane;
#pragma unroll
            for (int j = 0; j < 4; ++j) xv[j] = __builtin_nontemporal_load(xr + 64 * j); }
#pragma unroll
        for (int j = 0; j < 4; ++j) { yv[j] = (f32x4){0.f, 0.f, 0.f, 0.f};
#pragma unroll
            for (int sl = 0; sl < 8; ++sl) yv[j] = yv[j] + (f32x4){pg8::bflo(yb[sl][j].x), pg8::bfhi(yb[sl][j].x), pg8::bflo(yb[sl][j].y), pg8::bfhi(yb[sl][j].y)}; }
        float ss = 0.f;
#pragma unroll
        for (int j = 0; j < 4; ++j) ss += (yv[j].x * yv[j].x + yv[j].y * yv[j].y) + (yv[j].z * yv[j].z + yv[j].w * yv[j].w);
        ss = wave_sum(ss); if (lane == 0) red[wave] = ss;
        LDS_WAIT(); __syncthreads();
        float r = 1.0f / sqrtf((red[wave] + red[wave ^ 1]) * (1.0f / DM) + NORM_EPS);
        const GAS f32x4* gp = (const GAS f32x4*)(gg + co) + lane;
#pragma unroll
        for (int j = 0; j < 4; ++j) xv[j] = xv[j] + gp[64 * j] * (yv[j] * r);
        GAS v2u* xo = (GAS v2u*)(xout + off) + lane;
#pragma unroll
        for (int j = 0; j < 4; ++j) { v2u w; w.x = pg8::cvt_pk_bf16(xv[j].x, xv[j].y); w.y = pg8::cvt_pk_bf16(xv[j].z, xv[j].w); __builtin_nontemporal_store(w, xo + 64 * j); }
        ss = 0.f;
#pragma unroll
        for (int j = 0; j < 4; ++j) ss += (xv[j].x * xv[j].x + xv[j].y * xv[j].y) + (xv[j].z * xv[j].z + xv[j].w * xv[j].w);
        ss = wave_sum(ss); if (lane == 0) red[8 + wave] = ss;
        LDS_WAIT(); __syncthreads();
        r = 1.0f / sqrtf((red[8 + wave] + red[8 + (wave ^ 1)]) * (1.0f / DM) + NORM_EPS);
        const GAS f32x4* sp = (const GAS f32x4*)(sv + co) + lane; const GAS f32x4* hp = (const GAS f32x4*)(hv + co) + lane; GAS v2u* ho = (GAS v2u*)(hout + off) + lane;
#pragma unroll
        for (int j = 0; j < 4; ++j) { const f32x4 h = (xv[j] * r) * sp[64 * j] + hp[64 * j];
            v2u w; w.x = pg8::cvt_pk_bf16(h.x, h.y); w.y = pg8::cvt_pk_bf16(h.z, h.w); __builtin_nontemporal_store(w, ho + 64 * j); }
        LDS_WAIT();
    }
}

#define MFMA32(a, b, c) __builtin_amdgcn_mfma_f32_32x32x16_bf16(a, b, c, 0, 0, 0)
#define MFMA16(a, b, c) __builtin_amdgcn_mfma_f32_16x16x32_bf16(a, b, c, 0, 0, 0)
struct ScanPtrs { const float *lam_re, *lam_im, *log_dt, *b_re, *b_im, *c_re, *c_im, *dsk; const bf16* U; float* YP; bf16* ACT; };

__device__ __forceinline__ void s5_disc(const float* lam_re, const float* lam_im, int ldg, int pp, float dt, float& lbr, float& lbi, float& cr, float& ci) {
    const float lr = lam_re[ldg * 64 + pp], li = lam_im[ldg * 64 + pp];
    const float a = lr * dt, th = li * dt; float sn, cs; sincosf(th, &sn, &cs);
    const float em1 = expm1f(a), mag = em1 + 1.0f; float sh_, ch_; sincosf(0.5f * th, &sh_, &ch_);
    lbr = mag * cs; lbi = mag * sn;
    const float nr = em1 * cs - 2.0f * sh_ * sh_, ni = lbi;
    const float den = 1.0f / (lr * lr + li * li);
    cr = (nr * lr + ni * li) * den; ci = (ni * lr - nr * li) * den;
}
__device__ __forceinline__ float gelu_tanh(float y) { const float z = 0.7978845608028654f * (y + 0.044715f * y * y * y); return y * pg8::sigm(2.0f * z); }

constexpr int SELF_CI = 22;
template <bool REV>
__device__ __forceinline__ void scan_chain(LAS unsigned char* sl, LAS unsigned* flags, int layer, int b, int g, const ScanPtrs P, int lane, bool ctx_out) {
    const int d = REV ? 1 : 0, ldg = (layer * 2 + d) * 64 + g, hh = lane >> 5, l31 = lane & 31;
    const float dt = expf(P.log_dt[ldg]);
    float lb0r, lb0i, c0r, c0i, lb1r, lb1i, c1r, c1i;
    s5_disc(P.lam_re, P.lam_im, ldg, l31, dt, lb0r, lb0i, c0r, c0i);
    s5_disc(P.lam_re, P.lam_im, ldg, 32 + l31, dt, lb1r, lb1i, c1r, c1i);
    const float lr = hh ? lb1r : lb0r, li = hh ? lb1i : lb0i;
    bf16x8 bfr[4];
#pragma unroll
    for (int j = 0; j < 4; ++j) { const int pp = l31 + 32 * (j & 1); const float cr = (j & 1) ? c1r : c0r, ci = (j & 1) ? c1i : c0i;
        const float* br = P.b_re + ((size_t)ldg * 64 + pp) * 16 + 8 * hh; const float* bi = P.b_im + ((size_t)ldg * 64 + pp) * 16 + 8 * hh;
        const f32x4 r0 = *(const f32x4*)br, r1 = *(const f32x4*)(br + 4), i0 = *(const f32x4*)bi, i1 = *(const f32x4*)(bi + 4);
        f32x4 v0, v1; if (j < 2) { v0 = r0 * cr - i0 * ci; v1 = r1 * cr - i1 * ci; } else { v0 = i0 * cr + r0 * ci; v1 = i1 * cr + r1 * ci; }
        v4u w; w.x = pk2(v0.x, v0.y); w.y = pk2(v0.z, v0.w); w.z = pk2(v1.x, v1.y); w.w = pk2(v1.z, v1.w); bfr[j] = __builtin_bit_cast(bf16x8, w); }
    const int cc = lane & 15, kq = lane >> 4;
    bf16x8 cfr[4];
#pragma unroll
    for (int s = 0; s < 4; ++s) { const size_t o = ((size_t)ldg * 16 + cc) * 64 + 16 * s + 4 * kq; const f32x4 re = *(const f32x4*)(P.c_re + o), im = *(const f32x4*)(P.c_im + o);
        v4u w; w.x = pk2(re.x, -im.x); w.y = pk2(re.y, -im.y); w.z = pk2(re.z, -im.z); w.w = pk2(re.w, -im.w); cfr[s] = __builtin_bit_cast(bf16x8, w); }
    LAS unsigned char* SB = sl;
    float sr = 0.f, si = 0.f; int pend0 = -1, pend1 = -1;
    auto rowbase_of = [&](int ci) -> int { if (ci < 4) { const int c4 = REV ? 3 - ci : ci; return RL + b * CTX + c4 * 64; } const int lc = ci - 4, c32 = REV ? 31 - lc : lc; return b * SEQ + c32 * 64; };
    bf16x8 ufr[2], un1[2], un2[2];
    { const int rb = rowbase_of(0), r1 = rowbase_of(1);
#pragma unroll
      for (int i = 0; i < 2; ++i) { ufr[i] = *(const bf16x8*)(P.U + (size_t)(rb + 32 * i + l31) * 1024 + g * 16 + 8 * hh); un1[i] = *(const bf16x8*)(P.U + (size_t)(r1 + 32 * i + l31) * 1024 + g * 16 + 8 * hh); } }
    un2[0] = un1[0]; un2[1] = un1[1];
    const f32x4 dk4 = *(const f32x4*)(P.dsk + layer * 1024 + g * 16 + 4 * kq);
    for (int ci = 0; ci < 36; ++ci) {
        const int rb = rowbase_of(ci);
        const int fidx = ci < 4 ? (REV ? 3 - ci : ci) : 4 + (REV ? 35 - ci : ci - 4);
        const bool selfc = ci >= SELF_CI;
        unsigned long long op[8]; v2u uu[4];
#pragma unroll
        for (int e = 0; e < 4; ++e) { op[2 * e] = 0ull; op[2 * e + 1] = 0ull; uu[e] = (v2u){0u, 0u}; }
        if (selfc) {
            while (__hip_atomic_load(flags + fidx, __ATOMIC_RELAXED, __HIP_MEMORY_SCOPE_WORKGROUP) < 1u) __builtin_amdgcn_s_sleep(2);
            asm volatile("" ::: "memory");
            const size_t eo = (size_t)(rb + cc) * 1024 + g * 16 + 4 * kq;
            const unsigned long long* opp = (const unsigned long long*)(P.YP + (size_t)(1 - d) * RT * 1024 + eo); const bf16* upp = P.U + eo;
#pragma unroll
            for (int f = 0; f < 4; ++f) { op[2 * f] = __hip_atomic_load(opp + (size_t)f * 8192, RLX_AGENT); op[2 * f + 1] = __hip_atomic_load(opp + (size_t)f * 8192 + 1, RLX_AGENT); uu[f] = *(const v2u*)(upp + (size_t)f * 16384); }
        }
        if (ci + 2 < 36) { const int rn = rowbase_of(ci + 2);
#pragma unroll
            for (int i = 0; i < 2; ++i) un2[i] = *(const bf16x8*)(P.U + (size_t)(rn + 32 * i + l31) * 1024 + g * 16 + 8 * hh); }
#pragma unroll
        for (int ib = 0; ib < 2; ++ib) { const int i = REV ? 1 - ib : ib;
            const f32x16 z = {0.f, 0.f, 0.f, 0.f, 0.f, 0.f, 0.f, 0.f, 0.f, 0.f, 0.f, 0.f, 0.f, 0.f, 0.f, 0.f};
            f32x16 x0 = MFMA32(ufr[i], bfr[0], z), x1 = MFMA32(ufr[i], bfr[1], z), x2 = MFMA32(ufr[i], bfr[2], z), x3 = MFMA32(ufr[i], bfr[3], z);
#pragma unroll
            for (int r = 0; r < 16; ++r) {
                auto pa = __builtin_amdgcn_permlane32_swap(__float_as_uint(x0[r]), __float_as_uint(x1[r]), false, false); x0[r] = __uint_as_float(pa[0]); x1[r] = __uint_as_float(pa[1]);
                auto pc = __builtin_amdgcn_permlane32_swap(__float_as_uint(x2[r]), __float_as_uint(x3[r]), false, false); x2[r] = __uint_as_float(pc[0]); x3[r] = __uint_as_float(pc[1]);
            }
#pragma unroll
            for (int k = 0; k < 32; ++k) { const int t = REV ? 31 - k : k; const int tg = (t >> 2) & 1, rg = (t & 3) + 4 * (t >> 3);
                const float xr = tg ? x1[rg] : x0[rg], xi = tg ? x3[rg] : x2[rg];
                const float nr = fmaf(-li, si, fmaf(lr, sr, xr)), ni = fmaf(li, sr, fmaf(lr, si, xi)); sr = nr; si = ni;
                *(LAS unsigned*)(SB + (32 * i + t) * 272 + lane * 4) = pg8::cvt_pk_bf16(sr, si); }
        }
        LDS_WAIT(); asm volatile("" ::: "memory");
        if (ci >= 4 || ctx_out) {
            f32x4 ya[4];
#pragma unroll
            for (int f = 0; f < 4; ++f) { f32x4 a = {0.f, 0.f, 0.f, 0.f};
#pragma unroll
                for (int s = 0; s < 4; ++s) { const bf16x8 af = *(const LAS bf16x8*)(SB + (16 * f + cc) * 272 + (32 * s + 8 * kq) * 2); a = MFMA16(cfr[s], af, a); }
                ya[f] = a; }
            if (!selfc) {
            asm volatile("s_waitcnt vmcnt(6)" ::: "memory");
            if (pend1 >= 0 && lane == 0) (void)__hip_atomic_fetch_add(flags + pend1, 1u, __ATOMIC_RELAXED, __HIP_MEMORY_SCOPE_WORKGROUP);
            pend1 = pend0; pend0 = fidx;
            float* myp = P.YP + ((size_t)d * RT + rb + cc) * 1024 + g * 16 + 4 * kq;
#pragma unroll
            for (int f = 0; f < 4; ++f) *(f32x4*)(myp + (size_t)f * 16384) = ya[f];
            } else {
                VM_WAIT();
                if (lane == 0) { if (pend1 >= 0) (void)__hip_atomic_fetch_add(flags + pend1, 1u, __ATOMIC_RELAXED, __HIP_MEMORY_SCOPE_WORKGROUP);
                                 if (pend0 >= 0) (void)__hip_atomic_fetch_add(flags + pend0, 1u, __ATOMIC_RELAXED, __HIP_MEMORY_SCOPE_WORKGROUP); }
                pend1 = -1; pend0 = -1;
                bf16* ap = P.ACT + (size_t)(rb + cc) * 1024 + g * 16 + 4 * kq;
#pragma unroll
                for (int f = 0; f < 4; ++f) {
                    const float y0 = ya[f][0] + __uint_as_float((unsigned)op[2 * f]) + dk4[0] * pg8::bflo(uu[f].x), y1 = ya[f][1] + __uint_as_float((unsigned)(op[2 * f] >> 32)) + dk4[1] * pg8::bfhi(uu[f].x);
                    const float y2 = ya[f][2] + __uint_as_float((unsigned)op[2 * f + 1]) + dk4[2] * pg8::bflo(uu[f].y), y3 = ya[f][3] + __uint_as_float((unsigned)(op[2 * f + 1] >> 32)) + dk4[3] * pg8::bfhi(uu[f].y);
                    v2u w; w.x = pg8::cvt_pk_bf16(gelu_tanh(y0), gelu_tanh(y1)); w.y = pg8::cvt_pk_bf16(gelu_tanh(y2), gelu_tanh(y3)); *(v2u*)(ap + (size_t)f * 16384) = w; }
            }
        }
        ufr[0] = un1[0]; ufr[1] = un1[1]; un1[0] = un2[0]; un1[1] = un2[1];
    }
    VM_WAIT();
    if (lane == 0) { if (pend1 >= 0) (void)__hip_atomic_fetch_add(flags + pend1, 1u, __ATOMIC_RELAXED, __HIP_MEMORY_SCOPE_WORKGROUP);
                     if (pend0 >= 0) (void)__hip_atomic_fetch_add(flags + pend0, 1u, __ATOMIC_RELAXED, __HIP_MEMORY_SCOPE_WORKGROUP); }
}


__device__ __forceinline__ void scan_combine(const ScanPtrs P, int layer, int b, int g, int fidx, int lane) {
    const int rb = fidx < 4 ? RL + b * CTX + fidx * 64 : b * SEQ + (fidx - 4) * 64;
    const size_t ro = (size_t)(rb + lane) * 1024 + g * 16;
    const unsigned long long* p0 = (const unsigned long long*)(P.YP + ro); const unsigned long long* p1 = (const unsigned long long*)(P.YP + (size_t)RT * 1024 + ro);
    unsigned long long a[8], c[8];
#pragma unroll
    for (int i = 0; i < 8; ++i) { a[i] = __hip_atomic_load(p0 + i, RLX_AGENT); c[i] = __hip_atomic_load(p1 + i, RLX_AGENT); }
    const v4u u0 = *(const v4u*)(P.U + ro), u1 = *(const v4u*)(P.U + ro + 8);
    const unsigned uw[8] = {u0.x, u0.y, u0.z, u0.w, u1.x, u1.y, u1.z, u1.w};
    const float* dk = P.dsk + layer * 1024 + g * 16;
    unsigned ow[8];
#pragma unroll
    for (int i = 0; i < 8; ++i) {
        const float y0 = __uint_as_float((unsigned)a[i]) + __uint_as_float((unsigned)c[i]) + dk[2 * i] * pg8::bflo(uw[i]);
        const float y1 = __uint_as_float((unsigned)(a[i] >> 32)) + __uint_as_float((unsigned)(c[i] >> 32)) + dk[2 * i + 1] * pg8::bfhi(uw[i]);
        ow[i] = pg8::cvt_pk_bf16(gelu_tanh(y0), gelu_tanh(y1)); }
    v4u o0 = {ow[0], ow[1], ow[2], ow[3]}, o1 = {ow[4], ow[5], ow[6], ow[7]};
    *(v4u*)(P.ACT + ro) = o0; *(v4u*)(P.ACT + ro + 8) = o1;
}
struct AttPtrs { const bf16 *Q, *K, *VTl, *VTc; bf16* O; const float* rpb; };
constexpr int ATT_KS = 144, ATT_VS = 80, ATT_TILE = 32 * ATT_KS + 64 * ATT_VS;
struct AttG { v4u k[4], v[4]; };
__device__ __forceinline__ void att_gload(AttG& G, const bf16* kblk, const bf16* vblk, int vstride, int lane) {
#pragma unroll
    for (int i = 0; i < 4; ++i) { G.k[i] = *(const v4u*)(kblk + (size_t)(8 * i + (lane >> 3)) * 1024 + (lane & 7) * 8);
                                  G.v[i] = *(const v4u*)(vblk + (size_t)(16 * i + (lane >> 2)) * vstride + (lane & 3) * 8); }
}
__device__ __forceinline__ void att_lwrite(const AttG& G, LAS unsigned char* tile, int lane) {
#pragma unroll
    for (int i = 0; i < 4; ++i) { *(LAS v4u*)(tile + (8 * i + (lane >> 3)) * ATT_KS + (lane & 7) * 16) = G.k[i];
        LAS unsigned char* vp = tile + 32 * ATT_KS + (16 * i + (lane >> 2)) * ATT_VS + 32 * ((lane & 3) >> 1) + 8 * (lane & 1); v2u lo = {G.v[i].x, G.v[i].y}, hi = {G.v[i].z, G.v[i].w}; *(LAS v2u*)vp = lo; *(LAS v2u*)(vp + 16) = hi; }
}
struct AttF { bf16x8 k[4]; v2u v[8]; };
__device__ __forceinline__ void att_fread(AttF& F, const LAS unsigned char* tile, int lane) {
    const int q = lane & 31, hh = lane >> 5;
#pragma unroll
    for (int ss = 0; ss < 4; ++ss) F.k[ss] = *(const LAS bf16x8*)(tile + q * ATT_KS + (16 * ss + 8 * hh) * 2);
#pragma unroll
    for (int f = 0; f < 2; ++f)
#pragma unroll
        for (int s2 = 0; s2 < 2; ++s2) { const v4u w = *(const LAS v4u*)(tile + 32 * ATT_KS + (32 * f + q) * ATT_VS + 32 * s2 + 16 * hh); F.v[(f * 2 + s2) * 2] = (v2u){w.x, w.y}; F.v[(f * 2 + s2) * 2 + 1] = (v2u){w.z, w.w}; }
}
__device__ __forceinline__ void att_compute(const AttF& B, const bf16x8 (&qf)[4], f32x16& o0, f32x16& o1, float& mrun, float& lrun, bool local, const unsigned (&colb)[4], unsigned rowb) {
    f32x16 s = {0.f, 0.f, 0.f, 0.f, 0.f, 0.f, 0.f, 0.f, 0.f, 0.f, 0.f, 0.f, 0.f, 0.f, 0.f, 0.f};
#pragma unroll
    for (int ss = 0; ss < 4; ++ss) s = MFMA32(B.k[ss], qf[ss], s);
    if (local) {
        float bs[16];
#pragma unroll
        for (int r = 0; r < 16; ++r) bs[r] = *(const LAS float*)(size_t)(((colb[r >> 2] >> (8 * (r & 3))) & 0xffu) + rowb);
#pragma unroll
        for (int r = 0; r < 16; ++r) s[r] += bs[r];
    }
    float bm = s[0];
#pragma unroll
    for (int r = 1; r < 16; ++r) bm = fmaxf(bm, s[r]);
    bm = fmaxf(bm, __shfl_xor(bm, 32));
    if (__any(bm > mrun)) {
        const float mn = fmaxf(mrun, bm), alpha = __builtin_amdgcn_exp2f(mrun - mn); mrun = mn;
        lrun = lrun * alpha; o0 = o0 * alpha; o1 = o1 * alpha;
    }
    float p[16]; float ps = 0.f;
#pragma unroll
    for (int r = 0; r < 16; ++r) { p[r] = __builtin_amdgcn_exp2f(s[r] - mrun); ps += p[r]; }
    lrun += ps;
#pragma unroll
    for (int s2 = 0; s2 < 2; ++s2) { v4u w; w.x = pg8::cvt_pk_bf16(p[8 * s2], p[8 * s2 + 1]); w.y = pg8::cvt_pk_bf16(p[8 * s2 + 2], p[8 * s2 + 3]);
        w.z = pg8::cvt_pk_bf16(p[8 * s2 + 4], p[8 * s2 + 5]); w.w = pg8::cvt_pk_bf16(p[8 * s2 + 6], p[8 * s2 + 7]); const bf16x8 pf = __builtin_bit_cast(bf16x8, w);
        { v4u a = {B.v[s2 * 2].x, B.v[s2 * 2].y, B.v[s2 * 2 + 1].x, B.v[s2 * 2 + 1].y}; o0 = MFMA32(__builtin_bit_cast(bf16x8, a), pf, o0); }
        { v4u a = {B.v[(2 + s2) * 2].x, B.v[(2 + s2) * 2].y, B.v[(2 + s2) * 2 + 1].x, B.v[(2 + s2) * 2 + 1].y}; o1 = MFMA32(__builtin_bit_cast(bf16x8, a), pf, o1); } }
}
__device__ __forceinline__ void att_item(int item, int layer, const AttPtrs P, LAS unsigned char* tile, LAS float* btab, int& tab_head, int lane) {
    const int q = lane & 31, hh = lane >> 5;
    const bool local = item < 4096;
    int b, h, r = 0, half = 0, qrow;
    if (local) { half = item & 1; r = (item >> 1) & 31; h = (item >> 6) & 15; b = item >> 10; qrow = b * SEQ + r * 64 + half * 32 + q; }
    else { const int it = item - 4096; const int qb = it & 7; h = (it >> 3) & 15; b = it >> 7; qrow = RL + b * CTX + qb * 32 + q; }
    if (local && tab_head != h) {
        LDS_WAIT(); asm volatile("" ::: "memory");
        const float* src = P.rpb + ((size_t)layer * NHEAD + h) * 465;
        for (int i = lane; i < 480; i += 64) { const int ro = i >> 5, j = i & 31; btab[i] = j < 31 ? src[ro * 31 + j] * LOG2E : -1e30f; }
        LDS_WAIT(); asm volatile("" ::: "memory");
        tab_head = h;
    }
    bf16x8 qf[4];
#pragma unroll
    for (int s = 0; s < 4; ++s) qf[s] = *(const bf16x8*)(P.Q + (size_t)qrow * 1024 + h * 64 + 16 * s + 8 * hh);
    f32x16 o0 = {0.f, 0.f, 0.f, 0.f, 0.f, 0.f, 0.f, 0.f, 0.f, 0.f, 0.f, 0.f, 0.f, 0.f, 0.f, 0.f}, o1 = o0; float mrun = -1e30f, lrun = 0.f;
    const bf16* vtc = P.VTc + (size_t)(b * 16 + h) * 64 * CTX;
    const bf16* kc = P.K + (size_t)(RL + b * CTX) * 1024 + h * 64;
    int r0 = r - 4; r0 = r0 < 0 ? 0 : (r0 > 24 ? 24 : r0);
    const int c = half * 32 + q; int c0 = c - 8; c0 = c0 < 0 ? 0 : (c0 > 48 ? 48 : c0);
    const bf16* vtl = P.VTl + (size_t)(b * 16 + h) * 64 * SEQ;
    const bf16* kl = P.K + (size_t)(b * SEQ) * 1024 + h * 64;
    unsigned colb0[4] = {0u, 0u, 0u, 0u}, colb1[4] = {0u, 0u, 0u, 0u}; const unsigned tb = (unsigned)(size_t)btab;
#pragma unroll
    for (int rr = 0; rr < 16; ++rr) { const int k0 = (rr & 3) + 8 * (rr >> 2) + 4 * hh, k1 = 32 + k0;
        colb0[rr >> 2] |= (4u * (unsigned)(((unsigned)(k0 - c0) < 16u) ? k0 - c + 15 : 31)) << (8 * (rr & 3)); colb1[rr >> 2] |= (4u * (unsigned)(((unsigned)(k1 - c0) < 16u) ? k1 - c + 15 : 31)) << (8 * (rr & 3)); }
    const int npair = local ? 12 : 4;
    auto gl = [&](AttG& G, int i) { if (i < 8) att_gload(G, kc + (size_t)(32 * i) * 1024, vtc + 32 * i, CTX, lane);
                                    else { const int j = i - 8, t0 = (r0 + (j >> 1)) * 64 + 32 * (j & 1); att_gload(G, kl + (size_t)t0 * 1024, vtl + t0, SEQ, lane); } };
    const int nblk = 2 * npair;
    AttG G; gl(G, 0);
    att_lwrite(G, tile, lane);
    gl(G, 1);
    for (int p = 0; p < npair; ++p) {
        const bool loc = p >= 4; const unsigned rowb = tb + (loc ? (unsigned)((r0 + (p - 4) - r + 7) * 128) : 0u);
        { AttF F; LDS_WAIT(); asm volatile("" ::: "memory"); att_fread(F, tile, lane); LDS_WAIT(); asm volatile("" ::: "memory");
          att_lwrite(G, tile, lane); gl(G, 2 * p + 2 < nblk ? 2 * p + 2 : nblk - 1);
          att_compute(F, qf, o0, o1, mrun, lrun, loc, colb0, rowb); }
        { AttF F; LDS_WAIT(); asm volatile("" ::: "memory"); att_fread(F, tile, lane); LDS_WAIT(); asm volatile("" ::: "memory");
          att_lwrite(G, tile, lane); gl(G, 2 * p + 3 < nblk ? 2 * p + 3 : nblk - 1);
          att_compute(F, qf, o0, o1, mrun, lrun, loc, colb1, rowb); }
    }
    const float inv = 1.0f / (lrun + __shfl_xor(lrun, 32));
    bf16* op = P.O + (size_t)qrow * 1024 + h * 64 + 4 * hh;
#pragma unroll
    for (int g4 = 0; g4 < 4; ++g4) {
        v2u w0, w1; w0.x = pg8::cvt_pk_bf16(o0[4 * g4] * inv, o0[4 * g4 + 1] * inv); w0.y = pg8::cvt_pk_bf16(o0[4 * g4 + 2] * inv, o0[4 * g4 + 3] * inv);
        w1.x = pg8::cvt_pk_bf16(o1[4 * g4] * inv, o1[4 * g4 + 1] * inv); w1.y = pg8::cvt_pk_bf16(o1[4 * g4 + 2] * inv, o1[4 * g4 + 3] * inv);
        *(v2u*)(op + 8 * g4) = w0; *(v2u*)(op + 32 + 8 * g4) = w1; }
}

#ifndef REPEAT_MASK
#define REPEAT_MASK 0
#endif
#ifndef PROBE_SCAN_REP
#define PROBE_SCAN_REP 1
#endif
#ifndef PROBE_ATT_REP
#define PROBE_ATT_REP 1
#endif
#ifndef PHASE_MASK
#define PHASE_MASK 2047
#endif
constexpr int NPH = 2 + 9 * DEPTH;
struct Args { const float* in[26]; float* out; unsigned char* ws; int ph_lo, ph_hi, use_bar, pad; };
typedef const __attribute__((address_space(4))) Args* KArgs;
#define KARGS(ka) KArgs ka = (KArgs)__builtin_amdgcn_kernarg_segment_ptr(); asm volatile("" : "+s"(ka))

constexpr int I_IN = (DM / 64) * (PW / 32), I_VG = (SSMW / 64) * (DM / 32), I_NA = (NAW / 64) * (DM / 32), I_OUT = (DM / 64) * (DM / 32), I_F1 = (DM / 64) * (DFF / 32), I_F2 = (DFF / 64) * (DM / 32);
constexpr int I_MIX = I_IN + 2 * I_VG + I_NA + I_OUT, I_LAYER = I_MIX + I_F1 + I_F2;
__device__ __forceinline__ void conv_item(KArgs ka, unsigned char* ws, int l, int r, LAS float* scr, int lane) {
    unsigned char* wb = ws + WS_W + (size_t)l * W_LAYER;
    const float* src; int K, N, mode; size_t wo;
    if (r < I_IN) { src = ka->in[10] + (size_t)l * DM * PW; K = DM; N = PW; mode = 0; wo = WO_IN; }
    else if ((r -= I_IN) < I_VG) { src = ka->in[19] + (size_t)l * SSMW * DM; K = SSMW; N = DM; mode = 1; wo = WO_VG; }
    else if ((r -= I_VG) < I_VG) { src = ka->in[20] + (size_t)l * SSMW * DM; K = SSMW; N = DM; mode = 2; wo = WO_VG; }
    else if ((r -= I_VG) < I_NA) { src = ka->in[22] + (size_t)l * NAW * DM; K = NAW; N = DM; mode = 0; wo = WO_NA; }
    else if ((r -= I_NA) < I_OUT) { src = ka->in[23] + (size_t)l * DM * DM; K = DM; N = DM; mode = 0; wo = WO_OUT; }
    else if ((r -= I_OUT) < I_F1) { src = ka->in[24] + (size_t)l * DM * DFF; K = DM; N = DFF; mode = 0; wo = WO_FC1; }
    else { r -= I_F1; src = ka->in[25] + (size_t)l * DFF * DM; K = DFF; N = DM; mode = 0; wo = WO_FC2; }
    p0_transpose_item(src, K, N, (bf16*)(wb + wo), mode, scr, r, lane);
}

__device__ __forceinline__ void mod_gemv_items(KArgs ka, unsigned char* ws, LAS unsigned char* lds, int tid, int lane, int wave, int it0, int it1, int step) {
        {
            const float* c_in = ka->in[1]; const float* cctx_in = ka->in[3]; const float* w_mod = ka->in[4]; const float* b_mod = ka->in[5]; float* MOD = (float*)(ws + WS_MOD);
            LAS float* SIL = (LAS float*)(lds + 71680); LAS float* PART = (LAS float*)(lds + 112640);
            for (int i = tid; i < 5 * DM; i += NWAVES * 64) { const int r = i >> 11, k = i & 2047; const float v = r < 4 ? c_in[r * DM + k] : cctx_in[k]; SIL[i] = v / (1.0f + expf(-v)); }
            __syncthreads();
            for (int it = it0; it < it1; it += step) {
                const int l = it / 192, jn = it % 192, col = jn * 64 + lane, k0 = wave * 256;
                const float* W = w_mod + (size_t)l * DM * (NMOD * DM) + (size_t)k0 * (NMOD * DM) + col;
                float a0 = 0.f, a1 = 0.f, a2 = 0.f, a3 = 0.f, a4 = 0.f;
                for (int kk = 0; kk < 256; kk += 16) {
                    float wv[16];
#pragma unroll
                    for (int e = 0; e < 16; ++e) wv[e] = __builtin_nontemporal_load(W + (size_t)(kk + e) * (NMOD * DM));
#pragma unroll
                    for (int q4 = 0; q4 < 4; ++q4) { const int ko = k0 + kk + 4 * q4; const float w0 = wv[4 * q4], w1 = wv[4 * q4 + 1], w2 = wv[4 * q4 + 2], w3 = wv[4 * q4 + 3];
                        const f32x4 s0 = *(const LAS f32x4*)(SIL + 0 * DM + ko), s1 = *(const LAS f32x4*)(SIL + 1 * DM + ko), s2 = *(const LAS f32x4*)(SIL + 2 * DM + ko),
                                    s3 = *(const LAS f32x4*)(SIL + 3 * DM + ko), s4 = *(const LAS f32x4*)(SIL + 4 * DM + ko);
                        a0 += s0.x * w0 + s0.y * w1 + s0.z * w2 + s0.w * w3; a1 += s1.x * w0 + s1.y * w1 + s1.z * w2 + s1.w * w3; a2 += s2.x * w0 + s2.y * w1 + s2.z * w2 + s2.w * w3;
                        a3 += s3.x * w0 + s3.y * w1 + s3.z * w2 + s3.w * w3; a4 += s4.x * w0 + s4.y * w1 + s4.z * w2 + s4.w * w3; }
                }
                PART[(wave * 5 + 0) * 64 + lane] = a0; PART[(wave * 5 + 1) * 64 + lane] = a1; PART[(wave * 5 + 2) * 64 + lane] = a2; PART[(wave * 5 + 3) * 64 + lane] = a3; PART[(wave * 5 + 4) * 64 + lane] = a4;
                __syncthreads();
                if (wave < 5) { float s = b_mod[l * (NMOD * DM) + col];
#pragma unroll
                    for (int w = 0; w < 8; ++w) s += PART[(w * 5 + wave) * 64 + lane];
                    const int kidx = jn >> 5, c = col & (DM - 1);
                    if (kidx == 1) s = ka->in[6][l * DM + c] * (1.0f + s); else if (kidx == 2) s *= ka->in[7][l * DM + c];
                    else if (kidx == 4) s = ka->in[8][l * DM + c] * (1.0f + s); else if (kidx == 5) s *= ka->in[9][l * DM + c];
                    MOD[(size_t)(l * 5 + wave) * (NMOD * DM) + col] = s; }
                __syncthreads();
            }
        }
}
#define IDLE_COPY(nun, cl, lo_, hi_) do { const int first_ = (nun) % G; if (first_ != 0 && bx >= first_) { const int nid_ = G - first_, j_ = bx - first_, per_ = ((hi_) - (lo_) + nid_ - 1) / nid_; \
        const int a_ = (lo_) + j_ * per_, b_ = (a_ + per_ < (hi_)) ? a_ + per_ : (hi_); LAS float* scr_ = (LAS float*)(lds + wave * 8704); \
        for (int it_ = a_ + wave; it_ < b_; it_ += NWAVES) conv_item(ka, ws, cl, it_, scr_, lane); } } while (0)
__global__ void __launch_bounds__(NWAVES * 64, 2) mega_fwd(Args args_unused) {
    extern __shared__ __attribute__((aligned(16))) unsigned char lds_raw[];
    LAS unsigned char* lds = (LAS unsigned char*)lds_raw;
    const int tid0 = threadIdx.x, wave = __builtin_amdgcn_readfirstlane(tid0 >> 6);
    const int G = gridDim.x, bx = blockIdx.x;
    const int vcu = (G % 8 == 0) ? (bx % 8) * (G / 8) + bx / 8 : bx;
    const int gw = vcu * NWAVES + wave, NGW = G * NWAVES;
    for (int u = tid0; u < (LDS_BYTES - RING_BYTES) / 4; u += NWAVES * 64) ((LAS unsigned*)(lds + RING_BYTES))[u] = 0u;
    __syncthreads();
    int lo, hi, use_bar;
    { KARGS(ka); lo = ka->ph_lo; hi = ka->ph_hi; use_bar = ka->use_bar;
      if (use_bar) (void)xcd_barrier_post((unsigned*)(ka->ws + WS_CTL) + CW_BAR, (volatile LAS unsigned*)(lds + MISC_OFF) + 8); }
    for (int ph = lo; ph < hi; ++ph) {
    const int l = ph >= 2 ? (ph - 2) / 9 : 0, pk = ph >= 2 ? (ph - 2) % 9 : -1; const bool last = (l == DEPTH - 1);
    const int Mrows = last ? RL : RT;
    const int pbit = ph == 0 ? 512 : (ph == 1 ? 1024 : (1 << pk)); const int nrep = (REPEAT_MASK & pbit) ? 2 : 1;
    for (int rep = 0; rep < nrep; ++rep) {
    int tid = threadIdx.x; asm volatile("" : "+v"(tid)); const int lane = tid & 63;
    if (ph == 0 && (PHASE_MASK & 512)) {
        KARGS(ka); unsigned char* ws = ka->ws;
        {
            mod_gemv_items(ka, ws, lds, tid, lane, wave, bx, 192, G);
            float* ROPE = (float*)(ws + WS_ROPE);
            if (bx == G - 1) for (int i = tid; i < 64 * 16; i += NWAVES * 64) { const int pos = i >> 4, f = i & 15; const float inv = powf(10000.0f, -(float)f / 16.0f); const float ang = (float)pos * inv;
                float sn, cs; sincosf(ang, &sn, &cs); ROPE[2 * i] = cs; ROPE[2 * i + 1] = sn; }
        }
        LAS float* scr = (LAS float*)(lds + wave * 8704);
        for (int it = gw; it < I_MIX; it += NGW) conv_item(ka, ws, 0, it, scr, lane);
    }
    else if (ph == 1 && (PHASE_MASK & 1024)) {
        KARGS(ka); unsigned char* ws = ka->ws; const float* x_in = ka->in[0]; const float* ctx_in = ka->in[2];
        const float* MOD = (const float*)(ws + WS_MOD); bf16* H = (bf16*)(ws + WS_H);
        rowpass_pipe<false, 0, true>(lane, gw, NGW, RL, x_in, false, nullptr, nullptr, H, nullptr, MOD, 1, 0, -1);
        rowpass_pipe<false, 0, true>(lane, (gw & 1) ? RC : (gw >> 1), NGW / 2, RC, ctx_in, false, nullptr, nullptr, H + (size_t)RL * DM, nullptr, MOD, 1, 0, 4);
    }
    else {
        if (pk == 0 && (PHASE_MASK & 1)) {
            KARGS(ka); unsigned char* ws = ka->ws; unsigned char* wb = ws + WS_W + (size_t)l * W_LAYER; unsigned char* pj = ws + WS_PROJ;
            pg8::Gemm g{(const bf16*)(ws + WS_H), (const bf16*)(wb + WO_IN), RT, PW, DM};
            pg8::EpiIn E{(bf16*)(pj + PO_U), (bf16*)(pj + PO_Q), (bf16*)(pj + PO_K), (bf16*)(pj + PO_VTL), (bf16*)(pj + PO_VTC), (bf16*)(pj + PO_GS), (bf16*)(pj + PO_GN), (const float*)(ws + WS_ROPE)};
            if (!last) { pg8::StaticOrder S; S.init(RT, PW, G, bx); pg8::gemm_phase<pg8::EpiIn, pg8::StaticOrder, true, true>(lds, g, S, E); IDLE_COPY((RT / 256) * (PW / 256), 0, I_MIX, I_LAYER); }
            else { pg8::OrderL1In S; S.init(RL, PW, G, bx); pg8::gemm_phase<pg8::EpiIn, pg8::OrderL1In, true, true>(lds, g, S, E); IDLE_COPY((RL / 256) * (PW / 256) + 48, 1, I_MIX, I_LAYER); }
        }
        else if (pk == 1 && (PHASE_MASK & 2)) {
            KARGS(ka); unsigned char* ws = ka->ws; unsigned char* pj = ws + WS_PROJ;
            const ScanPtrs SPp{ka->in[11], ka->in[12], ka->in[13], ka->in[14], ka->in[15], ka->in[16], ka->in[17], ka->in[18], (const bf16*)(pj + PO_U), (float*)(ws + WS_OUT), (bf16*)(ws + WS_ACT)};
            LAS unsigned* flagb = (LAS unsigned*)(lds + MISC_OFF) + 16;
            if (tid < 320) flagb[tid] = 0u;
            if (tid == 0) ((LAS unsigned*)(lds + MISC_OFF))[12] = 0u;
            LDS_WAIT(); __syncthreads();
            LAS unsigned* cctr = (LAS unsigned*)(lds + MISC_OFF) + 12;
            if (wave < 2) {
                __builtin_amdgcn_s_setprio(3);
                LAS unsigned char* sl = lds + wave * SCAN_LDS; int iter = 0;
                for (int rp = 0; rp < PROBE_SCAN_REP; ++rp)
                for (int pair = bx; pair < NB * SG; pair += G, ++iter) {
                    LAS unsigned* flags = flagb + (iter & 7) * 40;
                    if (wave == 0) scan_chain<false>(sl, flags, l, pair >> 6, pair & 63, SPp, lane, !last);
                    else scan_chain<true>(sl, flags, l, pair >> 6, pair & 63, SPp, lane, !last);
                }
                __builtin_amdgcn_s_setprio(0);
            } else {
                LAS unsigned char* tile = lds + 2 * SCAN_LDS + (wave - 2) * ATT_TILE;
                {
                    const AttPtrs AP{(const bf16*)(pj + PO_Q), (const bf16*)(pj + PO_K), (const bf16*)(pj + PO_VTL), (const bf16*)(pj + PO_VTC), (bf16*)(ws + WS_ATT), ka->in[21]};
                    LAS float* btab = (LAS float*)(lds + 2 * SCAN_LDS + 6 * ATT_TILE + (wave - 2) * 2048); int tab_head = -1;
                    const int ipp = last ? 64 : 72, nq = 8 * ipp, xg = bx & 7, slot = (bx >> 3) * 6 + (wave - 2), nslot = (G >> 3) * 6;
                    const int ncl = last ? 4 : 8; int cpair = bx, citer = 0, cli = wave - 2;
                    for (int q = slot; ; q += nslot) {
                        const bool have = q < nq;
                        if (have) { const int pid = xg * 8 + q / ipp, w = q % ipp;
                            att_item(w < 64 ? pid * 64 + w : 4096 + pid * 8 + (w - 64), l, AP, tile, btab, tab_head, lane); }
                        while (cpair < NB * SG) {
                            if (cli >= ncl) { cli = wave - 2; cpair += G; ++citer; continue; }
                            const int cfc = last ? 18 + cli : (cli < 4 ? cli : 14 + cli);
                            volatile LAS unsigned* flags = (volatile LAS unsigned*)(flagb + (citer & 7) * 40);
                            if (flags[cfc] < 2u) { if (have) break;
                                unsigned spins = 0; while (flags[cfc] < 2u && ++spins < (1u << 24)) __builtin_amdgcn_s_sleep(8); }
                            asm volatile("" ::: "memory");
                            scan_combine(SPp, l, cpair >> 6, cpair & 63, cfc, lane);
                            cli += 6;
                        }
                        if (!have) break;
                    }
                }
            }
            __syncthreads();
        }
        else if (pk == 2 && (PHASE_MASK & 4)) {
            KARGS(ka); unsigned char* ws = ka->ws; unsigned char* wb = ws + WS_W + (size_t)l * W_LAYER;
            pg8::Gemm g{(const bf16*)(ws + WS_ACT), (const bf16*)(wb + WO_VG), Mrows, 2 * DM, SSMW}; pg8::StaticOrder S; S.init(Mrows, 2 * DM, G, bx);
            pg8::EpiD1 E{(const bf16*)(ws + WS_PROJ + PO_GS), (bf16*)(ws + WS_TM)};
            pg8::gemm_phase<pg8::EpiD1, pg8::StaticOrder, true, true>(lds, g, S, E);
            if (!last) { const int first = ((Mrows / 256) * (2 * DM / 256)) % G; if (first != 0 && bx >= first) mod_gemv_items(ka, ws, lds, tid, lane, wave, 192 + bx - first, 2 * 192, G - first); else if (first == 0) mod_gemv_items(ka, ws, lds, tid, lane, wave, 192 + bx, 2 * 192, G); }
        }
        else if (pk == 3 && (PHASE_MASK & 8)) {
            KARGS(ka); unsigned char* ws = ka->ws; unsigned char* wb = ws + WS_W + (size_t)l * W_LAYER;
            pg8::Gemm g{(const bf16*)(ws + WS_ATT), (const bf16*)(wb + WO_NA), Mrows, DM, NAW}; pg8::StaticOrder S; S.init(Mrows, DM, G, bx);
            pg8::EpiD2 E{(const bf16*)(ws + WS_PROJ + PO_GN), (bf16*)(ws + WS_TM)};
            pg8::gemm_phase<pg8::EpiD2, pg8::StaticOrder, true, true>(lds, g, S, E);
        }
        else if (pk == 4 && (PHASE_MASK & 16)) {
            KARGS(ka); unsigned char* ws = ka->ws; unsigned char* wb = ws + WS_W + (size_t)l * W_LAYER;
            pg8::Gemm g{(const bf16*)(ws + WS_TM), (const bf16*)(wb + WO_OUT), Mrows, DM, DM}; pg8::OrderSplitCtx S; S.init(RL, DM, G, bx); S.ksl = DM / 64 / 8; S.nctx = last ? 0 : 256;
            pg8::EpiF32S E{(bf16*)(ws + WS_OUT), (bf16*)(ws + WS_SLAB)};
            pg8::gemm_phase<pg8::EpiF32S, pg8::OrderSplitCtx, true, true>(lds, g, S, E);
        }
        else if ((pk == 5 && (PHASE_MASK & 32)) || (pk == 8 && (PHASE_MASK & 256))) {
            KARGS(ka); unsigned char* ws = ka->ws; const bool r2 = pk == 8;
            const float* mdl = (const float*)(ws + WS_MOD) + (size_t)(l * 5) * (NMOD * DM); const float* modg = mdl + (r2 ? 5 : 2) * DM;
            const float* modh = r2 ? mdl + (size_t)5 * (NMOD * DM) : mdl; const int kss = r2 ? 1 : 4, ksh = r2 ? 0 : 3;
            bf16* H = (bf16*)(ws + WS_H); bf16* XA = (bf16*)(ws + WS_XA); const bool xf = !r2 && l == 0;
            if (!last) rowpass_ctx8((LAS float*)(lds + MISC_OFF + 4096), lane, wave, vcu, G, xf ? (const void*)ka->in[2] : (const void*)(XA + (size_t)RL * DM), !xf, (const bf16*)(ws + WS_SLAB), XA + (size_t)RL * DM, H + (size_t)RL * DM,
                                    modg + (size_t)4 * (NMOD * DM), modh + (size_t)4 * (NMOD * DM) + kss * DM, modh + (size_t)4 * (NMOD * DM) + ksh * DM);
            if (!(r2 && last)) rowpass_pipe<true, 2, true>(lane, gw, NGW, RL, xf ? (const void*)ka->in[0] : (const void*)XA, !xf, (const bf16*)(ws + WS_OUT), XA, H, modg, modh, kss, ksh, -1);
            else rowpass_pipe<true, 1, false>(lane, gw, NGW, RL, XA, true, (const bf16*)(ws + WS_OUT), ka->out, nullptr, modg, nullptr, 0, 0, -1);
        }
        else if (pk == 6 && (PHASE_MASK & 64)) {
            KARGS(ka); unsigned char* ws = ka->ws; unsigned char* wb = ws + WS_W + (size_t)l * W_LAYER;
            pg8::Gemm g{(const bf16*)(ws + WS_H), (const bf16*)(wb + WO_FC1), Mrows, DFF, DM}; pg8::StaticOrder S; S.init(Mrows, DFF, G, bx);
            pg8::EpiRelu2 E{(bf16*)(ws + WS_PROJ), DFF};
            pg8::gemm_phase<pg8::EpiRelu2, pg8::StaticOrder, true, true>(lds, g, S, E);
            if (!last) IDLE_COPY((RT / 256) * (DFF / 256), 1, 0, I_MIX);
        }
        else if (pk == 7 && (PHASE_MASK & 128)) {
            KARGS(ka); unsigned char* ws = ka->ws; unsigned char* wb = ws + WS_W + (size_t)l * W_LAYER;
            pg8::Gemm g{(const bf16*)(ws + WS_PROJ), (const bf16*)(wb + WO_FC2), Mrows, DM, DFF}; pg8::OrderSplitCtx S; S.init(RL, DM, G, bx); S.ksl = DFF / 64 / 8; S.nctx = last ? 0 : 256;
            pg8::EpiF32S E{(bf16*)(ws + WS_OUT), (bf16*)(ws + WS_SLAB)};
            pg8::gemm_phase<pg8::EpiF32S, pg8::OrderSplitCtx, true, true>(lds, g, S, E);
        }
    }
    }
    if (ph + 1 < hi && use_bar) {
        KARGS(kb); XcdBarrier b2; b2.bar = (unsigned*)(kb->ws + WS_CTL) + CW_BAR; b2.x = xb_xcc_id(); b2.st = (volatile LAS unsigned*)(lds + MISC_OFF) + 8;
        xcd_barrier(b2);
    }
    }
}

extern "C" void kernel_launch(void* const* d_in, const int* in_sizes, int n_in, void* d_out, int out_size, void* d_ws, size_t ws_size, hipStream_t stream) {
    static int grid = 0;
    if (grid == 0) {
        if (n_in != 26 || in_sizes[0] != RL * DM || out_size != RL * DM || ws_size < WS_END) { fprintf(stderr, "kernel_launch: unexpected shapes / workspace (n_in %d, in0 %d, out %d, ws %zu < %zu); nothing launched\n", n_in, n_in > 0 ? in_sizes[0] : -1, out_size, ws_size, (size_t)WS_END); grid = -1; return; }
        int dev = 0, cus = 0, per_cu = 0;
        if (hipGetDevice(&dev) != hipSuccess || hipDeviceGetAttribute(&cus, hipDeviceAttributeMultiprocessorCount, dev) != hipSuccess) { grid = -1; return; }
        if (hipFuncSetAttribute((const void*)mega_fwd, hipFuncAttributeMaxDynamicSharedMemorySize, LDS_BYTES) != hipSuccess) { fprintf(stderr, "kernel_launch: hipFuncSetAttribute failed\n"); grid = -1; return; }
        if (hipOccupancyMaxActiveBlocksPerMultiprocessor(&per_cu, (const void*)mega_fwd, NWAVES * 64, LDS_BYTES) != hipSuccess || per_cu < 1) { fprintf(stderr, "kernel_launch: occupancy query says %d blocks per CU; nothing launched\n", per_cu); (void)hipGetLastError(); grid = -1; return; }
        grid = cus;
    }
    if (grid < 0) return;
    (void)hipMemsetAsync((char*)d_ws + WS_CTL, 0, CTL_ZERO_BYTES, stream);
    Args a{};
    for (int i = 0; i < 26; ++i) a.in[i] = (const float*)d_in[i];
    a.out = (float*)d_out; a.ws = (unsigned char*)d_ws;
#if MK_PER_PHASE
    for (int p = 0; p < NPH; ++p) { a.ph_lo = p; a.ph_hi = p + 1; a.use_bar = 0; a.pad = 0; hipLaunchKernelGGL(mega_fwd, dim3(grid), dim3(NWAVES * 64), LDS_BYTES, stream, a); }
#else
    a.ph_lo = 0; a.ph_hi = NPH; a.use_bar = 1; a.pad = 0;
    hipLaunchKernelGGL(mega_fwd, dim3(grid), dim3(NWAVES * 64), LDS_BYTES, stream, a);
#endif
}
```

```cpp
#include <hip/hip_runtime.h>
#include <cstdio>
#include <cstdint>
#ifndef MK_PER_PHASE
#define MK_PER_PHASE 0
#endif
namespace pg8 {
#define PG8_LAS __attribute__((address_space(3)))
typedef unsigned short bf16_t;
typedef short bf16x8 __attribute__((ext_vector_type(8)));
typedef float f32x4 __attribute__((ext_vector_type(4)));
typedef unsigned u32x4 __attribute__((ext_vector_type(4)));
constexpr int BM = 256, BK = 64, HALF = 128, HTB = HALF * BK * 2  , STAGE_BYTES = 8 * HTB, NXCD = 8, WGM = 8;

__host__ __device__ __forceinline__ int lds_byte(int r, int c) { const int st = (r >> 4) * 2 + (c >> 5), rr = r & 15, cc = c & 31, ob = rr * 64 + cc * 2; return st * 1024 + (ob ^ (((ob >> 9) & 1) << 5)); }
__host__ __device__ __forceinline__ void stage_rc(int b, int& R, int& C) { const int st = b / 1024, sb = b % 1024, swz = sb ^ (((sb >> 9) & 1) << 5); R = (st >> 1) * 16 + swz / 64; C = (st & 1) * 32 + (swz % 64) / 2; }
__host__ __device__ __forceinline__ int perm32(int rho) { const int n = rho >> 4, i = rho & 15; return 8 * (i >> 2) + 4 * n + (i & 3); }

struct Unit { int pm, pn, nt, ks; };
struct Gemm { const bf16_t* A; const bf16_t* Bt; int M, N, K; };

struct StaticOrder {
    int nM, nN, nwg, G, c;
    __host__ __device__ void init(int M, int N, int G_, int c_) { nM = M / BM; nN = N / BM; nwg = nM * nN; G = G_; c = c_; }
    __host__ __device__ __forceinline__ bool next(int i, Unit& u, int ntdef) const {
        u.nt = ntdef; u.ks = 0; u.pm = 0; u.pn = 0;
        const long L = (long)i * G + c; if (L >= nwg) return false;
        int wgid = (int)L; { const int q = nwg / NXCD, r = nwg % NXCD, xcd = wgid % NXCD, off = wgid / NXCD; wgid = (xcd < r ? xcd * (q + 1) : r * (q + 1) + (xcd - r) * q) + off; }
        const int nig = WGM * nN, gid = wgid / nig, fm = gid * WGM, gsz = (nM - fm) < WGM ? (nM - fm) : WGM;
        u.pm = fm + ((wgid % nig) % gsz); u.pn = (wgid % nig) / gsz; return true;
    }
    __device__ __forceinline__ void a_ready(const Unit&) const {}
    __device__ __forceinline__ void done(const Unit&) const {}
};


__device__ __forceinline__ unsigned cvt_pk_bf16(float lo, float hi) { unsigned r; asm volatile("v_cvt_pk_bf16_f32 %0, %1, %2" : "=v"(r) : "v"(lo), "v"(hi)); return r; }
typedef unsigned u32x2 __attribute__((ext_vector_type(2)));
__device__ __forceinline__ float sigm(float x) { return __builtin_amdgcn_rcpf(1.0f + __builtin_amdgcn_exp2f(-1.4426950408889634f * x)); }
__device__ __forceinline__ float bflo(unsigned w) { return __uint_as_float(w << 16); }
__device__ __forceinline__ float bfhi(unsigned w) { return __uint_as_float(w & 0xffff0000u); }
__device__ __forceinline__ u32x2 pack4(f32x4 v) { u32x2 w; w.x = cvt_pk_bf16(v[0], v[1]); w.y = cvt_pk_bf16(v[2], v[3]); return w; }

constexpr float QSCALE = 0.125f * 1.4426950408889634f;

struct EpiIn {
    static constexpr bool PERM = false, AFTER_DRAIN = false;
    bf16_t *U, *Q, *Kb, *VTl, *VTc, *GS, *GN; const float* rope;
    __device__ __forceinline__ void operator()(const f32x4 (&acc)[2][2][4][2], const Unit& u, int wr, int wc, int fr, int fq) const {
        const int pn = u.pn; const bool lat = u.pm < 32;
        const int row0 = u.pm * BM + wr * 64 + fr;
        if (pn < 4 || pn >= 16) {
            bf16_t* base; int ld, colt; bool sg;
            if (pn < 4) { base = U; ld = 1024; colt = pn * 256; sg = false; }
            else if (pn < 24) { base = GS; ld = 2048; colt = (pn - 16) * 256; sg = true; }
            else { base = GN; ld = 2048; colt = (pn - 24) * 256; sg = true; }
            const int col0 = colt + wc * 32 + 4 * fq;
#pragma unroll
            for (int ai = 0; ai < 2; ++ai)
#pragma unroll
                for (int m = 0; m < 4; ++m) { bf16_t* rowp = base + (size_t)(row0 + ai * HALF + m * 16) * ld + col0;
#pragma unroll
                    for (int bj = 0; bj < 2; ++bj)
#pragma unroll
                        for (int n = 0; n < 2; ++n) { f32x4 v = acc[ai][bj][m][n];
                            if (sg) { v[0] = sigm(v[0]); v[1] = sigm(v[1]); v[2] = sigm(v[2]); v[3] = sigm(v[3]); }
                            *(u32x2*)(rowp + bj * HALF + n * 16) = pack4(v); } }
        } else if (pn < 12) {
            const bool isq = pn < 8; bf16_t* base = isq ? Q : Kb; const int colt = (pn - (isq ? 4 : 8)) * 256;
            const float sc = isq ? QSCALE : 1.0f; const int col0 = colt + wc * 32 + 4 * fq; const int colsel = wc & 1;
#pragma unroll
            for (int ai = 0; ai < 2; ++ai)
#pragma unroll
                for (int m = 0; m < 4; ++m) { const int row = row0 + ai * HALF + m * 16; bf16_t* rowp = base + (size_t)row * 1024 + col0;
                    f32x4 cA = (f32x4){1.f, 0.f, 1.f, 0.f}, cB = cA;
                    if (lat) { const int t = row & 2047, pos = colsel ? (t & 63) : (t >> 6); const f32x4* rp = (const f32x4*)(rope + (pos * 16 + 4 * fq) * 2); cA = rp[0]; cB = rp[1]; }
#pragma unroll
                    for (int bj = 0; bj < 2; ++bj) { const f32x4 x1 = acc[ai][bj][m][0], x2 = acc[ai][bj][m][1]; f32x4 o1, o2;
                        o1[0] = x1[0] * cA[0] - x2[0] * cA[1]; o2[0] = x1[0] * cA[1] + x2[0] * cA[0];
                        o1[1] = x1[1] * cA[2] - x2[1] * cA[3]; o2[1] = x1[1] * cA[3] + x2[1] * cA[2];
                        o1[2] = x1[2] * cB[0] - x2[2] * cB[1]; o2[2] = x1[2] * cB[1] + x2[2] * cB[0];
                        o1[3] = x1[3] * cB[2] - x2[3] * cB[3]; o2[3] = x1[3] * cB[3] + x2[3] * cB[2];
                        o1 = o1 * sc; o2 = o2 * sc;
                        *(u32x2*)(rowp + bj * HALF) = pack4(o1); *(u32x2*)(rowp + bj * HALF + 16) = pack4(o2); } }
        } else {
            const int colt = (pn - 12) * 256;
#pragma unroll
            for (int ai = 0; ai < 2; ++ai)
#pragma unroll
                for (int m = 0; m < 4; ++m) { const int row = row0 + ai * HALF + m * 16;
                    bf16_t* bp; int tstride;
                    if (lat) { const int b = row >> 11, t = row & 2047; bp = VTl + (size_t)b * (16 * 64 * 2048) + t; tstride = 2048; }
                    else { const int rr = row - 8192, b = rr >> 8, l = rr & 255; bp = VTc + (size_t)b * (16 * 64 * 256) + l; tstride = 256; }
#pragma unroll
                    for (int bj = 0; bj < 2; ++bj)
#pragma unroll
                        for (int n = 0; n < 2; ++n) { const int c = colt + bj * HALF + wc * 32 + n * 16 + 4 * fq; const f32x4 v = acc[ai][bj][m][n];
                            const u32x2 w = pack4(v);
                            bp[(size_t)(c + 0) * tstride] = (bf16_t)(w.x & 0xffffu); bp[(size_t)(c + 1) * tstride] = (bf16_t)(w.x >> 16);
                            bp[(size_t)(c + 2) * tstride] = (bf16_t)(w.y & 0xffffu); bp[(size_t)(c + 3) * tstride] = (bf16_t)(w.y >> 16); } }
        }
    }
};
struct EpiD1 {
    static constexpr bool PERM = false, AFTER_DRAIN = false;
    const bf16_t* GS; bf16_t* T1;
    __device__ __forceinline__ void operator()(const f32x4 (&acc)[2][2][4][2], const Unit& u, int wr, int wc, int fr, int fq) const {
        const int row0 = u.pm * BM + wr * 64 + fr, L0 = u.pn * 128 + wc * 16 + 4 * fq;
#pragma unroll
        for (int ai = 0; ai < 2; ++ai)
#pragma unroll
            for (int m = 0; m < 4; ++m) { const size_t off = (size_t)(row0 + ai * HALF + m * 16) * 2048 + L0;
#pragma unroll
                for (int bj = 0; bj < 2; ++bj) { const f32x4 val = acc[ai][bj][m][0], glu = acc[ai][bj][m][1]; const u32x2 g = *(const u32x2*)(GS + off + bj * 64); f32x4 t;
                    t[0] = bflo(g.x) * val[0] * sigm(glu[0]); t[1] = bfhi(g.x) * val[1] * sigm(glu[1]); t[2] = bflo(g.y) * val[2] * sigm(glu[2]); t[3] = bfhi(g.y) * val[3] * sigm(glu[3]);
                    *(u32x2*)(T1 + off + bj * 64) = pack4(t); } }
    }
};
struct EpiD2 {
    static constexpr bool PERM = true, AFTER_DRAIN = false;
    const bf16_t* GN; bf16_t* TM;
    __device__ __forceinline__ void operator()(const f32x4 (&acc)[2][2][4][2], const Unit& u, int wr, int wc, int fr, int fq) const {
        const int row0 = u.pm * BM + wr * 64 + fr, col0 = u.pn * BM + wc * 32 + 8 * fq;
#pragma unroll
        for (int ai = 0; ai < 2; ++ai)
#pragma unroll
            for (int m = 0; m < 4; ++m) { const size_t off = (size_t)(row0 + ai * HALF + m * 16) * 2048 + col0;
#pragma unroll
                for (int bj = 0; bj < 2; ++bj) { const f32x4 v0 = acc[ai][bj][m][0], v1 = acc[ai][bj][m][1];
                    const u32x4 t = *(const u32x4*)(TM + off + bj * HALF), g = *(const u32x4*)(GN + off + bj * HALF); u32x4 w;
                    w.x = cvt_pk_bf16(bflo(t.x) + bflo(g.x) * v0[0], bfhi(t.x) + bfhi(g.x) * v0[1]); w.y = cvt_pk_bf16(bflo(t.y) + bflo(g.y) * v0[2], bfhi(t.y) + bfhi(g.y) * v0[3]);
                    w.z = cvt_pk_bf16(bflo(t.z) + bflo(g.z) * v1[0], bfhi(t.z) + bfhi(g.z) * v1[1]); w.w = cvt_pk_bf16(bflo(t.w) + bflo(g.w) * v1[2], bfhi(t.w) + bfhi(g.w) * v1[3]);
                    *(u32x4*)(TM + off + bj * HALF) = w; } }
    }
};
struct EpiF32 {
    static constexpr bool PERM = false, AFTER_DRAIN = false;
    float* O; int ldc;
    __device__ __forceinline__ void operator()(const f32x4 (&acc)[2][2][4][2], const Unit& u, int wr, int wc, int fr, int fq) const {
        const int row0 = u.pm * BM + wr * 64 + fr, col0 = u.pn * BM + wc * 32 + 4 * fq;
#pragma unroll
        for (int ai = 0; ai < 2; ++ai)
#pragma unroll
            for (int m = 0; m < 4; ++m) { float* rowp = O + (size_t)(row0 + ai * HALF + m * 16) * ldc + col0;
#pragma unroll
                for (int bj = 0; bj < 2; ++bj)
#pragma unroll
                    for (int n = 0; n < 2; ++n) *(f32x4*)(rowp + bj * HALF + n * 16) = acc[ai][bj][m][n]; }
    }
};
struct EpiF32S {
    static constexpr bool PERM = true, AFTER_DRAIN = false;
    bf16_t* O; bf16_t* SL;
    __device__ __forceinline__ void operator()(const f32x4 (&acc)[2][2][4][2], const Unit& u, int wr, int wc, int fr, int fq) const {
        const int row0 = u.pm * BM + wr * 64 + fr, col0 = u.pn * BM + wc * 32 + 8 * fq;
        if (u.pm < 32) {
#pragma unroll
            for (int ai = 0; ai < 2; ++ai)
#pragma unroll
                for (int m = 0; m < 4; ++m) { bf16_t* rowp = O + (size_t)(row0 + ai * HALF + m * 16) * 2048 + col0;
#pragma unroll
                    for (int bj = 0; bj < 2; ++bj) { const f32x4 v0 = acc[ai][bj][m][0], v1 = acc[ai][bj][m][1];
                        u32x4 w; w.x = cvt_pk_bf16(v0[0], v0[1]); w.y = cvt_pk_bf16(v0[2], v0[3]); w.z = cvt_pk_bf16(v1[0], v1[1]); w.w = cvt_pk_bf16(v1[2], v1[3]);
                        *(u32x4*)(rowp + bj * HALF) = w; } }
        } else {
            bf16_t* base = SL + ((size_t)u.ks * 1024 + (row0 - 8192)) * 2048;
#pragma unroll
            for (int ai = 0; ai < 2; ++ai)
#pragma unroll
                for (int m = 0; m < 4; ++m) { bf16_t* rowp = base + (size_t)(ai * HALF + m * 16) * 2048 + col0;
#pragma unroll
                    for (int bj = 0; bj < 2; ++bj) { const f32x4 v0 = acc[ai][bj][m][0], v1 = acc[ai][bj][m][1];
                        u32x4 w; w.x = cvt_pk_bf16(v0[0], v0[1]); w.y = cvt_pk_bf16(v0[2], v0[3]); w.z = cvt_pk_bf16(v1[0], v1[1]); w.w = cvt_pk_bf16(v1[2], v1[3]);
                        *(u32x4*)(rowp + bj * HALF) = w; } }
        }
    }
};
struct OrderSplitCtx : StaticOrder {
    int ksl, nctx;
    __device__ __forceinline__ bool next(int i, Unit& u, int ntdef) const {
        if (StaticOrder::next(i, u, ntdef)) return true;
        const long L = (long)i * G + c - nwg; if (L >= nctx) return false;
        const int unit = (int)L >> 3; u.pm = 32 + (unit & 3); u.pn = unit >> 2; u.ks = (int)L & 7; u.nt = ksl; return true;
    }
};
struct EpiRelu2 {
    static constexpr bool PERM = true, AFTER_DRAIN = false;
    bf16_t* O; int ldc;
    __device__ __forceinline__ void operator()(const f32x4 (&acc)[2][2][4][2], const Unit& u, int wr, int wc, int fr, int fq) const {
        const int row0 = u.pm * BM + wr * 64 + fr, col0 = u.pn * BM + wc * 32 + 8 * fq;
#pragma unroll
        for (int ai = 0; ai < 2; ++ai)
#pragma unroll
            for (int m = 0; m < 4; ++m) { bf16_t* rowp = O + (size_t)(row0 + ai * HALF + m * 16) * ldc + col0;
#pragma unroll
                for (int bj = 0; bj < 2; ++bj) { f32x4 v0 = acc[ai][bj][m][0], v1 = acc[ai][bj][m][1];
                    v0 = __builtin_elementwise_max(v0, (f32x4){0.f, 0.f, 0.f, 0.f}); v1 = __builtin_elementwise_max(v1, (f32x4){0.f, 0.f, 0.f, 0.f}); v0 = v0 * v0; v1 = v1 * v1;
                    u32x4 w; w.x = cvt_pk_bf16(v0[0], v0[1]); w.y = cvt_pk_bf16(v0[2], v0[3]); w.z = cvt_pk_bf16(v1[0], v1[1]); w.w = cvt_pk_bf16(v1[2], v1[3]);
                    *(u32x4*)(rowp + bj * HALF) = w; } }
    }
};
struct OrderL1In : StaticOrder {
    __device__ __forceinline__ bool next(int i, Unit& u, int ntdef) const {
        if (StaticOrder::next(i, u, ntdef)) return true;
        const long L = (long)i * G + c - nwg; if (L >= 48) return false;
        const int k = (int)L >> 2; u.pm = 32 + ((int)L & 3); u.pn = k < 4 ? k : k + 4; return true;
    }
};

template <class Epi, class Sched, bool ALIGN_EPI = false, bool SP2 = false>
__device__ __forceinline__ void gemm_phase(PG8_LAS unsigned char* lds, const Gemm g, const Sched& S, const Epi& E) {
    int tid_o = threadIdx.x; asm volatile("" : "+v"(tid_o));
    const int tid = tid_o, wid = __builtin_amdgcn_readfirstlane(tid >> 6), lane = tid & 63, wr = wid >> 2, wc = wid & 3, fr = lane & 15, fq = lane >> 4;
    const int K = g.K, nt = K / BK;
    unsigned voffA[2], voffB[2];
#pragma unroll
    for (int i = 0; i < 2; ++i) { int R, C; stage_rc(tid * 16 + i * 8192, R, C); const int Rb = Epi::PERM ? ((R & ~31) + perm32(R & 31)) : R;
        voffA[i] = (unsigned)(R * K + C) * 2u; voffB[i] = (unsigned)(Rb * K + C) * 2u; }
    const size_t kstep = (size_t)(BK * 2);
    const size_t hstep = (size_t)HALF * K * 2;
    const size_t tstep = 2 * hstep;
    const unsigned ldsw = (unsigned)wid * 1024u;
    const int aoff = lds_byte(wr * 64 + fr, fq * 8), boff = lds_byte(wc * 32 + fr, fq * 8);
#define PG8_SA(b, h) (((b) * 2 + (h)) * HTB)
#define PG8_SB(b, h) ((4 + (b) * 2 + (h)) * HTB)
#define PG8_STAGE(bufoff, gbase, voff) do { _Pragma("unroll") for (int _i = 0; _i < 2; ++_i) \
        __builtin_amdgcn_global_load_lds((const unsigned*)((const char*)(gbase) + (voff)[_i]), (PG8_LAS unsigned*)(lds + (bufoff) + ldsw + _i * 8192), 16, 0, 0); } while (0)
#define PG8_LDA(dst, b, h) do { _Pragma("unroll") for (int m = 0; m < 4; ++m) _Pragma("unroll") for (int k = 0; k < 2; ++k) dst[m][k] = *(const PG8_LAS bf16x8*)(lds + PG8_SA(b, h) + aoff + m * 2048 + k * 1024); } while (0)
#define PG8_LDB(dst, b, h) do { _Pragma("unroll") for (int n = 0; n < 2; ++n) _Pragma("unroll") for (int k = 0; k < 2; ++k) dst[n][k] = *(const PG8_LAS bf16x8*)(lds + PG8_SB(b, h) + boff + n * 2048 + k * 1024); } while (0)
#define PG8_MMA(ai, bj, At, Bt) do { __builtin_amdgcn_s_setprio(1); _Pragma("unroll") for (int m = 0; m < 4; ++m) _Pragma("unroll") for (int n = 0; n < 2; ++n) _Pragma("unroll") for (int k = 0; k < 2; ++k) \
        acc[ai][bj][m][n] = __builtin_amdgcn_mfma_f32_16x16x32_bf16(Bt[n][k], At[m][k], acc[ai][bj][m][n], 0, 0, 0); __builtin_amdgcn_s_setprio(0); } while (0)
#define PG8_WAIT_V(n) asm volatile("s_waitcnt vmcnt(" #n ")" ::: "memory")
#define PG8_WAIT_L(n) asm volatile("s_waitcnt lgkmcnt(" #n ")" ::: "memory")
#define PG8_BAR __builtin_amdgcn_s_barrier()
#define PG8_SCHED __builtin_amdgcn_sched_barrier(0)
    Unit cur, nxt; int ui = 0;
    if (!S.next(0, cur, nt)) return;
    f32x4 acc[2][2][4][2];
#pragma unroll
    for (int a = 0; a < 2; ++a)
#pragma unroll
        for (int b = 0; b < 2; ++b)
#pragma unroll
            for (int m = 0; m < 4; ++m)
#pragma unroll
                for (int n = 0; n < 2; ++n) acc[a][b][m][n] = (f32x4){0.f, 0.f, 0.f, 0.f};
    bf16x8 At[4][2], B0[2][2], B1[2][2];
    const char* cA = (const char*)g.A + (size_t)cur.pm * tstep + (size_t)(cur.ks * cur.nt) * (BK * 2); const char* cB = (const char*)g.Bt + (size_t)cur.pn * tstep + (size_t)(cur.ks * cur.nt) * (BK * 2);
    S.a_ready(cur);
    if constexpr (SP2) {
        PG8_STAGE(PG8_SB(0, 0), cB, voffB); PG8_STAGE(PG8_SB(0, 1), cB + hstep, voffB); PG8_STAGE(PG8_SA(0, 0), cA, voffA); PG8_STAGE(PG8_SA(0, 1), cA + hstep, voffA);
        if (wr == 1) PG8_BAR;
        PG8_WAIT_V(2); PG8_BAR;
        PG8_STAGE(PG8_SB(1, 0), cB + kstep, voffB); PG8_STAGE(PG8_SA(1, 0), cA + kstep, voffA); PG8_STAGE(PG8_SB(1, 1), cB + hstep + kstep, voffB);
        PG8_WAIT_V(6); PG8_BAR;
    } else {
        PG8_STAGE(PG8_SB(0, 0), cB, voffB); PG8_STAGE(PG8_SA(0, 0), cA, voffA); PG8_STAGE(PG8_SB(0, 1), cB + hstep, voffB); PG8_STAGE(PG8_SA(0, 1), cA + hstep, voffA);
        if (wr == 1) PG8_BAR;
        PG8_WAIT_V(4); PG8_BAR;
        PG8_STAGE(PG8_SB(1, 0), cB + kstep, voffB); PG8_STAGE(PG8_SA(1, 0), cA + kstep, voffA); PG8_STAGE(PG8_SB(1, 1), cB + hstep + kstep, voffB);
        PG8_WAIT_V(6); PG8_BAR;
    }
    for (;;) {
        const bool has_next = S.next(ui + 1, nxt, nt);
        const int ntu = cur.nt;
        const char* nA = has_next ? (const char*)g.A + (size_t)nxt.pm * tstep + (size_t)(nxt.ks * nxt.nt) * (BK * 2) : cA; const char* nB = has_next ? (const char*)g.Bt + (size_t)nxt.pn * tstep + (size_t)(nxt.ks * nxt.nt) * (BK * 2) : cB;
        for (int t = 0; t < ntu; t += 2) {
            const bool last = (t == ntu - 2);
            const char* a1 = cA + (size_t)(t + 1) * kstep;
            const char* a2 = last ? nA : cA + (size_t)(t + 2) * kstep; const char* b2 = last ? nB : cB + (size_t)(t + 2) * kstep;
            const char* a3 = a2 + kstep; const char* b3 = b2 + kstep;
            if (last && has_next) S.a_ready(nxt);
            if constexpr (SP2) {
            PG8_LDB(B0, 0, 0); PG8_LDB(B1, 0, 1); PG8_SCHED; PG8_LDA(At, 0, 0); PG8_STAGE(PG8_SA(1, 1), a1 + hstep, voffA);
            PG8_WAIT_V(8); PG8_WAIT_L(0); PG8_BAR; PG8_MMA(0, 0, At, B0); PG8_MMA(0, 1, At, B1); PG8_BAR; PG8_SCHED;
            PG8_LDA(At, 0, 1); PG8_STAGE(PG8_SB(0, 0), b2, voffB); PG8_STAGE(PG8_SB(0, 1), b2 + hstep, voffB); PG8_STAGE(PG8_SA(0, 0), a2, voffA);
            PG8_WAIT_V(8); PG8_WAIT_L(0); PG8_BAR; PG8_MMA(1, 0, At, B0); PG8_MMA(1, 1, At, B1); PG8_BAR; PG8_SCHED;
            PG8_LDB(B0, 1, 0); PG8_LDB(B1, 1, 1); PG8_SCHED; PG8_LDA(At, 1, 0); PG8_STAGE(PG8_SA(0, 1), a2 + hstep, voffA);
            PG8_WAIT_V(8); PG8_WAIT_L(0); PG8_BAR; PG8_MMA(0, 0, At, B0); PG8_MMA(0, 1, At, B1); PG8_BAR; PG8_SCHED;
            PG8_LDA(At, 1, 1); PG8_STAGE(PG8_SB(1, 0), b3, voffB); PG8_STAGE(PG8_SB(1, 1), b3 + hstep, voffB); PG8_STAGE(PG8_SA(1, 0), a3, voffA);
            PG8_WAIT_V(8); PG8_WAIT_L(0); PG8_BAR; PG8_MMA(1, 0, At, B0); PG8_MMA(1, 1, At, B1); PG8_BAR; PG8_SCHED;
            } else {
            PG8_LDB(B0, 0, 0); PG8_SCHED; PG8_LDA(At, 0, 0); PG8_STAGE(PG8_SA(1, 1), a1 + hstep, voffA);
            PG8_WAIT_L(8); PG8_BAR; PG8_WAIT_L(0); PG8_MMA(0, 0, At, B0); PG8_BAR; PG8_SCHED;
            PG8_LDB(B1, 0, 1); PG8_STAGE(PG8_SB(0, 0), b2, voffB);
            PG8_BAR; PG8_WAIT_L(0); PG8_MMA(0, 1, At, B1); PG8_BAR;
            PG8_LDA(At, 0, 1); PG8_STAGE(PG8_SA(0, 0), a2, voffA);
            PG8_BAR; PG8_WAIT_L(0); PG8_MMA(1, 0, At, B0); PG8_BAR; PG8_SCHED;
            PG8_STAGE(PG8_SB(0, 1), b2 + hstep, voffB);
            PG8_WAIT_V(6); PG8_BAR; PG8_MMA(1, 1, At, B1); PG8_BAR;
            PG8_LDB(B0, 1, 0); PG8_SCHED; PG8_LDA(At, 1, 0); PG8_STAGE(PG8_SA(0, 1), a2 + hstep, voffA);
            PG8_WAIT_L(8); PG8_BAR; PG8_WAIT_L(0); PG8_MMA(0, 0, At, B0); PG8_BAR; PG8_SCHED;
            PG8_LDB(B1, 1, 1); PG8_STAGE(PG8_SB(1, 0), b3, voffB);
            PG8_BAR; PG8_WAIT_L(0); PG8_MMA(0, 1, At, B1); PG8_BAR;
            PG8_LDA(At, 1, 1); PG8_STAGE(PG8_SA(1, 0), a3, voffA);
            PG8_BAR; PG8_WAIT_L(0); PG8_MMA(1, 0, At, B0); PG8_BAR; PG8_SCHED;
            PG8_STAGE(PG8_SB(1, 1), b3 + hstep, voffB);
            PG8_WAIT_V(6); PG8_BAR; PG8_MMA(1, 1, At, B1); PG8_BAR;
            }
        }
        if constexpr (ALIGN_EPI) { if (wr == 0) PG8_BAR; }
        if constexpr (!Epi::AFTER_DRAIN) { E(acc, cur, wr, wc, fr, fq); S.done(cur); }
        if (!has_next) break;
#pragma unroll
        for (int a = 0; a < 2; ++a)
#pragma unroll
            for (int b = 0; b < 2; ++b)
#pragma unroll
                for (int m = 0; m < 4; ++m)
#pragma unroll
                    for (int n = 0; n < 2; ++n) acc[a][b][m][n] = (f32x4){0.f, 0.f, 0.f, 0.f};
        cur = nxt; cA = nA; cB = nB; ++ui;
        if constexpr (ALIGN_EPI) { if (wr == 1) PG8_BAR; }
    }
    PG8_WAIT_V(0);
    if constexpr (!ALIGN_EPI) { if (wr == 0) PG8_BAR; }
    PG8_BAR;
    if constexpr (Epi::AFTER_DRAIN) { E.fused(acc, cur, wr, wc, fr, fq, lds, wid, lane); S.done(cur); }
#undef PG8_SA
#undef PG8_SB
#undef PG8_STAGE
#undef PG8_LDA
#undef PG8_LDB
#undef PG8_MMA
#undef PG8_WAIT_V
#undef PG8_WAIT_L
#undef PG8_BAR
#undef PG8_SCHED
}
}

constexpr int NWAVES = 8;
constexpr int DM = 2048, NB = 4, SEQ = 2048, CTX = 256, DEPTH = 2, NHEAD = 16, HD = 64, GRIDW = 64, NMOD = 6;
constexpr int RL = NB * SEQ, RC = NB * CTX, RT = RL + RC;
constexpr int SSMW = 1024, NAW = 1024, PW = 8192, DFF = 8192, SG = 64, SP = 64, SC = 16;
constexpr float NORM_EPS = 1e-6f;
constexpr float LOG2E = 1.4426950408889634f;

constexpr size_t MiB = 1u << 20;
constexpr size_t WS_CTL = 0, CTL_ZERO_BYTES = 1 * MiB;
constexpr size_t WS_MOD = 1 * MiB;
constexpr size_t WS_ROPE = 1 * MiB + 512 * 1024;
constexpr size_t WS_W = 2 * MiB, W_LAYER = 116 * MiB;
constexpr size_t WO_IN = 0, WO_VG = 32 * MiB, WO_NA = 40 * MiB, WO_OUT = 44 * MiB, WO_FC1 = 52 * MiB, WO_FC2 = 84 * MiB;
constexpr size_t WS_XA = 234 * MiB;
constexpr size_t WS_H = 306 * MiB;
constexpr size_t WS_PROJ = 342 * MiB;
constexpr size_t PO_U = 0, PO_Q = 18 * MiB, PO_K = 36 * MiB, PO_VTL = 54 * MiB, PO_VTC = 70 * MiB, PO_GS = 72 * MiB, PO_GN = 108 * MiB;
constexpr size_t WS_ACT = 486 * MiB;
constexpr size_t WS_ATT = 504 * MiB;
constexpr size_t WS_TM = 522 * MiB;
constexpr size_t WS_OUT = 558 * MiB;
constexpr size_t WS_SLAB = 630 * MiB;
constexpr size_t WS_END = 694 * MiB;
constexpr int CW_BAR = 4096;

constexpr int RING_BYTES = 131072, MISC_OFF = RING_BYTES + 320, LDS_BYTES = 147456;
constexpr int SCAN_LDS = 17408;
#define GAS __attribute__((address_space(1)))
#define LAS __attribute__((address_space(3)))
typedef unsigned short bf16;
typedef unsigned v4u __attribute__((ext_vector_type(4)));
typedef unsigned v2u __attribute__((ext_vector_type(2)));
typedef float f32x4 __attribute__((ext_vector_type(4)));
typedef float f32x16 __attribute__((ext_vector_type(16)));
typedef short bf16x8 __attribute__((ext_vector_type(8)));
typedef GAS unsigned gu32;
#define RLX_AGENT __ATOMIC_RELAXED, __HIP_MEMORY_SCOPE_AGENT
#define LDS_WAIT() asm volatile("s_waitcnt lgkmcnt(0)" ::: "memory")
#define VM_WAIT() asm volatile("s_waitcnt vmcnt(0)" ::: "memory")
__device__ __forceinline__ unsigned f2bf(float f) { unsigned u = __builtin_bit_cast(unsigned, f); return (u + 0x7fffu + ((u >> 16) & 1u)) >> 16; }
__device__ __forceinline__ unsigned pk2(float lo, float hi) { return f2bf(lo) | (f2bf(hi) << 16); }
__device__ __forceinline__ float bf2f(bf16 v) { return __uint_as_float((unsigned)v << 16); }
__device__ __forceinline__ float wave_sum(float v) {
#pragma unroll
    for (int o = 1; o < 64; o <<= 1) v += __shfl_xor(v, o);
    return v;
}
#define XB_TMO      128
#define XB_XCNT(j)  (256  + 64 * (j))
#define XB_XSUB(j)  (1280 + 64 * (j))
#define XB_XGEN(j)  (2304 + 64 * (j))
#define XB_TOP      3328
#define XB_TOPGEN   3392
#define XCD_BAR_WORDS 3456
#define XB_SPIN_CAP (1u << 18)

__device__ __forceinline__ unsigned xb_ld(unsigned* p)              { return __hip_atomic_load(p, __ATOMIC_RELAXED, __HIP_MEMORY_SCOPE_AGENT); }
__device__ __forceinline__ unsigned xb_add(unsigned* p, unsigned v) { return __hip_atomic_fetch_add(p, v, __ATOMIC_RELAXED, __HIP_MEMORY_SCOPE_AGENT); }
__device__ __forceinline__ unsigned xb_xcc_id() { return (unsigned)__builtin_amdgcn_s_getreg((3 << 11) | 20) & 0xFu; }
#define XB_SPIN(cond, bar) do { unsigned _sp = 0; while (cond) { __builtin_amdgcn_s_sleep(1); \
    if ((++_sp & 255u) == 0u) { if (xb_ld(&(bar)[XB_TMO])) break; if (_sp > XB_SPIN_CAP) { atomicAdd(&(bar)[XB_TMO], 1u); break; } } } } while (0)

struct XcdBarrier {
    unsigned* bar; unsigned x;
    volatile LAS unsigned* st;
};

__device__ __forceinline__ XcdBarrier xcd_barrier_post(unsigned* bar, volatile LAS unsigned* st) {
    XcdBarrier b; b.bar = bar; b.x = xb_xcc_id(); b.st = st;
    if (threadIdx.x == 0) (void)xb_add(&bar[XB_XCNT(b.x)], 1u);
    return b;
}
__device__ __forceinline__ void xcd_barrier_complete(unsigned* bar, unsigned x, unsigned& nloc, unsigned& nx) {
    const unsigned G = gridDim.x * gridDim.y * gridDim.z;
    unsigned sum, cnt, mine, sp = 0u;
    for (;;) {
        sum = 0u; cnt = 0u; mine = 0u;
#pragma unroll
        for (unsigned j = 0; j < 16; ++j) { const unsigned c = xb_ld(&bar[XB_XCNT(j)]); sum += c; cnt += (c > 0u) ? 1u : 0u; mine = (j == x) ? c : mine; }
        if (sum == G) break;
        __builtin_amdgcn_s_sleep(1);
        if ((++sp & 255u) == 0u) { if (xb_ld(&bar[XB_TMO])) break; if (sp > XB_SPIN_CAP) { atomicAdd(&bar[XB_TMO], 1u); break; } }
    }
    nloc = mine > 0u ? mine : 1u; nx = cnt > 0u ? cnt : 1u;
}

__device__ __forceinline__ void xcd_barrier(const XcdBarrier& b) {
    asm volatile("s_waitcnt vmcnt(0)" ::: "memory");
    __syncthreads();
    if (threadIdx.x == 0) {
        unsigned* bar = b.bar;
        __builtin_amdgcn_s_waitcnt(0);
        unsigned nloc = b.st[0], nx = b.st[1];
        if (nloc == 0u) { xcd_barrier_complete(bar, b.x, nloc, nx); b.st[0] = nloc; b.st[1] = nx; }
        const unsigned old = xb_add(&bar[XB_XSUB(b.x)], 1u);
        const unsigned gen = old / nloc;
        if (old + 1u == (gen + 1u) * nloc) {
            __builtin_amdgcn_fence(__ATOMIC_RELEASE, "agent");
            asm volatile("s_waitcnt vmcnt(0)" ::: "memory");
            const unsigned og = xb_add(&bar[XB_TOP], 1u);
            const unsigned tg = og / nx;
            if (og + 1u == (tg + 1u) * nx) xb_add(&bar[XB_TOPGEN], 1u);
            else XB_SPIN(xb_ld(&bar[XB_TOPGEN]) == tg, bar);
            __builtin_amdgcn_fence(__ATOMIC_ACQUIRE, "agent");
            xb_add(&bar[XB_XGEN(b.x)], 1u);
            asm volatile("s_waitcnt vmcnt(0)" ::: "memory");
        } else {
            XB_SPIN(xb_ld(&bar[XB_XGEN(b.x)]) == gen, bar);
            __builtin_amdgcn_fence(__ATOMIC_ACQUIRE, "agent");
            asm volatile("s_waitcnt vmcnt(0)" ::: "memory");
        }
    }
    __syncthreads();
}

__device__ __forceinline__ void p0_transpose_item(const float* W, int K, int N, bf16* WT, int mode, LAS float* scr, int item, int lane) {
    const int nblk = N / 32, kb = item / nblk, nb = item % nblk, k0 = 64 * kb, n0 = 32 * nb;
    float wv[32];
    const float* wp = W + (size_t)(k0 + (lane >> 5)) * N + n0 + (lane & 31);
#pragma unroll
    for (int i = 0; i < 32; ++i) wv[i] = __builtin_nontemporal_load(wp + (size_t)(2 * i) * N);
#pragma unroll
    for (int i = 0; i < 32; ++i) scr[(2 * i + (lane >> 5)) * 33 + (lane & 31)] = wv[i];
    LDS_WAIT(); asm volatile("" ::: "memory");
    const int c = lane & 7;
#pragma unroll
    for (int j = 0; j < 4; ++j) { const int n = (lane >> 3) + 8 * j; const LAS float* s = scr + (8 * c) * 33 + n;
        v4u o; o.x = pk2(s[0 * 33], s[1 * 33]); o.y = pk2(s[2 * 33], s[3 * 33]); o.z = pk2(s[4 * 33], s[5 * 33]); o.w = pk2(s[6 * 33], s[7 * 33]);
        const int ng = n0 + n; const int drow = mode == 0 ? ng : (32 * (ng >> 4) + (ng & 15) + (mode == 2 ? 16 : 0));
        __builtin_nontemporal_store(o, (GAS v4u*)(WT + (size_t)drow * K + k0 + 8 * c)); }
    LDS_WAIT(); asm volatile("" ::: "memory");
}

template <bool HASY, int XOUT, bool HOUT>
__device__ __forceinline__ void rowpass_pipe(int lane, int first, int step, int M, const void* xin, bool xbf, const bf16* yin, void* xout, bf16* hout,
                                             const float* modg, const float* modh, int kss, int ksh, int mr_fixed) {
    int m = first; if (m >= M) return;
    f32x4 xr_[8]; v2u yc[8];
#pragma unroll
    for (int j = 0; j < 8; ++j) { xr_[j] = (f32x4){0.f, 0.f, 0.f, 0.f}; yc[j] = (v2u){0u, 0u}; }
    if (xbf) { const GAS v2u* xb = (const GAS v2u*)((const bf16*)xin + (size_t)m * DM) + lane;
#pragma unroll
        for (int j = 0; j < 8; ++j) { const v2u t = __builtin_nontemporal_load(xb + 64 * j); xr_[j].x = __uint_as_float(t.x); xr_[j].y = __uint_as_float(t.y); } }
    else { const GAS f32x4* xr = (const GAS f32x4*)((const float*)xin + (size_t)m * DM) + lane;
#pragma unroll
        for (int j = 0; j < 8; ++j) xr_[j] = __builtin_nontemporal_load(xr + 64 * j); }
    if (HASY) { const GAS v2u* yb = (const GAS v2u*)(yin + (size_t)m * DM) + lane;
#pragma unroll
        for (int j = 0; j < 8; ++j) yc[j] = __builtin_nontemporal_load(yb + 64 * j); }
    for (;;) {
        const int mn = m + step; const bool hn = mn < M;
        const int mr = mr_fixed >= 0 ? mr_fixed : (m >> 11);
        f32x4 gg[8], sv[8], hv[8];
        if (HASY) { const GAS f32x4* p = (const GAS f32x4*)(modg + (size_t)mr * (NMOD * DM)) + lane;
#pragma unroll
            for (int j = 0; j < 8; ++j) gg[j] = p[64 * j]; }
        f32x4 xn[8]; v2u yn[8];
#pragma unroll
        for (int j = 0; j < 8; ++j) { xn[j] = xr_[j]; yn[j] = yc[j]; }
        if (hn) {
            if (xbf) { const GAS v2u* xb = (const GAS v2u*)((const bf16*)xin + (size_t)mn * DM) + lane;
#pragma unroll
                for (int j = 0; j < 8; ++j) { const v2u t = __builtin_nontemporal_load(xb + 64 * j); xn[j].x = __uint_as_float(t.x); xn[j].y = __uint_as_float(t.y); } }
            else { const GAS f32x4* xr = (const GAS f32x4*)((const float*)xin + (size_t)mn * DM) + lane;
#pragma unroll
                for (int j = 0; j < 8; ++j) xn[j] = __builtin_nontemporal_load(xr + 64 * j); }
            if (HASY) { const GAS v2u* yb = (const GAS v2u*)(yin + (size_t)mn * DM) + lane;
#pragma unroll
                for (int j = 0; j < 8; ++j) yn[j] = __builtin_nontemporal_load(yb + 64 * j); } }
        f32x4 xc[8];
#pragma unroll
        for (int j = 0; j < 8; ++j) { const unsigned w0 = __float_as_uint(xr_[j].x), w1 = __float_as_uint(xr_[j].y);
            xc[j] = xbf ? (f32x4){pg8::bflo(w0), pg8::bfhi(w0), pg8::bflo(w1), pg8::bfhi(w1)} : xr_[j]; }
        if (HASY) { f32x4 yv[8]; float ss = 0.f;
#pragma unroll
            for (int j = 0; j < 8; ++j) { yv[j] = (f32x4){pg8::bflo(yc[j].x), pg8::bfhi(yc[j].x), pg8::bflo(yc[j].y), pg8::bfhi(yc[j].y)};
                ss += (yv[j].x * yv[j].x + yv[j].y * yv[j].y) + (yv[j].z * yv[j].z + yv[j].w * yv[j].w); }
            const float r = 1.0f / sqrtf(wave_sum(ss) * (1.0f / DM) + NORM_EPS);
#pragma unroll
            for (int j = 0; j < 8; ++j) xc[j] = xc[j] + gg[j] * (yv[j] * r); }
        if (XOUT == 1) { GAS f32x4* xo = (GAS f32x4*)((float*)xout + (size_t)m * DM) + lane;
#pragma unroll
            for (int j = 0; j < 8; ++j) __builtin_nontemporal_store(xc[j], xo + 64 * j); }
        if (XOUT == 2) { GAS v2u* xo = (GAS v2u*)((bf16*)xout + (size_t)m * DM) + lane;
#pragma unroll
            for (int j = 0; j < 8; ++j) { v2u w; w.x = pg8::cvt_pk_bf16(xc[j].x, xc[j].y); w.y = pg8::cvt_pk_bf16(xc[j].z, xc[j].w); __builtin_nontemporal_store(w, xo + 64 * j); } }
        if (HOUT) { float ss = 0.f;
            if (HASY) __builtin_amdgcn_sched_barrier(0);
            { const GAS f32x4* p = (const GAS f32x4*)(modh + (size_t)mr * (NMOD * DM) + kss * DM) + lane; const GAS f32x4* q = (const GAS f32x4*)(modh + (size_t)mr * (NMOD * DM) + ksh * DM) + lane;
#pragma unroll
              for (int j = 0; j < 8; ++j) { sv[j] = p[64 * j]; hv[j] = q[64 * j]; } }
#pragma unroll
            for (int j = 0; j < 8; ++j) ss += (xc[j].x * xc[j].x + xc[j].y * xc[j].y) + (xc[j].z * xc[j].z + xc[j].w * xc[j].w);
            const float r = 1.0f / sqrtf(wave_sum(ss) * (1.0f / DM) + NORM_EPS);
            GAS v2u* ho = (GAS v2u*)(hout + (size_t)m * DM) + lane;
#pragma unroll
            for (int j = 0; j < 8; ++j) { const f32x4 h = (xc[j] * r) * sv[j] + hv[j];
                v2u w; w.x = pg8::cvt_pk_bf16(h.x, h.y); w.y = pg8::cvt_pk_bf16(h.z, h.w); __builtin_nontemporal_store(w, ho + 64 * j); } }
        if (!hn) break;
#pragma unroll
        for (int j = 0; j < 8; ++j) { xr_[j] = xn[j]; yc[j] = yn[j]; }
        m = mn;
    }
}
__device__ __forceinline__ void rowpass_ctx8(LAS float* red, int lane, int wave, int vcu, int G, const void* xin, bool xbf, const bf16* slab, bf16* xout, bf16* hout,
                                             const float* gg, const float* sv, const float* hv) {
    for (int base = vcu * 4; base < RC; base += G * 4) {
        const int row = base + (wave >> 1); const size_t off = (size_t)row * DM + (wave & 1) * 1024; const int co = (wave & 1) * 1024;
        f32x4 xv[4], yv[4];
        v2u yb[8][4];
#pragma unroll
        for (int sl = 0; sl < 8; ++sl) { const GAS v2u* ys = (const GAS v2u*)(slab + (size_t)sl * RC * DM + off) + lane;
#pragma unroll
            for (int j = 0; j < 4; ++j) yb[sl][j] = __builtin_nontemporal_load(ys + 64 * j); }
        if (xbf) { const GAS v2u* xb = (const GAS v2u*)((const bf16*)xin + off) + lane;
#pragma unroll
            for (int j = 0; j < 4; ++j) { const v2u t = __builtin_nontemporal_load(xb + 64 * j); xv[j] = (f32x4){pg8::bflo(t.x), pg8::bfhi(t.x), pg8::bflo(t.y), pg8::bfhi(t.y)}; } }
        else { const GAS f32x4* xr = (const GAS f32x4*)((const float*)xin + off) + lane;
#pragma unroll
            for (int j = 0; j < 4; ++j) xv[j] = __builtin_nontemporal_load(xr + 64 * j); }
#pragma unroll
        for (int j = 0; j < 4; ++j) { yv[j] = (f32x4){0.f, 0.f, 0.f, 0.f};
#pragma unroll
            for (int sl = 0; sl < 8; ++sl) yv[j] = yv[j] + (f32x4){pg8::bflo(yb[sl][j].x), pg8::bfhi(yb[sl][j].x), pg8::bflo(yb[sl][j].y), pg8::bfhi(yb[sl][j].y)}; }
        float ss = 0.f;
#pragma unroll
        for (int j = 0; j < 4; ++j) ss += (yv[j].x * yv[j].x + yv[j].y * yv[j].y) + (yv[j].z * yv[j].z + yv[j].w * yv[j].w);
        ss = wave_sum(ss); if (lane == 0) red[wave] = ss;
        LDS_WAIT(); __syncthreads();
        float r = 1.0f / sqrtf((red[wave] + red[wave ^ 1]) * (1.0f / DM) + NORM_EPS);
        const GAS f32x4* gp = (const GAS f32x4*)(gg + co) + lane;
#pragma unroll
        for (int j = 0; j < 4; ++j) xv[j] = xv[j] + gp[64 * j] * (yv[j] * r);
        GAS v2u* xo = (GAS v2u*)(xout + off) + lane;
#pragma unroll
        for (int j = 0; j < 4; ++j) { v2u w; w.x = pg8::cvt_pk_bf16(xv[j].x, xv[j].y); w.y = pg8::cvt_pk_bf16(xv[j].z, xv[j].w); __builtin_nontemporal_store(w, xo + 64 * j); }
        ss = 0.f;
#pragma unroll
        for (int j = 0; j < 4; ++j) ss += (xv[j].x * xv[j].x + xv[j].y * xv[j].y) + (xv[j].z * xv[j].z + xv[j].w * xv[j].w);
        ss = wave_sum(ss); if (lane == 0) red[8 + wave] = ss;
        LDS_WAIT(); __syncthreads();
        r = 1.0f / sqrtf((red[8 + wave] + red[8 + (wave ^ 1)]) * (1.0f / DM) + NORM_EPS);
        const GAS f32x4* sp = (const GAS f32x4*)(sv + co) + lane; const GAS f32x4* hp = (const GAS f32x4*)(hv + co) + lane; GAS v2u* ho = (GAS v2u*)(hout + off) + lane;
#pragma unroll
        for (int j = 0; j < 4; ++j) { const f32x4 h = (xv[j] * r) * sp[64 * j] + hp[64 * j];
            v2u w; w.x = pg8::cvt_pk_bf16(h.x, h.y); w.y = pg8::cvt_pk_bf16(h.z, h.w); __builtin_nontemporal_store(w, ho + 64 * j); }
        LDS_WAIT();
    }
}

#define MFMA32(a, b, c) __builtin_amdgcn_mfma_f32_32x32x16_bf16(a, b, c, 0, 0, 0)
#define MFMA16(a, b, c) __builtin_amdgcn_mfma_f32_16x16x32_bf16(a, b, c, 0, 0, 0)
struct ScanPtrs { const float *lam_re, *lam_im, *log_dt, *b_re, *b_im, *c_re, *c_im, *dsk; const bf16* U; float* YP; bf16* ACT; };

__device__ __forceinline__ void s5_disc(const float* lam_re, const float* lam_im, int ldg, int pp, float dt, float& lbr, float& lbi, float& cr, float& ci) {
    const float lr = lam_re[ldg * 64 + pp], li = lam_im[ldg * 64 + pp];
    const float a = lr * dt, th = li * dt; float sn, cs; sincosf(th, &sn, &cs);
    const float em1 = expm1f(a), mag = em1 + 1.0f; float sh_, ch_; sincosf(0.5f * th, &sh_, &ch_);
    lbr = mag * cs; lbi = mag * sn;
    const float nr = em1 * cs - 2.0f * sh_ * sh_, ni = lbi;
    const float den = 1.0f / (lr * lr + li * li);
    cr = (nr * lr + ni * li) * den; ci = (ni * lr - nr * li) * den;
}
__device__ __forceinline__ float gelu_tanh(float y) { const float z = 0.7978845608028654f * (y + 0.044715f * y * y * y); return y * pg8::sigm(2.0f * z); }

constexpr int SELF_CI = 22;
template <bool REV>
__device__ __forceinline__ void scan_chain(LAS unsigned char* sl, LAS unsigned* flags, int layer, int b, int g, const ScanPtrs P, int lane, bool ctx_out) {
    const int d = REV ? 1 : 0, ldg = (layer * 2 + d) * 64 + g, hh = lane >> 5, l31 = lane & 31;
    const float dt = expf(P.log_dt[ldg]);
    float lb0r, lb0i, c0r, c0i, lb1r, lb1i, c1r, c1i;
    s5_disc(P.lam_re, P.lam_im, ldg, l31, dt, lb0r, lb0i, c0r, c0i);
    s5_disc(P.lam_re, P.lam_im, ldg, 32 + l31, dt, lb1r, lb1i, c1r, c1i);
    const float lr = hh ? lb1r : lb0r, li = hh ? lb1i : lb0i;
    bf16x8 bfr[4];
#pragma unroll
    for (int j = 0; j < 4; ++j) { const int pp = l31 + 32 * (j & 1); const float cr = (j & 1) ? c1r : c0r, ci = (j & 1) ? c1i : c0i;
        const float* br = P.b_re + ((size_t)ldg * 64 + pp) * 16 + 8 * hh; const float* bi = P.b_im + ((size_t)ldg * 64 + pp) * 16 + 8 * hh;
        const f32x4 r0 = *(const f32x4*)br, r1 = *(const f32x4*)(br + 4), i0 = *(const f32x4*)bi, i1 = *(const f32x4*)(bi + 4);
        f32x4 v0, v1; if (j < 2) { v0 = r0 * cr - i0 * ci; v1 = r1 * cr - i1 * ci; } else { v0 = i0 * cr + r0 * ci; v1 = i1 * cr + r1 * ci; }
        v4u w; w.x = pk2(v0.x, v0.y); w.y = pk2(v0.z, v0.w); w.z = pk2(v1.x, v1.y); w.w = pk2(v1.z, v1.w); bfr[j] = __builtin_bit_cast(bf16x8, w); }
    const int cc = lane & 15, kq = lane >> 4;
    bf16x8 cfr[4];
#pragma unroll
    for (int s = 0; s < 4; ++s) { const size_t o = ((size_t)ldg * 16 + cc) * 64 + 16 * s + 4 * kq; const f32x4 re = *(const f32x4*)(P.c_re + o), im = *(const f32x4*)(P.c_im + o);
        v4u w; w.x = pk2(re.x, -im.x); w.y = pk2(re.y, -im.y); w.z = pk2(re.z, -im.z); w.w = pk2(re.w, -im.w); cfr[s] = __builtin_bit_cast(bf16x8, w); }
    LAS unsigned char* SB = sl;
    float sr = 0.f, si = 0.f; int pend0 = -1, pend1 = -1;
    auto rowbase_of = [&](int ci) -> int { if (ci < 4) { const int c4 = REV ? 3 - ci : ci; return RL + b * CTX + c4 * 64; } const int lc = ci - 4, c32 = REV ? 31 - lc : lc; return b * SEQ + c32 * 64; };
    bf16x8 ufr[2], un1[2], un2[2];
    { const int rb = rowbase_of(0), r1 = rowbase_of(1);
#pragma unroll
      for (int i = 0; i < 2; ++i) { ufr[i] = *(const bf16x8*)(P.U + (size_t)(rb + 32 * i + l31) * 1024 + g * 16 + 8 * hh); un1[i] = *(const bf16x8*)(P.U + (size_t)(r1 + 32 * i + l31) * 1024 + g * 16 + 8 * hh); } }
    un2[0] = un1[0]; un2[1] = un1[1];
    const f32x4 dk4 = *(const f32x4*)(P.dsk + layer * 1024 + g * 16 + 4 * kq);
    for (int ci = 0; ci < 36; ++ci) {
        const int rb = rowbase_of(ci);
        const int fidx = ci < 4 ? (REV ? 3 - ci : ci) : 4 + (REV ? 35 - ci : ci - 4);
        const bool selfc = ci >= SELF_CI;
        unsigned long long op[8]; v2u uu[4];
#pragma unroll
        for (int e = 0; e < 4; ++e) { op[2 * e] = 0ull; op[2 * e + 1] = 0ull; uu[e] = (v2u){0u, 0u}; }
        if (selfc) {
            while (__hip_atomic_load(flags + fidx, __ATOMIC_RELAXED, __HIP_MEMORY_SCOPE_WORKGROUP) < 1u) __builtin_amdgcn_s_sleep(2);
            asm volatile("" ::: "memory");
            const size_t eo = (size_t)(rb + cc) * 1024 + g * 16 + 4 * kq;
            const unsigned long long* opp = (const unsigned long long*)(P.YP + (size_t)(1 - d) * RT * 1024 + eo); const bf16* upp = P.U + eo;
#pragma unroll
            for (int f = 0; f < 4; ++f) { op[2 * f] = __hip_atomic_load(opp + (size_t)f * 8192, RLX_AGENT); op[2 * f + 1] = __hip_atomic_load(opp + (size_t)f * 8192 + 1, RLX_AGENT); uu[f] = *(const v2u*)(upp + (size_t)f * 16384); }
        }
        if (ci + 2 < 36) { const int rn = rowbase_of(ci + 2);
#pragma unroll
            for (int i = 0; i < 2; ++i) un2[i] = *(const bf16x8*)(P.U + (size_t)(rn + 32 * i + l31) * 1024 + g * 16 + 8 * hh); }
#pragma unroll
        for (int ib = 0; ib < 2; ++ib) { const int i = REV ? 1 - ib : ib;
            const f32x16 z = {0.f, 0.f, 0.f, 0.f, 0.f, 0.f, 0.f, 0.f, 0.f, 0.f, 0.f, 0.f, 0.f, 0.f, 0.f, 0.f};
            f32x16 x0 = MFMA32(ufr[i], bfr[0], z), x1 = MFMA32(ufr[i], bfr[1], z), x2 = MFMA32(ufr[i], bfr[2], z), x3 = MFMA32(ufr[i], bfr[3], z);
#pragma unroll
            for (int r = 0; r < 16; ++r) {
                auto pa = __builtin_amdgcn_permlane32_swap(__float_as_uint(x0[r]), __float_as_uint(x1[r]), false, false); x0[r] = __uint_as_float(pa[0]); x1[r] = __uint_as_float(pa[1]);
                auto pc = __builtin_amdgcn_permlane32_swap(__float_as_uint(x2[r]), __float_as_uint(x3[r]), false, false); x2[r] = __uint_as_float(pc[0]); x3[r] = __uint_as_float(pc[1]);
            }
#pragma unroll
            for (int k = 0; k < 32; ++k) { const int t = REV ? 31 - k : k; const int tg = (t >> 2) & 1, rg = (t & 3) + 4 * (t >> 3);
                const float xr = tg ? x1[rg] : x0[rg], xi = tg ? x3[rg] : x2[rg];
                const float nr = fmaf(-li, si, fmaf(lr, sr, xr)), ni = fmaf(li, sr, fmaf(lr, si, xi)); sr = nr; si = ni;
                *(LAS unsigned*)(SB + (32 * i + t) * 272 + lane * 4) = pg8::cvt_pk_bf16(sr, si); }
        }
        LDS_WAIT(); asm volatile("" ::: "memory");
        if (ci >= 4 || ctx_out) {
            f32x4 ya[4];
#pragma unroll
            for (int f = 0; f < 4; ++f) { f32x4 a = {0.f, 0.f, 0.f, 0.f};
#pragma unroll
                for (int s = 0; s < 4; ++s) { const bf16x8 af = *(const LAS bf16x8*)(SB + (16 * f + cc) * 272 + (32 * s + 8 * kq) * 2); a = MFMA16(cfr[s], af, a); }
                ya[f] = a; }
            if (!selfc) {
            asm volatile("s_waitcnt vmcnt(6)" ::: "memory");
            if (pend1 >= 0 && lane == 0) (void)__hip_atomic_fetch_add(flags + pend1, 1u, __ATOMIC_RELAXED, __HIP_MEMORY_SCOPE_WORKGROUP);
            pend1 = pend0; pend0 = fidx;
            float* myp = P.YP + ((size_t)d * RT + rb + cc) * 1024 + g * 16 + 4 * kq;
#pragma unroll
            for (int f = 0; f < 4; ++f) *(f32x4*)(myp + (size_t)f * 16384) = ya[f];
            } else {
                VM_WAIT();
                if (lane == 0) { if (pend1 >= 0) (void)__hip_atomic_fetch_add(flags + pend1, 1u, __ATOMIC_RELAXED, __HIP_MEMORY_SCOPE_WORKGROUP);
                                 if (pend0 >= 0) (void)__hip_atomic_fetch_add(flags + pend0, 1u, __ATOMIC_RELAXED, __HIP_MEMORY_SCOPE_WORKGROUP); }
                pend1 = -1; pend0 = -1;
                bf16* ap = P.ACT + (size_t)(rb + cc) * 1024 + g * 16 + 4 * kq;
#pragma unroll
                for (int f = 0; f < 4; ++f) {
                    const float y0 = ya[f][0] + __uint_as_float((unsigned)op[2 * f]) + dk4[0] * pg8::bflo(uu[f].x), y1 = ya[f][1] + __uint_as_float((unsigned)(op[2 * f] >> 32)) + dk4[1] * pg8::bfhi(uu[f].x);
                    const float y2 = ya[f][2] + __uint_as_float((unsigned)op[2 * f + 1]) + dk4[2] * pg8::bflo(uu[f].y), y3 = ya[f][3] + __uint_as_float((unsigned)(op[2 * f + 1] >> 32)) + dk4[3] * pg8::bfhi(uu[f].y);
                    v2u w; w.x = pg8::cvt_pk_bf16(gelu_tanh(y0), gelu_tanh(y1)); w.y = pg8::cvt_pk_bf16(gelu_tanh(y2), gelu_tanh(y3)); *(v2u*)(ap + (size_t)f * 16384) = w; }
            }
        }
        ufr[0] = un1[0]; ufr[1] = un1[1]; un1[0] = un2[0]; un1[1] = un2[1];
    }
    VM_WAIT();
    if (lane == 0) { if (pend1 >= 0) (void)__hip_atomic_fetch_add(flags + pend1, 1u, __ATOMIC_RELAXED, __HIP_MEMORY_SCOPE_WORKGROUP);
                     if (pend0 >= 0) (void)__hip_atomic_fetch_add(flags + pend0, 1u, __ATOMIC_RELAXED, __HIP_MEMORY_SCOPE_WORKGROUP); }
}


__device__ __forceinline__ void scan_combine(const ScanPtrs P, int layer, int b, int g, int fidx, int lane) {
    const int rb = fidx < 4 ? RL + b * CTX + fidx * 64 : b * SEQ + (fidx - 4) * 64;
    const size_t ro = (size_t)(rb + lane) * 1024 + g * 16;
    const unsigned long long* p0 = (const unsigned long long*)(P.YP + ro); const unsigned long long* p1 = (const unsigned long long*)(P.YP + (size_t)RT * 1024 + ro);
    unsigned long long a[8], c[8];
#pragma unroll
    for (int i = 0; i < 8; ++i) { a[i] = __hip_atomic_load(p0 + i, RLX_AGENT); c[i] = __hip_atomic_load(p1 + i, RLX_AGENT); }
    const v4u u0 = *(const v4u*)(P.U + ro), u1 = *(const v4u*)(P.U + ro + 8);
    const unsigned uw[8] = {u0.x, u0.y, u0.z, u0.w, u1.x, u1.y, u1.z, u1.w};
    const float* dk = P.dsk + layer * 1024 + g * 16;
    unsigned ow[8];
#pragma unroll
    for (int i = 0; i < 8; ++i) {
        const float y0 = __uint_as_float((unsigned)a[i]) + __uint_as_float((unsigned)c[i]) + dk[2 * i] * pg8::bflo(uw[i]);
        const float y1 = __uint_as_float((unsigned)(a[i] >> 32)) + __uint_as_float((unsigned)(c[i] >> 32)) + dk[2 * i + 1] * pg8::bfhi(uw[i]);
        ow[i] = pg8::cvt_pk_bf16(gelu_tanh(y0), gelu_tanh(y1)); }
    v4u o0 = {ow[0], ow[1], ow[2], ow[3]}, o1 = {ow[4], ow[5], ow[6], ow[7]};
    *(v4u*)(P.ACT + ro) = o0; *(v4u*)(P.ACT + ro + 8) = o1;
}
struct AttPtrs { const bf16 *Q, *K, *VTl, *VTc; bf16* O; const float* rpb; };
constexpr int ATT_KS = 144, ATT_VS = 80, ATT_TILE = 32 * ATT_KS + 64 * ATT_VS;
struct AttG { v4u k[4], v[4]; };
__device__ __forceinline__ void att_gload(AttG& G, const bf16* kblk, const bf16* vblk, int vstride, int lane) {
#pragma unroll
    for (int i = 0; i < 4; ++i) { G.k[i] = *(const v4u*)(kblk + (size_t)(8 * i + (lane >> 3)) * 1024 + (lane & 7) * 8);
                                  G.v[i] = *(const v4u*)(vblk + (size_t)(16 * i + (lane >> 2)) * vstride + (lane & 3) * 8); }
}
__device__ __forceinline__ void att_lwrite(const AttG& G, LAS unsigned char* tile, int lane) {
#pragma unroll
    for (int i = 0; i < 4; ++i) { *(LAS v4u*)(tile + (8 * i + (lane >> 3)) * ATT_KS + (lane & 7) * 16) = G.k[i];
        LAS unsigned char* vp = tile + 32 * ATT_KS + (16 * i + (lane >> 2)) * ATT_VS + 32 * ((lane & 3) >> 1) + 8 * (lane & 1); v2u lo = {G.v[i].x, G.v[i].y}, hi = {G.v[i].z, G.v[i].w}; *(LAS v2u*)vp = lo; *(LAS v2u*)(vp + 16) = hi; }
}
struct AttF { bf16x8 k[4]; v2u v[8]; };
__device__ __forceinline__ void att_fread(AttF& F, const LAS unsigned char* tile, int lane) {
    const int q = lane & 31, hh = lane >> 5;
#pragma unroll
    for (int ss = 0; ss < 4; ++ss) F.k[ss] = *(const LAS bf16x8*)(tile + q * ATT_KS + (16 * ss + 8 * hh) * 2);
#pragma unroll
    for (int f = 0; f < 2; ++f)
#pragma unroll
        for (int s2 = 0; s2 < 2; ++s2) { const v4u w = *(const LAS v4u*)(tile + 32 * ATT_KS + (32 * f + q) * ATT_VS + 32 * s2 + 16 * hh); F.v[(f * 2 + s2) * 2] = (v2u){w.x, w.y}; F.v[(f * 2 + s2) * 2 + 1] = (v2u){w.z, w.w}; }
}
__device__ __forceinline__ void att_compute(const AttF& B, const bf16x8 (&qf)[4], f32x16& o0, f32x16& o1, float& mrun, float& lrun, bool local, const unsigned (&colb)[4], unsigned rowb) {
    f32x16 s = {0.f, 0.f, 0.f, 0.f, 0.f, 0.f, 0.f, 0.f, 0.f, 0.f, 0.f, 0.f, 0.f, 0.f, 0.f, 0.f};
#pragma unroll
    for (int ss = 0; ss < 4; ++ss) s = MFMA32(B.k[ss], qf[ss], s);
    if (local) {
        float bs[16];
#pragma unroll
        for (int r = 0; r < 16; ++r) bs[r] = *(const LAS float*)(size_t)(((colb[r >> 2] >> (8 * (r & 3))) & 0xffu) + rowb);
#pragma unroll
        for (int r = 0; r < 16; ++r) s[r] += bs[r];
    }
    float bm = s[0];
#pragma unroll
    for (int r = 1; r < 16; ++r) bm = fmaxf(bm, s[r]);
    bm = fmaxf(bm, __shfl_xor(bm, 32));
    if (__any(bm > mrun)) {
        const float mn = fmaxf(mrun, bm), alpha = __builtin_amdgcn_exp2f(mrun - mn); mrun = mn;
        lrun = lrun * alpha; o0 = o0 * alpha; o1 = o1 * alpha;
    }
    float p[16]; float ps = 0.f;
#pragma unroll
    for (int r = 0; r < 16; ++r) { p[r] = __builtin_amdgcn_exp2f(s[r] - mrun); ps += p[r]; }
    lrun += ps;
#pragma unroll
    for (int s2 = 0; s2 < 2; ++s2) { v4u w; w.x = pg8::cvt_pk_bf16(p[8 * s2], p[8 * s2 + 1]); w.y = pg8::cvt_pk_bf16(p[8 * s2 + 2], p[8 * s2 + 3]);
        w.z = pg8::cvt_pk_bf16(p[8 * s2 + 4], p[8 * s2 + 5]); w.w = pg8::cvt_pk_bf16(p[8 * s2 + 6], p[8 * s2 + 7]); const bf16x8 pf = __builtin_bit_cast(bf16x8, w);
        { v4u a = {B.v[s2 * 2].x, B.v[s2 * 2].y, B.v[s2 * 2 + 1].x, B.v[s2 * 2 + 1].y}; o0 = MFMA32(__builtin_bit_cast(bf16x8, a), pf, o0); }
        { v4u a = {B.v[(2 + s2) * 2].x, B.v[(2 + s2) * 2].y, B.v[(2 + s2) * 2 + 1].x, B.v[(2 + s2) * 2 + 1].y}; o1 = MFMA32(__builtin_bit_cast(bf16x8, a), pf, o1); } }
}
__device__ __forceinline__ void att_item(int item, int layer, const AttPtrs P, LAS unsigned char* tile, LAS float* btab, int& tab_head, int lane) {
    const int q = lane & 31, hh = lane >> 5;
    const bool local = item < 4096;
    int b, h, r = 0, half = 0, qrow;
    if (local) { half = item & 1; r = (item >> 1) & 31; h = (item >> 6) & 15; b = item >> 10; qrow = b * SEQ + r * 64 + half * 32 + q; }
    else { const int it = item - 4096; const int qb = it & 7; h = (it >> 3) & 15; b = it >> 7; qrow = RL + b * CTX + qb * 32 + q; }
    if (local && tab_head != h) {
        LDS_WAIT(); asm volatile("" ::: "memory");
        const float* src = P.rpb + ((size_t)layer * NHEAD + h) * 465;
        for (int i = lane; i < 480; i += 64) { const int ro = i >> 5, j = i & 31; btab[i] = j < 31 ? src[ro * 31 + j] * LOG2E : -1e30f; }
        LDS_WAIT(); asm volatile("" ::: "memory");
        tab_head = h;
    }
    bf16x8 qf[4];
#pragma unroll
    for (int s = 0; s < 4; ++s) qf[s] = *(const bf16x8*)(P.Q + (size_t)qrow * 1024 + h * 64 + 16 * s + 8 * hh);
    f32x16 o0 = {0.f, 0.f, 0.f, 0.f, 0.f, 0.f, 0.f, 0.f, 0.f, 0.f, 0.f, 0.f, 0.f, 0.f, 0.f, 0.f}, o1 = o0; float mrun = -1e30f, lrun = 0.f;
    const bf16* vtc = P.VTc + (size_t)(b * 16 + h) * 64 * CTX;
    const bf16* kc = P.K + (size_t)(RL + b * CTX) * 1024 + h * 64;
    int r0 = r - 4; r0 = r0 < 0 ? 0 : (r0 > 24 ? 24 : r0);
    const int c = half * 32 + q; int c0 = c - 8; c0 = c0 < 0 ? 0 : (c0 > 48 ? 48 : c0);
    const bf16* vtl = P.VTl + (size_t)(b * 16 + h) * 64 * SEQ;
    const bf16* kl = P.K + (size_t)(b * SEQ) * 1024 + h * 64;
    unsigned colb0[4] = {0u, 0u, 0u, 0u}, colb1[4] = {0u, 0u, 0u, 0u}; const unsigned tb = (unsigned)(size_t)btab;
#pragma unroll
    for (int rr = 0; rr < 16; ++rr) { const int k0 = (rr & 3) + 8 * (rr >> 2) + 4 * hh, k1 = 32 + k0;
        colb0[rr >> 2] |= (4u * (unsigned)(((unsigned)(k0 - c0) < 16u) ? k0 - c + 15 : 31)) << (8 * (rr & 3)); colb1[rr >> 2] |= (4u * (unsigned)(((unsigned)(k1 - c0) < 16u) ? k1 - c + 15 : 31)) << (8 * (rr & 3)); }
    const int npair = local ? 12 : 4;
    auto gl = [&](AttG& G, int i) { if (i < 8) att_gload(G, kc + (size_t)(32 * i) * 1024, vtc + 32 * i, CTX, lane);
                                    else { const int j = i - 8, t0 = (r0 + (j >> 1)) * 64 + 32 * (j & 1); att_gload(G, kl + (size_t)t0 * 1024, vtl + t0, SEQ, lane); } };
    const int nblk = 2 * npair;
    AttG G; gl(G, 0);
    att_lwrite(G, tile, lane);
    gl(G, 1);
    for (int p = 0; p < npair; ++p) {
        const bool loc = p >= 4; const unsigned rowb = tb + (loc ? (unsigned)((r0 + (p - 4) - r + 7) * 128) : 0u);
        { AttF F; LDS_WAIT(); asm volatile("" ::: "memory"); att_fread(F, tile, lane); LDS_WAIT(); asm volatile("" ::: "memory");
          att_lwrite(G, tile, lane); gl(G, 2 * p + 2 < nblk ? 2 * p + 2 : nblk - 1);
          att_compute(F, qf, o0, o1, mrun, lrun, loc, colb0, rowb); }
        { AttF F; LDS_WAIT(); asm volatile("" ::: "memory"); att_fread(F, tile, lane); LDS_WAIT(); asm volatile("" ::: "memory");
          att_lwrite(G, tile, lane); gl(G, 2 * p + 3 < nblk ? 2 * p + 3 : nblk - 1);
          att_compute(F, qf, o0, o1, mrun, lrun, loc, colb1, rowb); }
    }
    const float inv = 1.0f / (lrun + __shfl_xor(lrun, 32));
    bf16* op = P.O + (size_t)qrow * 1024 + h * 64 + 4 * hh;
#pragma unroll
    for (int g4 = 0; g4 < 4; ++g4) {
        v2u w0, w1; w0.x = pg8::cvt_pk_bf16(o0[4 * g4] * inv, o0[4 * g4 + 1] * inv); w0.y = pg8::cvt_pk_bf16(o0[4 * g4 + 2] * inv, o0[4 * g4 + 3] * inv);
        w1.x = pg8::cvt_pk_bf16(o1[4 * g4] * inv, o1[4 * g4 + 1] * inv); w1.y = pg8::cvt_pk_bf16(o1[4 * g4 + 2] * inv, o1[4 * g4 + 3] * inv);
        *(v2u*)(op + 8 * g4) = w0; *(v2u*)(op + 32 + 8 * g4) = w1; }
}

#ifndef REPEAT_MASK
#define REPEAT_MASK 0
#endif
#ifndef PROBE_SCAN_REP
#define PROBE_SCAN_REP 1
#endif
#ifndef PROBE_ATT_REP
#define PROBE_ATT_REP 1
#endif
#ifndef PHASE_MASK
#define PHASE_MASK 2047
#endif
constexpr int NPH = 2 + 9 * DEPTH;
struct Args { const float* in[26]; float* out; unsigned char* ws; int ph_lo, ph_hi, use_bar, pad; };
typedef const __attribute__((address_space(4))) Args* KArgs;
#define KARGS(ka) KArgs ka = (KArgs)__builtin_amdgcn_kernarg_segment_ptr(); asm volatile("" : "+s"(ka))

constexpr int I_IN = (DM / 64) * (PW / 32), I_VG = (SSMW / 64) * (DM / 32), I_NA = (NAW / 64) * (DM / 32), I_OUT = (DM / 64) * (DM / 32), I_F1 = (DM / 64) * (DFF / 32), I_F2 = (DFF / 64) * (DM / 32);
constexpr int I_MIX = I_IN + 2 * I_VG + I_NA + I_OUT, I_LAYER = I_MIX + I_F1 + I_F2;
__device__ __forceinline__ void conv_item(KArgs ka, unsigned char* ws, int l, int r, LAS float* scr, int lane) {
    unsigned char* wb = ws + WS_W + (size_t)l * W_LAYER;
    const float* src; int K, N, mode; size_t wo;
    if (r < I_IN) { src = ka->in[10] + (size_t)l * DM * PW; K = DM; N = PW; mode = 0; wo = WO_IN; }
    else if ((r -= I_IN) < I_VG) { src = ka->in[19] + (size_t)l * SSMW * DM; K = SSMW; N = DM; mode = 1; wo = WO_VG; }
    else if ((r -= I_VG) < I_VG) { src = ka->in[20] + (size_t)l * SSMW * DM; K = SSMW; N = DM; mode = 2; wo = WO_VG; }
    else if ((r -= I_VG) < I_NA) { src = ka->in[22] + (size_t)l * NAW * DM; K = NAW; N = DM; mode = 0; wo = WO_NA; }
    else if ((r -= I_NA) < I_OUT) { src = ka->in[23] + (size_t)l * DM * DM; K = DM; N = DM; mode = 0; wo = WO_OUT; }
    else if ((r -= I_OUT) < I_F1) { src = ka->in[24] + (size_t)l * DM * DFF; K = DM; N = DFF; mode = 0; wo = WO_FC1; }
    else { r -= I_F1; src = ka->in[25] + (size_t)l * DFF * DM; K = DFF; N = DM; mode = 0; wo = WO_FC2; }
    p0_transpose_item(src, K, N, (bf16*)(wb + wo), mode, scr, r, lane);
}

__device__ __forceinline__ void mod_gemv_items(KArgs ka, unsigned char* ws, LAS unsigned char* lds, int tid, int lane, int wave, int it0, int it1, int step) {
        {
            const float* c_in = ka->in[1]; const float* cctx_in = ka->in[3]; const float* w_mod = ka->in[4]; const float* b_mod = ka->in[5]; float* MOD = (float*)(ws + WS_MOD);
            LAS float* SIL = (LAS float*)(lds + 71680); LAS float* PART = (LAS float*)(lds + 112640);
            for (int i = tid; i < 5 * DM; i += NWAVES * 64) { const int r = i >> 11, k = i & 2047; const float v = r < 4 ? c_in[r * DM + k] : cctx_in[k]; SIL[i] = v / (1.0f + expf(-v)); }
            __syncthreads();
            for (int it = it0; it < it1; it += step) {
                const int l = it / 192, jn = it % 192, col = jn * 64 + lane, k0 = wave * 256;
                const float* W = w_mod + (size_t)l * DM * (NMOD * DM) + (size_t)k0 * (NMOD * DM) + col;
                float a0 = 0.f, a1 = 0.f, a2 = 0.f, a3 = 0.f, a4 = 0.f;
                for (int kk = 0; kk < 256; kk += 32) {
                    float wv[32];
#pragma unroll
                    for (int e = 0; e < 32; ++e) wv[e] = __builtin_nontemporal_load(W + (size_t)(kk + e) * (NMOD * DM));
#pragma unroll
                    for (int q4 = 0; q4 < 8; ++q4) { const int ko = k0 + kk + 4 * q4; const float w0 = wv[4 * q4], w1 = wv[4 * q4 + 1], w2 = wv[4 * q4 + 2], w3 = wv[4 * q4 + 3];
                        const f32x4 s0 = *(const LAS f32x4*)(SIL + 0 * DM + ko), s1 = *(const LAS f32x4*)(SIL + 1 * DM + ko), s2 = *(const LAS f32x4*)(SIL + 2 * DM + ko),
                                    s3 = *(const LAS f32x4*)(SIL + 3 * DM + ko), s4 = *(const LAS f32x4*)(SIL + 4 * DM + ko);
                        a0 += s0.x * w0 + s0.y * w1 + s0.z * w2 + s0.w * w3; a1 += s1.x * w0 + s1.y * w1 + s1.z * w2 + s1.w * w3; a2 += s2.x * w0 + s2.y * w1 + s2.z * w2 + s2.w * w3;
                        a3 += s3.x * w0 + s3.y * w1 + s3.z * w2 + s3.w * w3; a4 += s4.x * w0 + s4.y * w1 + s4.z * w2 + s4.w * w3; }
                }
                PART[(wave * 5 + 0) * 64 + lane] = a0; PART[(wave * 5 + 1) * 64 + lane] = a1; PART[(wave * 5 + 2) * 64 + lane] = a2; PART[(wave * 5 + 3) * 64 + lane] = a3; PART[(wave * 5 + 4) * 64 + lane] = a4;
                __syncthreads();
                if (wave < 5) { float s = b_mod[l * (NMOD * DM) + col];
#pragma unroll
                    for (int w = 0; w < 8; ++w) s += PART[(w * 5 + wave) * 64 + lane];
                    const int kidx = jn >> 5, c = col & (DM - 1);
                    if (kidx == 1) s = ka->in[6][l * DM + c] * (1.0f + s); else if (kidx == 2) s *= ka->in[7][l * DM + c];
                    else if (kidx == 4) s = ka->in[8][l * DM + c] * (1.0f + s); else if (kidx == 5) s *= ka->in[9][l * DM + c];
                    MOD[(size_t)(l * 5 + wave) * (NMOD * DM) + col] = s; }
                __syncthreads();
            }
        }
}
#define IDLE_COPY(nun, cl, lo_, hi_) do { const int first_ = (nun) % G; if (first_ != 0 && bx >= first_) { const int nid_ = G - first_, j_ = bx - first_, per_ = ((hi_) - (lo_) + nid_ - 1) / nid_; \
        const int a_ = (lo_) + j_ * per_, b_ = (a_ + per_ < (hi_)) ? a_ + per_ : (hi_); LAS float* scr_ = (LAS float*)(lds + wave * 8704); \
        for (int it_ = a_ + wave; it_ < b_; it_ += NWAVES) conv_item(ka, ws, cl, it_, scr_, lane); } } while (0)
__global__ void __launch_bounds__(NWAVES * 64, 2) mega_fwd(Args args_unused) {
    extern __shared__ __attribute__((aligned(16))) unsigned char lds_raw[];
    LAS unsigned char* lds = (LAS unsigned char*)lds_raw;
    const int tid0 = threadIdx.x, wave = __builtin_amdgcn_readfirstlane(tid0 >> 6);
    const int G = gridDim.x, bx = blockIdx.x;
    const int vcu = (G % 8 == 0) ? (bx % 8) * (G / 8) + bx / 8 : bx;
    const int gw = vcu * NWAVES + wave, NGW = G * NWAVES;
    for (int u = tid0; u < (LDS_BYTES - RING_BYTES) / 4; u += NWAVES * 64) ((LAS unsigned*)(lds + RING_BYTES))[u] = 0u;
    __syncthreads();
    int lo, hi, use_bar;
    { KARGS(ka); lo = ka->ph_lo; hi = ka->ph_hi; use_bar = ka->use_bar;
      if (use_bar) (void)xcd_barrier_post((unsigned*)(ka->ws + WS_CTL) + CW_BAR, (volatile LAS unsigned*)(lds + MISC_OFF) + 8); }
    for (int ph = lo; ph < hi; ++ph) {
    const int l = ph >= 2 ? (ph - 2) / 9 : 0, pk = ph >= 2 ? (ph - 2) % 9 : -1; const bool last = (l == DEPTH - 1);
    const int Mrows = last ? RL : RT;
    const int pbit = ph == 0 ? 512 : (ph == 1 ? 1024 : (1 << pk)); const int nrep = (REPEAT_MASK & pbit) ? 2 : 1;
    for (int rep = 0; rep < nrep; ++rep) {
    int tid = threadIdx.x; asm volatile("" : "+v"(tid)); const int lane = tid & 63;
    if (ph == 0 && (PHASE_MASK & 512)) {
        KARGS(ka); unsigned char* ws = ka->ws;
        {
            mod_gemv_items(ka, ws, lds, tid, lane, wave, bx, 192, G);
            float* ROPE = (float*)(ws + WS_ROPE);
            if (bx == G - 1) for (int i = tid; i < 64 * 16; i += NWAVES * 64) { const int pos = i >> 4, f = i & 15; const float inv = powf(10000.0f, -(float)f / 16.0f); const float ang = (float)pos * inv;
                float sn, cs; sincosf(ang, &sn, &cs); ROPE[2 * i] = cs; ROPE[2 * i + 1] = sn; }
        }
        LAS float* scr = (LAS float*)(lds + wave * 8704);
        for (int it = gw; it < I_MIX; it += NGW) conv_item(ka, ws, 0, it, scr, lane);
    }
    else if (ph == 1 && (PHASE_MASK & 1024)) {
        KARGS(ka); unsigned char* ws = ka->ws; const float* x_in = ka->in[0]; const float* ctx_in = ka->in[2];
        const float* MOD = (const float*)(ws + WS_MOD); bf16* H = (bf16*)(ws + WS_H);
        rowpass_pipe<false, 0, true>(lane, gw, NGW, RL, x_in, false, nullptr, nullptr, H, nullptr, MOD, 1, 0, -1);
        rowpass_pipe<false, 0, true>(lane, (gw & 1) ? RC : (gw >> 1), NGW / 2, RC, ctx_in, false, nullptr, nullptr, H + (size_t)RL * DM, nullptr, MOD, 1, 0, 4);
    }
    else {
        if (pk == 0 && (PHASE_MASK & 1)) {
            KARGS(ka); unsigned char* ws = ka->ws; unsigned char* wb = ws + WS_W + (size_t)l * W_LAYER; unsigned char* pj = ws + WS_PROJ;
            pg8::Gemm g{(const bf16*)(ws + WS_H), (const bf16*)(wb + WO_IN), RT, PW, DM};
            pg8::EpiIn E{(bf16*)(pj + PO_U), (bf16*)(pj + PO_Q), (bf16*)(pj + PO_K), (bf16*)(pj + PO_VTL), (bf16*)(pj + PO_VTC), (bf16*)(pj + PO_GS), (bf16*)(pj + PO_GN), (const float*)(ws + WS_ROPE)};
            if (!last) { pg8::StaticOrder S; S.init(RT, PW, G, bx); pg8::gemm_phase<pg8::EpiIn, pg8::StaticOrder, true, true>(lds, g, S, E); IDLE_COPY((RT / 256) * (PW / 256), 0, I_MIX, I_LAYER); }
            else { pg8::OrderL1In S; S.init(RL, PW, G, bx); pg8::gemm_phase<pg8::EpiIn, pg8::OrderL1In, true, true>(lds, g, S, E); IDLE_COPY((RL / 256) * (PW / 256) + 48, 1, I_MIX, I_LAYER); }
        }
        else if (pk == 1 && (PHASE_MASK & 2)) {
            KARGS(ka); unsigned char* ws = ka->ws; unsigned char* pj = ws + WS_PROJ;
            const ScanPtrs SPp{ka->in[11], ka->in[12], ka->in[13], ka->in[14], ka->in[15], ka->in[16], ka->in[17], ka->in[18], (const bf16*)(pj + PO_U), (float*)(ws + WS_OUT), (bf16*)(ws + WS_ACT)};
            LAS unsigned* flagb = (LAS unsigned*)(lds + MISC_OFF) + 16;
            if (tid < 320) flagb[tid] = 0u;
            if (tid == 0) ((LAS unsigned*)(lds + MISC_OFF))[12] = 0u;
            LDS_WAIT(); __syncthreads();
            LAS unsigned* cctr = (LAS unsigned*)(lds + MISC_OFF) + 12;
            if (wave < 2) {
                __builtin_amdgcn_s_setprio(3);
                LAS unsigned char* sl = lds + wave * SCAN_LDS; int iter = 0;
                for (int rp = 0; rp < PROBE_SCAN_REP; ++rp)
                for (int pair = bx; pair < NB * SG; pair += G, ++iter) {
                    LAS unsigned* flags = flagb + (iter & 7) * 40;
                    if (wave == 0) scan_chain<false>(sl, flags, l, pair >> 6, pair & 63, SPp, lane, !last);
                    else scan_chain<true>(sl, flags, l, pair >> 6, pair & 63, SPp, lane, !last);
                }
                __builtin_amdgcn_s_setprio(0);
            } else {
                LAS unsigned char* tile = lds + 2 * SCAN_LDS + (wave - 2) * ATT_TILE;
                {
                    const AttPtrs AP{(const bf16*)(pj + PO_Q), (const bf16*)(pj + PO_K), (const bf16*)(pj + PO_VTL), (const bf16*)(pj + PO_VTC), (bf16*)(ws + WS_ATT), ka->in[21]};
                    LAS float* btab = (LAS float*)(lds + 2 * SCAN_LDS + 6 * ATT_TILE + (wave - 2) * 2048); int tab_head = -1;
                    const int ipp = last ? 64 : 72, nq = 8 * ipp, xg = bx & 7, slot = (bx >> 3) * 6 + (wave - 2), nslot = (G >> 3) * 6;
                    const int ncl = last ? 4 : 8; int cpair = bx, citer = 0, cli = wave - 2;
                    for (int q = slot; ; q += nslot) {
                        const bool have = q < nq;
                        if (have) { const int pid = xg * 8 + q / ipp, w = q % ipp;
                            att_item(w < 64 ? pid * 64 + w : 4096 + pid * 8 + (w - 64), l, AP, tile, btab, tab_head, lane); }
                        while (cpair < NB * SG) {
                            if (cli >= ncl) { cli = wave - 2; cpair += G; ++citer; continue; }
                            const int cfc = last ? 18 + cli : (cli < 4 ? cli : 14 + cli);
                            volatile LAS unsigned* flags = (volatile LAS unsigned*)(flagb + (citer & 7) * 40);
                            if (flags[cfc] < 2u) { if (have) break;
                                unsigned spins = 0; while (flags[cfc] < 2u && ++spins < (1u << 24)) __builtin_amdgcn_s_sleep(8); }
                            asm volatile("" ::: "memory");
                            scan_combine(SPp, l, cpair >> 6, cpair & 63, cfc, lane);
                            cli += 6;
                        }
                        if (!have) break;
                    }
                }
            }
            __syncthreads();
        }
        else if (pk == 2 && (PHASE_MASK & 4)) {
            KARGS(ka); unsigned char* ws = ka->ws; unsigned char* wb = ws + WS_W + (size_t)l * W_LAYER;
            pg8::Gemm g{(const bf16*)(ws + WS_ACT), (const bf16*)(wb + WO_VG), Mrows, 2 * DM, SSMW}; pg8::StaticOrder S; S.init(Mrows, 2 * DM, G, bx);
            pg8::EpiD1 E{(const bf16*)(ws + WS_PROJ + PO_GS), (bf16*)(ws + WS_TM)};
            pg8::gemm_phase<pg8::EpiD1, pg8::StaticOrder, true, true>(lds, g, S, E);
            if (!last) { const int first = ((Mrows / 256) * (2 * DM / 256)) % G; if (first != 0 && bx >= first) mod_gemv_items(ka, ws, lds, tid, lane, wave, 192 + bx - first, 2 * 192, G - first); else if (first == 0) mod_gemv_items(ka, ws, lds, tid, lane, wave, 192 + bx, 2 * 192, G); }
        }
        else if (pk == 3 && (PHASE_MASK & 8)) {
            KARGS(ka); unsigned char* ws = ka->ws; unsigned char* wb = ws + WS_W + (size_t)l * W_LAYER;
            pg8::Gemm g{(const bf16*)(ws + WS_ATT), (const bf16*)(wb + WO_NA), Mrows, DM, NAW}; pg8::StaticOrder S; S.init(Mrows, DM, G, bx);
            pg8::EpiD2 E{(const bf16*)(ws + WS_PROJ + PO_GN), (bf16*)(ws + WS_TM)};
            pg8::gemm_phase<pg8::EpiD2, pg8::StaticOrder, true, true>(lds, g, S, E);
        }
        else if (pk == 4 && (PHASE_MASK & 16)) {
            KARGS(ka); unsigned char* ws = ka->ws; unsigned char* wb = ws + WS_W + (size_t)l * W_LAYER;
            pg8::Gemm g{(const bf16*)(ws + WS_TM), (const bf16*)(wb + WO_OUT), Mrows, DM, DM}; pg8::OrderSplitCtx S; S.init(RL, DM, G, bx); S.ksl = DM / 64 / 8; S.nctx = last ? 0 : 256;
            pg8::EpiF32S E{(bf16*)(ws + WS_OUT), (bf16*)(ws + WS_SLAB)};
            pg8::gemm_phase<pg8::EpiF32S, pg8::OrderSplitCtx, true, true>(lds, g, S, E);
        }
        else if ((pk == 5 && (PHASE_MASK & 32)) || (pk == 8 && (PHASE_MASK & 256))) {
            KARGS(ka); unsigned char* ws = ka->ws; const bool r2 = pk == 8;
            const float* mdl = (const float*)(ws + WS_MOD) + (size_t)(l * 5) * (NMOD * DM); const float* modg = mdl + (r2 ? 5 : 2) * DM;
            const float* modh = r2 ? mdl + (size_t)5 * (NMOD * DM) : mdl; const int kss = r2 ? 1 : 4, ksh = r2 ? 0 : 3;
            bf16* H = (bf16*)(ws + WS_H); bf16* XA = (bf16*)(ws + WS_XA); const bool xf = !r2 && l == 0;
            if (!last) rowpass_ctx8((LAS float*)(lds + MISC_OFF + 4096), lane, wave, vcu, G, xf ? (const void*)ka->in[2] : (const void*)(XA + (size_t)RL * DM), !xf, (const bf16*)(ws + WS_SLAB), XA + (size_t)RL * DM, H + (size_t)RL * DM,
                                    modg + (size_t)4 * (NMOD * DM), modh + (size_t)4 * (NMOD * DM) + kss * DM, modh + (size_t)4 * (NMOD * DM) + ksh * DM);
            if (!(r2 && last)) rowpass_pipe<true, 2, true>(lane, gw, NGW, RL, xf ? (const void*)ka->in[0] : (const void*)XA, !xf, (const bf16*)(ws + WS_OUT), XA, H, modg, modh, kss, ksh, -1);
            else rowpass_pipe<true, 1, false>(lane, gw, NGW, RL, XA, true, (const bf16*)(ws + WS_OUT), ka->out, nullptr, modg, nullptr, 0, 0, -1);
        }
        else if (pk == 6 && (PHASE_MASK & 64)) {
            KARGS(ka); unsigned char* ws = ka->ws; unsigned char* wb = ws + WS_W + (size_t)l * W_LAYER;
            pg8::Gemm g{(const bf16*)(ws + WS_H), (const bf16*)(wb + WO_FC1), Mrows, DFF, DM}; pg8::StaticOrder S; S.init(Mrows, DFF, G, bx);
            pg8::EpiRelu2 E{(bf16*)(ws + WS_PROJ), DFF};
            pg8::gemm_phase<pg8::EpiRelu2, pg8::StaticOrder, true, true>(lds, g, S, E);
            if (!last) IDLE_COPY((RT / 256) * (DFF / 256), 1, 0, I_MIX);
        }
        else if (pk == 7 && (PHASE_MASK & 128)) {
            KARGS(ka); unsigned char* ws = ka->ws; unsigned char* wb = ws + WS_W + (size_t)l * W_LAYER;
            pg8::Gemm g{(const bf16*)(ws + WS_PROJ), (const bf16*)(wb + WO_FC2), Mrows, DM, DFF}; pg8::OrderSplitCtx S; S.init(RL, DM, G, bx); S.ksl = DFF / 64 / 8; S.nctx = last ? 0 : 256;
            pg8::EpiF32S E{(bf16*)(ws + WS_OUT), (bf16*)(ws + WS_SLAB)};
            pg8::gemm_phase<pg8::EpiF32S, pg8::OrderSplitCtx, true, true>(lds, g, S, E);
        }
    }
    }
    if (ph + 1 < hi && use_bar) {
        KARGS(kb); XcdBarrier b2; b2.bar = (unsigned*)(kb->ws + WS_CTL) + CW_BAR; b2.x = xb_xcc_id(); b2.st = (volatile LAS unsigned*)(lds + MISC_OFF) + 8;
        xcd_barrier(b2);
    }
    }
}

extern "C" void kernel_launch(void* const* d_in, const int* in_sizes, int n_in, void* d_out, int out_size, void* d_ws, size_t ws_size, hipStream_t stream) {
    static int grid = 0;
    if (grid == 0) {
        if (n_in != 26 || in_sizes[0] != RL * DM || out_size != RL * DM || ws_size < WS_END) { fprintf(stderr, "kernel_launch: unexpected shapes / workspace (n_in %d, in0 %d, out %d, ws %zu < %zu); nothing launched\n", n_in, n_in > 0 ? in_sizes[0] : -1, out_size, ws_size, (size_t)WS_END); grid = -1; return; }
        int dev = 0, cus = 0, per_cu = 0;
        if (hipGetDevice(&dev) != hipSuccess || hipDeviceGetAttribute(&cus, hipDeviceAttributeMultiprocessorCount, dev) != hipSuccess) { grid = -1; return; }
        if (hipFuncSetAttribute((const void*)mega_fwd, hipFuncAttributeMaxDynamicSharedMemorySize, LDS_BYTES) != hipSuccess) { fprintf(stderr, "kernel_launch: hipFuncSetAttribute failed\n"); grid = -1; return; }
        if (hipOccupancyMaxActiveBlocksPerMultiprocessor(&per_cu, (const void*)mega_fwd, NWAVES * 64, LDS_BYTES) != hipSuccess || per_cu < 1) { fprintf(stderr, "kernel_launch: occupancy query says %d blocks per CU; nothing launched\n", per_cu); (void)hipGetLastError(); grid = -1; return; }
        grid = cus;
    }
    if (grid < 0) return;
    (void)hipMemsetAsync((char*)d_ws + WS_CTL, 0, CTL_ZERO_BYTES, stream);
    Args a{};
    for (int i = 0; i < 26; ++i) a.in[i] = (const float*)d_in[i];
    a.out = (float*)d_out; a.ws = (unsigned char*)d_ws;
#if MK_PER_PHASE
    for (int p = 0; p < NPH; ++p) { a.ph_lo = p; a.ph_hi = p + 1; a.use_bar = 0; a.pad = 0; hipLaunchKernelGGL(mega_fwd, dim3(grid), dim3(NWAVES * 64), LDS_BYTES, stream, a); }
#else
    a.ph_lo = 0; a.ph_hi = NPH; a.use_bar = 1; a.pad = 0;
    hipLaunchKernelGGL(mega_fwd, dim3(grid), dim3(NWAVES * 64), LDS_BYTES, stream, a);
#endif
}
```
